# Optimizing an MI355X kernel written in HIP

```python
import jax
import jax.numpy as jnp
from jax import lax
import numpy as np

D_MODEL = 2048
BATCH = 8
SEQ = 2048
DEPTH = 2

GRID_W = 64
CTX_LEN = 256
HEAD_DIM = 128
N_Q_HEADS = 16
N_KV_HEADS = 4
Q_BLOCK = 128
ROPE_THETA = 10000.0
POOL_GROUPS = 4
POOL_GROUP_DIM = 256
POOL_WINDOWS = (2, 4, 8, 16)
POOL_OUT_DIM = D_MODEL // POOL_GROUPS
PEER_HEADS = 8
PEER_N_KEYS = 128
PEER_N_EXPERTS = PEER_N_KEYS * PEER_N_KEYS
PEER_QUERY_DIM = 256
PEER_TOPK = 16
PEER_TOKEN_BLOCK = 128
EPS = 1e-6

Q_W = N_Q_HEADS * HEAD_DIM
KV_W = N_KV_HEADS * HEAD_DIM
POOL_W = POOL_GROUPS * POOL_GROUP_DIM
KV_OFF = Q_W
POOL_OFF = Q_W + 2 * KV_W
GA_OFF = POOL_OFF + POOL_W
GB_OFF = GA_OFF + D_MODEL
IN_W = GB_OFF + D_MODEL

kernel_name = 'hybrid_gqa_pool_peer_dit_block'


def rms(x):
    xf = x.astype(jnp.float32)
    return (xf * lax.rsqrt(jnp.mean(xf * xf, axis=-1, keepdims=True) + EPS)).astype(x.dtype)


def modulate(x, shift, scale):
    return rms(x) * (1 + scale) + shift


def rope_tables(L, dtype):
    rows = L // GRID_W
    row = jnp.repeat(jnp.arange(rows), GRID_W)
    col = jnp.tile(jnp.arange(GRID_W), rows)
    n_freq = HEAD_DIM // 4
    inv = ROPE_THETA ** (-jnp.arange(n_freq, dtype=jnp.float32) / n_freq)
    ang_r = row.astype(jnp.float32)[:, None, None] * inv
    ang_c = col.astype(jnp.float32)[:, None, None] * inv
    return (jnp.cos(ang_r).astype(dtype), jnp.sin(ang_r).astype(dtype),
            jnp.cos(ang_c).astype(dtype), jnp.sin(ang_c).astype(dtype))


def rotate(x, cos, sin):
    half = x.shape[-1] // 2
    x1, x2 = x[..., :half], x[..., half:]
    return jnp.concatenate([x1 * cos - x2 * sin, x2 * cos + x1 * sin], axis=-1)


def rope_2d(x, tabs):
    cos_r, sin_r, cos_c, sin_c = tabs
    half = HEAD_DIM // 2
    return jnp.concatenate([rotate(x[..., :half], cos_r, sin_r),
                            rotate(x[..., half:], cos_c, sin_c)], axis=-1)


def split_kv(kv, k_gain):
    B, L, _ = kv.shape
    k = rms(kv[..., :KV_W].reshape(B, L, N_KV_HEADS, HEAD_DIM)) * k_gain
    v = kv[..., KV_W:].reshape(B, L, N_KV_HEADS, HEAD_DIM)
    return k, v


def attn_block(qb, k, v):
    s = jnp.einsum('bqhgd,bkhd->bhgqk', qb, k).astype(jnp.float32) * (HEAD_DIM ** -0.5)
    p = jax.nn.softmax(s, axis=-1).astype(v.dtype)
    return jnp.einsum('bhgqk,bkhd->bqhgd', p, v)


def blocked_attention(q, k, v):
    B, L, Hq, Dh = q.shape
    G = Hq // N_KV_HEADS
    nb = L // Q_BLOCK
    qb = q.reshape(B, nb, Q_BLOCK, N_KV_HEADS, G, Dh).transpose(1, 0, 2, 3, 4, 5)
    o = lax.map(lambda blk: attn_block(blk, k, v), qb)
    return o.transpose(1, 0, 2, 3, 4, 5).reshape(B, L, Hq * Dh)


def multiscale_pool(u):
    B, L, _ = u.shape
    ug = u.reshape(B, L, POOL_GROUPS, POOL_GROUP_DIM)
    csum = jnp.concatenate([jnp.zeros((B, 1, POOL_GROUPS, POOL_GROUP_DIM), jnp.float32),
                            jnp.cumsum(ug.astype(jnp.float32), axis=1)], axis=1)
    t = jnp.arange(L)[:, None]
    w = jnp.array(POOL_WINDOWS)[None, :]
    lo = jnp.clip(t - w // 2, 0, L)
    hi = jnp.clip(t + (w - w // 2), 0, L)
    g_idx = jnp.arange(POOL_GROUPS)[None, :]
    sums = csum[:, hi, g_idx, :] - csum[:, lo, g_idx, :]
    count = (hi - lo).astype(jnp.float32)[None, :, :, None]
    return (sums / count).astype(u.dtype) - ug


def mix_tokens(p, k, v, q_gain, w_br_attn, w_pool, pool_scale, w_out, tabs):
    B, L, _ = p.shape
    q = rms(p[..., :Q_W].reshape(B, L, N_Q_HEADS, HEAD_DIM)) * q_gain
    if tabs is not None:
        q = rope_2d(q, tabs)
    y_a = blocked_attention(q, k, v) @ w_br_attn
    pooled = multiscale_pool(p[..., POOL_OFF:GA_OFF])
    y_b = jnp.einsum('blgc,gcd->blgd', pooled, w_pool).reshape(B, L, D_MODEL) * pool_scale
    merged = (jax.nn.sigmoid(p[..., GA_OFF:GB_OFF]) * y_a
              + jax.nn.sigmoid(p[..., GB_OFF:]) * y_b)
    return merged @ w_out


def peer_ffn(h, w_q_peer, peer_keys, peer_u, peer_v):
    B, L, D = h.shape
    q = (h @ w_q_peer).reshape(B, L, PEER_HEADS, 2, PEER_QUERY_DIM // 2)
    s = jnp.einsum('blhpd,hpkd->blhpk', q, peer_keys).astype(jnp.float32)
    sv, si = lax.top_k(s, PEER_TOPK)
    cand_s = (sv[..., 0, :, None] + sv[..., 1, None, :]).reshape(B, L, PEER_HEADS, PEER_TOPK * PEER_TOPK)
    cand_i = (si[..., 0, :, None] * PEER_N_KEYS + si[..., 1, None, :]).reshape(B, L, PEER_HEADS, PEER_TOPK * PEER_TOPK)
    top_s, pos = lax.top_k(cand_s, PEER_TOPK)
    idx = jnp.take_along_axis(cand_i, pos, axis=-1)
    g = jax.nn.softmax(top_s, axis=-1).astype(h.dtype)
    n_tok = B * L
    nb = n_tok // PEER_TOKEN_BLOCK
    n_sel = PEER_HEADS * PEER_TOPK
    hb = h.reshape(nb, PEER_TOKEN_BLOCK, D)
    ib = idx.reshape(nb, PEER_TOKEN_BLOCK, n_sel)
    gb = g.reshape(nb, PEER_TOKEN_BLOCK, n_sel)

    def token_block(args):
        hc, ic, gc = args
        act = jax.nn.gelu(jnp.einsum('td,ted->te', hc, peer_u[ic]), approximate=False)
        return jnp.einsum('te,ted->td', gc * act, peer_v[ic])

    out = lax.map(token_block, (hb, ib, gb))
    return out.reshape(B, L, D)


def setup_inputs(seed: int = 0) -> dict:
    key = jax.random.key(seed)
    ks = jax.random.split(key, 18)

    def nrm(k, shape, scale):
        return jax.random.normal(k, shape, jnp.float32) * scale

    return {
        'x': nrm(ks[0], (BATCH, SEQ, D_MODEL), 1.0),
        'c': nrm(ks[1], (BATCH, D_MODEL), 1.0),
        'ctx': nrm(ks[2], (BATCH, CTX_LEN, D_MODEL), 1.0),
        'c_ctx': nrm(ks[3], (D_MODEL,), 1.0),
        'w_ada': nrm(ks[4], (DEPTH, D_MODEL, 6 * D_MODEL), 0.5 * D_MODEL ** -0.5),
        'b_ada': nrm(ks[5], (DEPTH, 6 * D_MODEL), 0.01),
        'w_in': nrm(ks[6], (DEPTH, D_MODEL, IN_W), D_MODEL ** -0.5),
        'q_gain': 1.0 + nrm(ks[7], (DEPTH, HEAD_DIM), 0.1),
        'k_gain': 1.0 + nrm(ks[8], (DEPTH, HEAD_DIM), 0.1),
        'w_br_attn': nrm(ks[9], (DEPTH, Q_W, D_MODEL), Q_W ** -0.5),
        'w_pool': nrm(ks[10], (DEPTH, POOL_GROUPS, POOL_GROUP_DIM, POOL_OUT_DIM), POOL_GROUP_DIM ** -0.5),
        'pool_scale': 1.0 + nrm(ks[11], (DEPTH, D_MODEL), 0.1),
        'w_out': nrm(ks[12], (DEPTH, D_MODEL, D_MODEL), D_MODEL ** -0.5),
        'w_q_peer': nrm(ks[13], (DEPTH, D_MODEL, PEER_HEADS * PEER_QUERY_DIM), D_MODEL ** -0.5),
        'peer_keys': nrm(ks[14], (DEPTH, PEER_HEADS, 2, PEER_N_KEYS, PEER_QUERY_DIM // 2), (PEER_QUERY_DIM // 2) ** -0.5),
        'peer_u': nrm(ks[15], (DEPTH, PEER_N_EXPERTS, D_MODEL), D_MODEL ** -0.5),
        'peer_v': nrm(ks[16], (DEPTH, PEER_N_EXPERTS, D_MODEL), 2.0 * (PEER_HEADS * PEER_TOPK) ** -0.5),
        'final_gain': 1.0 + nrm(ks[17], (D_MODEL,), 0.1),
    }


def reference(x, c, ctx, c_ctx, w_ada, b_ada, w_in, q_gain, k_gain, w_br_attn, w_pool,
              pool_scale, w_out, w_q_peer, peer_keys, peer_u, peer_v, final_gain):
    B, L, D = x.shape
    tabs = rope_tables(L, x.dtype)
    for i in range(DEPTH):
        last = i == DEPTH - 1
        mod = jax.nn.silu(c) @ w_ada[i] + b_ada[i]
        sh_a, sc_a, g_a, sh_f, sc_f, g_f = [m[:, None, :] for m in jnp.split(mod, 6, axis=-1)]
        mod_c = jax.nn.silu(c_ctx) @ w_ada[i] + b_ada[i]
        csh_a, csc_a, cg_a, csh_f, csc_f, cg_f = jnp.split(mod_c, 6, axis=-1)

        hc = modulate(ctx, csh_a, csc_a)
        if last:
            pc = None
            kv_c = hc @ w_in[i][:, KV_OFF:POOL_OFF]
        else:
            pc = hc @ w_in[i]
            kv_c = pc[..., KV_OFF:POOL_OFF]
        k_c, v_c = split_kv(kv_c, k_gain[i])

        h = modulate(x, sh_a, sc_a)
        p = h @ w_in[i]
        k_x, v_x = split_kv(p[..., KV_OFF:POOL_OFF], k_gain[i])
        k_all = jnp.concatenate([rope_2d(k_x, tabs), k_c], axis=1)
        v_all = jnp.concatenate([v_x, v_c], axis=1)
        x = x + g_a * mix_tokens(p, k_all, v_all, q_gain[i], w_br_attn[i], w_pool[i],
                                 pool_scale[i], w_out[i], tabs)
        x = x + g_f * peer_ffn(modulate(x, sh_f, sc_f), w_q_peer[i], peer_keys[i],
                               peer_u[i], peer_v[i])

        if not last:
            ctx = ctx + cg_a * mix_tokens(pc, k_c, v_c, q_gain[i], w_br_attn[i], w_pool[i],
                                          pool_scale[i], w_out[i], None)
            ctx = ctx + cg_f * peer_ffn(modulate(ctx, csh_f, csc_f), w_q_peer[i], peer_keys[i],
                                        peer_u[i], peer_v[i])
    return rms(x) * final_gain
```

```cpp
#include <hip/hip_runtime.h>
#include <cstdio>
#include <cstdint>

#ifndef MK_PER_PHASE
#define MK_PER_PHASE 0
#endif

namespace pg8 {
#define PG8_LAS __attribute__((address_space(3)))
typedef unsigned short bf16_t;
typedef short bf16x8 __attribute__((ext_vector_type(8)));
typedef float f32x4 __attribute__((ext_vector_type(4)));
typedef unsigned u32x4 __attribute__((ext_vector_type(4)));
constexpr int BM = 256, BK = 64, HALF = 128, HTB = HALF * BK * 2, STAGE_BYTES = 8 * HTB, NXCD = 8, WGM = 8;

__host__ __device__ __forceinline__ int lds_byte(int r, int c) { const int st = (r >> 4) * 2 + (c >> 5), rr = r & 15, cc = c & 31, ob = rr * 64 + cc * 2; return st * 1024 + (ob ^ (((ob >> 9) & 1) << 5)); }
__host__ __device__ __forceinline__ void stage_rc(int b, int& R, int& C) { const int st = b / 1024, sb = b % 1024, swz = sb ^ (((sb >> 9) & 1) << 5); R = (st >> 1) * 16 + swz / 64; C = (st & 1) * 32 + (swz % 64) / 2; }
__host__ __device__ __forceinline__ int perm32(int rho) { const int n = rho >> 4, i = rho & 15; return 8 * (i >> 2) + 4 * n + (i & 3); }

struct Unit { int pm, pn; };
template <int LDA, int LDB, int KK, int AKSTEP, int AKSHIFT, int EB_ = 2> struct Gemm { const void* A; const void* Bt;
    static constexpr int lda = LDA, ldb = LDB, K = KK, akstep = AKSTEP, akshift = AKSHIFT, EB = EB_; };

struct StaticOrder {
    int nM, nN, nwg, G, c;
    __device__ void init(int M, int N, int G_, int c_) { nM = M / BM; nN = N / BM; nwg = nM * nN; G = G_; c = c_; }
    __device__ bool next(int i, Unit& u) const {
        const long L = (long)i * G + c; if (L >= nwg) return false;
        int wgid = (int)L; { const int q = nwg / NXCD, r = nwg % NXCD, xcd = wgid % NXCD, off = wgid / NXCD; wgid = (xcd < r ? xcd * (q + 1) : r * (q + 1) + (xcd - r) * q) + off; }
        const int nig = WGM * nN, gid = wgid / nig, fm = gid * WGM, gsz = (nM - fm) < WGM ? (nM - fm) : WGM;
        u.pm = fm + ((wgid % nig) % gsz); u.pn = (wgid % nig) / gsz; return true;
    }
};
struct SplitOrder {
    StaticOrder S; int kind, pm0, nMx;
    __device__ bool next(int i, Unit& u) const {
        const long L = (long)i * S.G + S.c;
        if (L < S.nwg) { S.next(i, u); u.pn = kind == 0 ? 12 + u.pn : (u.pn < 12 ? u.pn : u.pn + 4); return true; }
        const int j = (int)(L - S.nwg); if (j >= nMx * 4) return false;
        u.pm = pm0 + j / 4; u.pn = 8 + j % 4; return true;
    }
};

template <class F> struct EpiRow8 {
    static constexpr bool PERM = true;
    F f;
    __device__ __forceinline__ void operator()(const f32x4 (&acc)[2][2][4][2], const Unit& u, int wr, int wc, int fr, int fq) const {
        const int row0 = u.pm * BM + wr * 64 + fr, col0 = u.pn * BM + wc * 32 + 8 * fq;
        typename F::Col cp[2];
#pragma unroll
        for (int bj = 0; bj < 2; ++bj) cp[bj] = f.col_load(row0, col0 + bj * HALF);
#pragma unroll
        for (int ai = 0; ai < 2; ++ai) {
            typename F::Pre pre[4][2];
#pragma unroll
            for (int m = 0; m < 4; ++m)
#pragma unroll
                for (int bj = 0; bj < 2; ++bj) pre[m][bj] = f.load(row0 + ai * HALF + m * 16, col0 + bj * HALF);
#pragma unroll
            for (int m = 0; m < 4; ++m)
#pragma unroll
                for (int bj = 0; bj < 2; ++bj) f.apply(row0 + ai * HALF + m * 16, col0 + bj * HALF, acc[ai][bj][m][0], acc[ai][bj][m][1], pre[m][bj], cp[bj]);
            asm volatile("" ::: "memory");
        }
    }
    __device__ __forceinline__ void quarter(const f32x4 (&acc)[1][1][4][2], int rowo, int colo, int wr, int wc, int fr, int fq) const {
        const int row0 = rowo + wr * 64 + fr, col0 = colo + wc * 32 + 8 * fq;
        const typename F::Col cp = f.col_load(row0, col0);
        typename F::Pre pre[4];
#pragma unroll
        for (int m = 0; m < 4; ++m) pre[m] = f.load(row0 + m * 16, col0);
#pragma unroll
        for (int m = 0; m < 4; ++m) f.apply(row0 + m * 16, col0, acc[0][0][m][0], acc[0][0][m][1], pre[m], cp);
    }
};

template <class F> struct MidRow8 {
    F f;
    __device__ __forceinline__ void operator()(f32x4 (&acc)[2][2][4][2], const Unit& u, int wr, int wc, int fr, int fq) const {
        const int row0 = u.pm * BM + wr * 64 + fr, col0 = u.pn * BM + wc * 32 + 8 * fq;
        typename F::Col cp[2];
#pragma unroll
        for (int bj = 0; bj < 2; ++bj) cp[bj] = f.col_load(row0, col0 + bj * HALF);
#pragma unroll
        for (int ai = 0; ai < 2; ++ai) {
            typename F::Pre pre[4][2];
#pragma unroll
            for (int m = 0; m < 4; ++m)
#pragma unroll
                for (int bj = 0; bj < 2; ++bj) pre[m][bj] = f.load(row0 + ai * HALF + m * 16, col0 + bj * HALF);
#pragma unroll
            for (int m = 0; m < 4; ++m)
#pragma unroll
                for (int bj = 0; bj < 2; ++bj) f.xform(acc[ai][bj][m][0], acc[ai][bj][m][1], pre[m][bj], cp[bj]);
            asm volatile("" ::: "memory");
        }
    }
};
struct BlockOrder {
    int pm0, nM, nN, G, c;
    __device__ bool next(int i, Unit& u) const { const long k = (long)i * G + c; if (k >= (long)nM * nN) return false; u.pm = pm0 + (int)(k / nN); u.pn = (int)(k % nN); return true; }
};

template <class GemmT, class Epi, class Sched>
__device__ __forceinline__ void gemm_phase(PG8_LAS unsigned char* lds, const GemmT g, const Sched& S, const Epi& E) {
    int tid_ = threadIdx.x; asm volatile("" : "+v"(tid_));
    const int tid = tid_, wid = __builtin_amdgcn_readfirstlane(tid >> 6), lane = tid & 63, wr = wid >> 2, wc = wid & 3, fr = lane & 15, fq = lane >> 4;
    constexpr int K = GemmT::K, EB = GemmT::EB, nt = K * EB / 128;
    typedef int v8i __attribute__((ext_vector_type(8))); typedef int v4i __attribute__((ext_vector_type(4)));
    unsigned voffA[2], voffB[2];
#pragma unroll
    for (int i = 0; i < 2; ++i) { int R, C; stage_rc(tid * 16 + i * 8192, R, C); const int Rb = Epi::PERM ? ((R & ~31) + perm32(R & 31)) : R;
        voffA[i] = (unsigned)(R * GemmT::lda * EB + C * 2); voffB[i] = (unsigned)(Rb * GemmT::ldb * EB + C * 2); }
    constexpr size_t kstep = (size_t)(BK * 2);
    constexpr size_t hstepA = (size_t)HALF * GemmT::lda * EB, hstepB = (size_t)HALF * GemmT::ldb * EB;
    constexpr size_t tstepA = 2 * hstepA, tstepB = 2 * hstepB;
    constexpr size_t akb = (size_t)GemmT::akstep * EB;
    const unsigned ldsw = (unsigned)wid * 1024u;
    const int aoff0 = lds_byte(wr * 64 + fr, EB == 2 ? fq * 8 : fq * 16) + (EB == 2 ? 0 : 16 * (fq & 1)), boff0 = lds_byte(wc * 32 + fr, EB == 2 ? fq * 8 : fq * 16) + (EB == 2 ? 0 : 16 * (fq & 1));
    const int aoff1 = EB == 2 ? aoff0 + 1024 : (aoff0 ^ 16), boff1 = EB == 2 ? boff0 + 1024 : (boff0 ^ 16);
#define PG8_SA(b, h) (((b) * 2 + (h)) * HTB)
#define PG8_SB(b, h) ((4 + (b) * 2 + (h)) * HTB)
#define PG8_STAGE(bufoff, gbase, voff) do { _Pragma("unroll") for (int _i = 0; _i < 2; ++_i) \
        __builtin_amdgcn_global_load_lds((const unsigned*)((const char*)(gbase) + (voff)[_i]), (PG8_LAS unsigned*)(lds + (bufoff) + ldsw + _i * 8192), 16, 0, 0); } while (0)
#define PG8_LDA(dst, b, h) do { _Pragma("unroll") for (int m = 0; m < 4; ++m) { const v4i l_ = *(const PG8_LAS v4i*)(lds + PG8_SA(b, h) + aoff0 + m * 2048), h_ = *(const PG8_LAS v4i*)(lds + PG8_SA(b, h) + aoff1 + m * 2048); dst[m] = __builtin_shufflevector(l_, h_, 0, 1, 2, 3, 4, 5, 6, 7); } } while (0)
#define PG8_LDB(dst, b, h) do { _Pragma("unroll") for (int n = 0; n < 2; ++n) { const v4i l_ = *(const PG8_LAS v4i*)(lds + PG8_SB(b, h) + boff0 + n * 2048), h_ = *(const PG8_LAS v4i*)(lds + PG8_SB(b, h) + boff1 + n * 2048); dst[n] = __builtin_shufflevector(l_, h_, 0, 1, 2, 3, 4, 5, 6, 7); } } while (0)
#define PG8_LO(v) __builtin_bit_cast(bf16x8, __builtin_shufflevector(v, v, 0, 1, 2, 3))
#define PG8_HI(v) __builtin_bit_cast(bf16x8, __builtin_shufflevector(v, v, 4, 5, 6, 7))
#define PG8_MMA(ai, bj, At, Bt) do { __builtin_amdgcn_s_setprio(1); _Pragma("unroll") for (int m = 0; m < 4; ++m) _Pragma("unroll") for (int n = 0; n < 2; ++n) { \
        if constexpr (EB == 2) { acc[ai][bj][m][n] = __builtin_amdgcn_mfma_f32_16x16x32_bf16(PG8_LO(Bt[n]), PG8_LO(At[m]), acc[ai][bj][m][n], 0, 0, 0); \
                                 acc[ai][bj][m][n] = __builtin_amdgcn_mfma_f32_16x16x32_bf16(PG8_HI(Bt[n]), PG8_HI(At[m]), acc[ai][bj][m][n], 0, 0, 0); } \
        else asm volatile("v_mfma_f32_16x16x128_f8f6f4 %0, %1, %2, %0" : "+v"(acc[ai][bj][m][n]) : "v"(Bt[n]), "v"(At[m])); } __builtin_amdgcn_s_setprio(0); } while (0)
#define PG8_WAIT_V(n) asm volatile("s_waitcnt vmcnt(" #n ")" ::: "memory")
#define PG8_WAIT_L(n) asm volatile("s_waitcnt lgkmcnt(" #n ")" ::: "memory")
#define PG8_BAR __builtin_amdgcn_s_barrier()
#define PG8_SCHED __builtin_amdgcn_sched_barrier(0)
    Unit cur, nxt; int ui = 0;
    if (!S.next(0, cur)) return;
    f32x4 acc[2][2][4][2];
#pragma unroll
    for (int a = 0; a < 2; ++a)
#pragma unroll
        for (int b = 0; b < 2; ++b)
#pragma unroll
            for (int m = 0; m < 4; ++m)
#pragma unroll
                for (int n = 0; n < 2; ++n) acc[a][b][m][n] = (f32x4){0.f, 0.f, 0.f, 0.f};
    v8i At[4], B0[2], B1[2];
    const char* cA = (const char*)g.A + (size_t)cur.pm * tstepA + (size_t)(cur.pn >> GemmT::akshift) * akb; const char* cB = (const char*)g.Bt + (size_t)cur.pn * tstepB;
    PG8_STAGE(PG8_SB(0, 0), cB, voffB); PG8_STAGE(PG8_SB(0, 1), cB + hstepB, voffB); PG8_STAGE(PG8_SA(0, 0), cA, voffA); PG8_STAGE(PG8_SA(0, 1), cA + hstepA, voffA);
    if (wr == 1) PG8_BAR;
    PG8_WAIT_V(2); PG8_BAR;
    PG8_STAGE(PG8_SB(1, 0), cB + kstep, voffB); PG8_STAGE(PG8_SA(1, 0), cA + kstep, voffA); PG8_STAGE(PG8_SB(1, 1), cB + hstepB + kstep, voffB);
    PG8_WAIT_V(6); PG8_BAR;
    for (;;) {
        const bool has_next = S.next(ui + 1, nxt);
        const char* nA = has_next ? (const char*)g.A + (size_t)nxt.pm * tstepA + (size_t)(nxt.pn >> GemmT::akshift) * akb : cA; const char* nB = has_next ? (const char*)g.Bt + (size_t)nxt.pn * tstepB : cB;
#pragma unroll 1
        for (int t = 0; t < nt; t += 2) {
            const bool last = (t == nt - 2);
            const char* a1 = cA + (size_t)(t + 1) * kstep;
            const char* a2 = last ? nA : cA + (size_t)(t + 2) * kstep; const char* b2 = last ? nB : cB + (size_t)(t + 2) * kstep;
            const char* a3 = a2 + kstep; const char* b3 = b2 + kstep;
            PG8_LDB(B0, 0, 0); PG8_LDB(B1, 0, 1); PG8_SCHED; PG8_LDA(At, 0, 0); PG8_STAGE(PG8_SA(1, 1), a1 + hstepA, voffA);
            PG8_WAIT_V(8); PG8_WAIT_L(0); PG8_BAR; PG8_MMA(0, 0, At, B0); PG8_MMA(0, 1, At, B1); PG8_BAR; PG8_SCHED;
            PG8_LDA(At, 0, 1); PG8_STAGE(PG8_SB(0, 0), b2, voffB); PG8_STAGE(PG8_SB(0, 1), b2 + hstepB, voffB); PG8_STAGE(PG8_SA(0, 0), a2, voffA);
            PG8_WAIT_V(8); PG8_WAIT_L(0); PG8_BAR; PG8_MMA(1, 0, At, B0); PG8_MMA(1, 1, At, B1); PG8_BAR; PG8_SCHED;
            PG8_LDB(B0, 1, 0); PG8_LDB(B1, 1, 1); PG8_SCHED; PG8_LDA(At, 1, 0); PG8_STAGE(PG8_SA(0, 1), a2 + hstepA, voffA);
            PG8_WAIT_V(8); PG8_WAIT_L(0); PG8_BAR; PG8_MMA(0, 0, At, B0); PG8_MMA(0, 1, At, B1); PG8_BAR; PG8_SCHED;
            PG8_LDA(At, 1, 1); PG8_STAGE(PG8_SB(1, 0), b3, voffB); PG8_STAGE(PG8_SB(1, 1), b3 + hstepB, voffB); PG8_STAGE(PG8_SA(1, 0), a3, voffA);
            PG8_WAIT_V(8); PG8_WAIT_L(0); PG8_BAR; PG8_MMA(1, 0, At, B0); PG8_MMA(1, 1, At, B1); PG8_BAR; PG8_SCHED;
        }
        if (wr == 0) PG8_BAR;
        if constexpr (EB == 1) asm volatile("s_nop 15\n\ts_nop 15" ::: "memory");
        E(acc, cur, wr, wc, fr, fq);
        if (!has_next) break;
#pragma unroll
        for (int a = 0; a < 2; ++a)
#pragma unroll
            for (int b = 0; b < 2; ++b)
#pragma unroll
                for (int m = 0; m < 4; ++m)
#pragma unroll
                    for (int n = 0; n < 2; ++n) acc[a][b][m][n] = (f32x4){0.f, 0.f, 0.f, 0.f};
        cur = nxt; cA = nA; cB = nB; ++ui;
        if (wr == 1) PG8_BAR;
    }
    PG8_WAIT_V(0);
    PG8_BAR;
}
template <class GP, class GM, class Mid, class Epi, class Sched>
__device__ __forceinline__ void gemm_chain(PG8_LAS unsigned char* lds, const GP gp, const GM gm, const Sched& S, const Mid& M, const Epi& E) {
    static_assert(GP::EB == 2 && GM::EB == 1 && GP::lda * 2 == GM::lda, "chain: bf16 prefix, fp8 main, equal A row strides in bytes");
    int tid_ = threadIdx.x; asm volatile("" : "+v"(tid_));
    const int tid = tid_, wid = __builtin_amdgcn_readfirstlane(tid >> 6), lane = tid & 63, wr = wid >> 2, wc = wid & 3, fr = lane & 15, fq = lane >> 4;
    constexpr int ntp = GP::K * 2 / 128, ntm = GM::K / 128;
    static_assert(ntp == 4 && ntm % 2 == 0, "chain: prefix of two trips");
    typedef int v8i __attribute__((ext_vector_type(8))); typedef int v4i __attribute__((ext_vector_type(4)));
    unsigned voffA[2], voffBp[2], voffBm[2];
#pragma unroll
    for (int i = 0; i < 2; ++i) { int R, C; stage_rc(tid * 16 + i * 8192, R, C); const int Rb = (R & ~31) + perm32(R & 31);
        voffA[i] = (unsigned)(R * GM::lda + C * 2); voffBp[i] = (unsigned)(Rb * GP::ldb * 2 + C * 2); voffBm[i] = (unsigned)(Rb * GM::ldb + C * 2); }
    constexpr size_t kstep = (size_t)(BK * 2);
    constexpr size_t hstepA = (size_t)HALF * GM::lda, hstepBp = (size_t)HALF * GP::ldb * 2, hstepBm = (size_t)HALF * GM::ldb;
    constexpr size_t tstepA = 2 * hstepA, tstepBp = 2 * hstepBp, tstepBm = 2 * hstepBm;
    constexpr size_t akbp = (size_t)GP::akstep * 2;
    const unsigned ldsw = (unsigned)wid * 1024u;
#define PC_OFFS_P() int lq_ = tid; asm volatile("" : "+v"(lq_)); const int frq_ = lq_ & 15, fqq_ = (lq_ >> 4) & 3; \
    const int aoffP0 = lds_byte(wr * 64 + frq_, fqq_ * 8), boffP0 = lds_byte(wc * 32 + frq_, fqq_ * 8), aoffP1 = aoffP0 + 1024, boffP1 = boffP0 + 1024
#define PC_OFFS_M() int lm_ = tid; asm volatile("" : "+v"(lm_)); const int frm_ = lm_ & 15, fqm_ = (lm_ >> 4) & 3; \
    const int aoffM0 = lds_byte(wr * 64 + frm_, fqm_ * 16) + 16 * (fqm_ & 1), boffM0 = lds_byte(wc * 32 + frm_, fqm_ * 16) + 16 * (fqm_ & 1), aoffM1 = aoffM0 ^ 16, boffM1 = boffM0 ^ 16
#define PC_LDA(dst, b, h, o0, o1) do { _Pragma("unroll") for (int m = 0; m < 4; ++m) { const v4i l_ = *(const PG8_LAS v4i*)(lds + PG8_SA(b, h) + (o0) + m * 2048), h_ = *(const PG8_LAS v4i*)(lds + PG8_SA(b, h) + (o1) + m * 2048); dst[m] = __builtin_shufflevector(l_, h_, 0, 1, 2, 3, 4, 5, 6, 7); } } while (0)
#define PC_LDB(dst, b, h, o0, o1) do { _Pragma("unroll") for (int n = 0; n < 2; ++n) { const v4i l_ = *(const PG8_LAS v4i*)(lds + PG8_SB(b, h) + (o0) + n * 2048), h_ = *(const PG8_LAS v4i*)(lds + PG8_SB(b, h) + (o1) + n * 2048); dst[n] = __builtin_shufflevector(l_, h_, 0, 1, 2, 3, 4, 5, 6, 7); } } while (0)
#define PC_MMA(EBv, ai, bj, At, Bt) do { __builtin_amdgcn_s_setprio(1); _Pragma("unroll") for (int m = 0; m < 4; ++m) _Pragma("unroll") for (int n = 0; n < 2; ++n) { \
        if constexpr (EBv == 2) { acc[ai][bj][m][n] = __builtin_amdgcn_mfma_f32_16x16x32_bf16(PG8_LO(Bt[n]), PG8_LO(At[m]), acc[ai][bj][m][n], 0, 0, 0); \
                                  acc[ai][bj][m][n] = __builtin_amdgcn_mfma_f32_16x16x32_bf16(PG8_HI(Bt[n]), PG8_HI(At[m]), acc[ai][bj][m][n], 0, 0, 0); } \
        else asm volatile("v_mfma_f32_16x16x128_f8f6f4 %0, %1, %2, %0" : "+v"(acc[ai][bj][m][n]) : "v"(Bt[n]), "v"(At[m])); } __builtin_amdgcn_s_setprio(0); } while (0)
#define PC_TRIP(EBv, A0, A1, B0o, B1o, a1_, a2_, b2_, voffBn, hstepBn) do { const char* a3_ = (a2_) + kstep; const char* b3_ = (b2_) + kstep; \
        PC_LDB(B0, 0, 0, B0o, B1o); PC_LDB(B1, 0, 1, B0o, B1o); PG8_SCHED; PC_LDA(At, 0, 0, A0, A1); PG8_STAGE(PG8_SA(1, 1), (a1_) + hstepA, voffA); \
        PG8_WAIT_V(8); PG8_WAIT_L(0); PG8_BAR; PC_MMA(EBv, 0, 0, At, B0); PC_MMA(EBv, 0, 1, At, B1); PG8_BAR; PG8_SCHED; \
        PC_LDA(At, 0, 1, A0, A1); PG8_STAGE(PG8_SB(0, 0), (b2_), voffBn); PG8_STAGE(PG8_SB(0, 1), (b2_) + (hstepBn), voffBn); PG8_STAGE(PG8_SA(0, 0), (a2_), voffA); \
        PG8_WAIT_V(8); PG8_WAIT_L(0); PG8_BAR; PC_MMA(EBv, 1, 0, At, B0); PC_MMA(EBv, 1, 1, At, B1); PG8_BAR; PG8_SCHED; \
        PC_LDB(B0, 1, 0, B0o, B1o); PC_LDB(B1, 1, 1, B0o, B1o); PG8_SCHED; PC_LDA(At, 1, 0, A0, A1); PG8_STAGE(PG8_SA(0, 1), (a2_) + hstepA, voffA); \
        PG8_WAIT_V(8); PG8_WAIT_L(0); PG8_BAR; PC_MMA(EBv, 0, 0, At, B0); PC_MMA(EBv, 0, 1, At, B1); PG8_BAR; PG8_SCHED; \
        PC_LDA(At, 1, 1, A0, A1); PG8_STAGE(PG8_SB(1, 0), b3_, voffBn); PG8_STAGE(PG8_SB(1, 1), b3_ + (hstepBn), voffBn); PG8_STAGE(PG8_SA(1, 0), a3_, voffA); \
        PG8_WAIT_V(8); PG8_WAIT_L(0); PG8_BAR; PC_MMA(EBv, 1, 0, At, B0); PC_MMA(EBv, 1, 1, At, B1); PG8_BAR; PG8_SCHED; } while (0)
    Unit cur, nxt; int ui = 0;
    if (!S.next(0, cur)) return;
    f32x4 acc[2][2][4][2];
#pragma unroll
    for (int a = 0; a < 2; ++a)
#pragma unroll
        for (int b = 0; b < 2; ++b)
#pragma unroll
            for (int m = 0; m < 4; ++m)
#pragma unroll
                for (int n = 0; n < 2; ++n) acc[a][b][m][n] = (f32x4){0.f, 0.f, 0.f, 0.f};
    v8i At[4], B0[2], B1[2];
    const char* cAp = (const char*)gp.A + (size_t)cur.pm * tstepA + (size_t)(cur.pn >> GP::akshift) * akbp; const char* cBp = (const char*)gp.Bt + (size_t)cur.pn * tstepBp;
    PG8_STAGE(PG8_SB(0, 0), cBp, voffBp); PG8_STAGE(PG8_SB(0, 1), cBp + hstepBp, voffBp); PG8_STAGE(PG8_SA(0, 0), cAp, voffA); PG8_STAGE(PG8_SA(0, 1), cAp + hstepA, voffA);
    if (wr == 1) PG8_BAR;
    PG8_WAIT_V(2); PG8_BAR;
    PG8_STAGE(PG8_SB(1, 0), cBp + kstep, voffBp); PG8_STAGE(PG8_SA(1, 0), cAp + kstep, voffA); PG8_STAGE(PG8_SB(1, 1), cBp + hstepBp + kstep, voffBp);
    PG8_WAIT_V(6); PG8_BAR;
    for (;;) {
        const bool has_next = S.next(ui + 1, nxt);
        const char* nAp = has_next ? (const char*)gp.A + (size_t)nxt.pm * tstepA + (size_t)(nxt.pn >> GP::akshift) * akbp : cAp; const char* nBp = has_next ? (const char*)gp.Bt + (size_t)nxt.pn * tstepBp : cBp;
        const char* cAm = (const char*)gm.A + (size_t)cur.pm * tstepA; const char* cBm = (const char*)gm.Bt + (size_t)cur.pn * tstepBm;
        {   PC_OFFS_P();
#pragma unroll 1
            for (int t = 0; t < ntp; t += 2) {
                const bool last = (t == ntp - 2);
                unsigned voffBn[2]; voffBn[0] = last ? voffBm[0] : voffBp[0]; voffBn[1] = last ? voffBm[1] : voffBp[1];
                const size_t hstepBn = last ? hstepBm : hstepBp;
                const char* a2 = last ? cAm : cAp + (size_t)(t + 2) * kstep; const char* b2 = last ? cBm : cBp + (size_t)(t + 2) * kstep;
                PC_TRIP(2, aoffP0, aoffP1, boffP0, boffP1, cAp + (size_t)(t + 1) * kstep, a2, b2, voffBn, hstepBn);
            } }
        M(acc, cur, wr, wc, fr, fq);
        PC_OFFS_M();
#pragma unroll 1
        for (int t = 0; t < ntm; t += 2) {
            const bool last = (t == ntm - 2);
            unsigned voffBn[2]; voffBn[0] = last ? voffBp[0] : voffBm[0]; voffBn[1] = last ? voffBp[1] : voffBm[1];
            const size_t hstepBn = last ? hstepBp : hstepBm;
            const char* a2 = last ? nAp : cAm + (size_t)(t + 2) * kstep; const char* b2 = last ? nBp : cBm + (size_t)(t + 2) * kstep;
            PC_TRIP(1, aoffM0, aoffM1, boffM0, boffM1, cAm + (size_t)(t + 1) * kstep, a2, b2, voffBn, hstepBn);
        }
        if (wr == 0) PG8_BAR;
        asm volatile("s_nop 15\n\ts_nop 15" ::: "memory");
        {   Unit cue = cur; asm volatile("" : "+s"(cue.pm), "+s"(cue.pn));
            E(acc, cue, wr, wc, fr, fq); }
        if (!has_next) break;
#pragma unroll
        for (int a = 0; a < 2; ++a)
#pragma unroll
            for (int b = 0; b < 2; ++b)
#pragma unroll
                for (int m = 0; m < 4; ++m)
#pragma unroll
                    for (int n = 0; n < 2; ++n) acc[a][b][m][n] = (f32x4){0.f, 0.f, 0.f, 0.f};
        cur = nxt; cAp = nAp; cBp = nBp; ++ui;
        if (wr == 1) PG8_BAR;
    }
    PG8_WAIT_V(0);
    PG8_BAR;
#undef PC_LDA
#undef PC_LDB
#undef PC_MMA
#undef PC_TRIP
#undef PC_OFFS_P
#undef PC_OFFS_M
}
template <class GemmT, class Epi>
__device__ __forceinline__ void gemm_quarter(PG8_LAS unsigned char* lds, const GemmT g, int qm, int qn, const Epi& E) {
    int tid_ = threadIdx.x; asm volatile("" : "+v"(tid_));
    const int tid = tid_, wid = __builtin_amdgcn_readfirstlane(tid >> 6), lane = tid & 63, wr = wid >> 2, wc = wid & 3, fr = lane & 15, fq = lane >> 4;
    constexpr int K = GemmT::K, EB = GemmT::EB, nt = K * EB / 128;
    static_assert(nt % 4 == 0 && nt >= 4, "quarter unit: K-tiles in groups of four");
    typedef int v8i __attribute__((ext_vector_type(8))); typedef int v4i __attribute__((ext_vector_type(4)));
    unsigned voffA[2], voffB[2];
#pragma unroll
    for (int i = 0; i < 2; ++i) { int R, C; stage_rc(tid * 16 + i * 8192, R, C); const int Rb = Epi::PERM ? ((R & ~31) + perm32(R & 31)) : R;
        voffA[i] = (unsigned)(R * GemmT::lda * EB + C * 2); voffB[i] = (unsigned)(Rb * GemmT::ldb * EB + C * 2); }
    constexpr size_t kstep = (size_t)(BK * 2);
    constexpr size_t hstepA = (size_t)HALF * GemmT::lda * EB, hstepB = (size_t)HALF * GemmT::ldb * EB;
    const unsigned ldsw = (unsigned)wid * 1024u;
    const int aoff0 = lds_byte(wr * 64 + fr, EB == 2 ? fq * 8 : fq * 16) + (EB == 2 ? 0 : 16 * (fq & 1)), boff0 = lds_byte(wc * 32 + fr, EB == 2 ? fq * 8 : fq * 16) + (EB == 2 ? 0 : 16 * (fq & 1));
    const int aoff1 = EB == 2 ? aoff0 + 1024 : (aoff0 ^ 16), boff1 = EB == 2 ? boff0 + 1024 : (boff0 ^ 16);
    const char* cA = (const char*)g.A + (size_t)qm * hstepA + (size_t)((qn >> 1) >> GemmT::akshift) * GemmT::akstep * EB; const char* cB = (const char*)g.Bt + (size_t)qn * hstepB;
    f32x4 acc[1][1][4][2];
#pragma unroll
    for (int m = 0; m < 4; ++m)
#pragma unroll
        for (int n = 0; n < 2; ++n) acc[0][0][m][n] = (f32x4){0.f, 0.f, 0.f, 0.f};
    v8i At[4], B0[2];
#define PG8Q_LDA(dst, s) do { _Pragma("unroll") for (int m = 0; m < 4; ++m) { const v4i l_ = *(const PG8_LAS v4i*)(lds + (s) * HTB + aoff0 + m * 2048), h_ = *(const PG8_LAS v4i*)(lds + (s) * HTB + aoff1 + m * 2048); dst[m] = __builtin_shufflevector(l_, h_, 0, 1, 2, 3, 4, 5, 6, 7); } } while (0)
#define PG8Q_LDB(dst, s) do { _Pragma("unroll") for (int n = 0; n < 2; ++n) { const v4i l_ = *(const PG8_LAS v4i*)(lds + (4 + (s)) * HTB + boff0 + n * 2048), h_ = *(const PG8_LAS v4i*)(lds + (4 + (s)) * HTB + boff1 + n * 2048); dst[n] = __builtin_shufflevector(l_, h_, 0, 1, 2, 3, 4, 5, 6, 7); } } while (0)
#pragma unroll
    for (int s = 0; s < 3; ++s) { PG8_STAGE(s * HTB, cA + (size_t)s * kstep, voffA); PG8_STAGE((4 + s) * HTB, cB + (size_t)s * kstep, voffB); }
#pragma unroll 1
    for (int t = 0; t < nt; t += 4) {
#pragma unroll
        for (int s = 0; s < 4; ++s) {
            PG8_WAIT_V(8); PG8_BAR;
            const int nx = (t + s + 3 < nt) ? (t + s + 3) : (nt - 1);
            PG8_STAGE(((s + 3) & 3) * HTB, cA + (size_t)nx * kstep, voffA); PG8_STAGE((4 + ((s + 3) & 3)) * HTB, cB + (size_t)nx * kstep, voffB);
            PG8Q_LDB(B0, s); PG8Q_LDA(At, s);
            PG8_WAIT_L(0); PG8_SCHED; PG8_MMA(0, 0, At, B0); PG8_SCHED;
        }
    }
    if constexpr (EB == 1) asm volatile("s_nop 15\n\ts_nop 15" ::: "memory");
    E.quarter(acc, qm * HALF, qn * HALF, wr, wc, fr, fq);
    PG8_WAIT_V(0);
    PG8_BAR;
#undef PG8Q_LDA
#undef PG8Q_LDB
#undef PG8_SA
#undef PG8_SB
#undef PG8_STAGE
#undef PG8_LDA
#undef PG8_LDB
#undef PG8_MMA
#undef PG8_LO
#undef PG8_HI
#undef PG8_WAIT_V
#undef PG8_WAIT_L
#undef PG8_BAR
#undef PG8_SCHED
}
}

constexpr int DM = 2048, NB = 8, SEQ = 2048, CTXL = 256, NLAYER = 2;
constexpr int TL = NB * SEQ, TC = NB * CTXL, TT = TL + TC;
constexpr int INW = 8192, KVOFF = 2048, VOFF = 2560, POOLOFF = 3072, GAOFF = 4096, GBOFF = 6144;
constexpr int NEXP = 16384, NSEL = 128;
constexpr float EPS = 1e-6f;
constexpr int NWAVES = 8;

constexpr size_t MiB = 1u << 20;
constexpr size_t WS_CTL = 0, CTL_ZERO_BYTES = 1 * MiB;
constexpr size_t WS_MOD = 1 * MiB;
constexpr size_t WS_MODP = 2 * MiB;
constexpr size_t WS_ROPE = 9 * MiB;
constexpr size_t WS_WIN = 10 * MiB;
constexpr size_t WS_WOUT = 90 * MiB;
constexpr size_t WS_WQP = 106 * MiB;
constexpr size_t WS_WPOOL = 122 * MiB;
constexpr size_t WS_KEYS = 124 * MiB;
constexpr size_t WS_PU = 126 * MiB;
constexpr size_t WS_PV = 190 * MiB;
constexpr size_t WS_SCU = 254 * MiB;
constexpr size_t WS_SCV = 255 * MiB;
constexpr size_t WS_X = 382 * MiB;
constexpr size_t WS_H = 526 * MiB;
constexpr size_t WS_P = 598 * MiB;
constexpr size_t WS_AO = 886 * MiB;
constexpr size_t WS_H8 = 922 * MiB;
constexpr size_t WS_WIN8 = WS_PU + 16 * MiB;
constexpr size_t WS_WBR8 = WS_PV + 16 * MiB;
constexpr size_t WS_POOLED = 958 * MiB;
constexpr size_t WS_YB = 994 * MiB;
constexpr size_t WS_END = 1066 * MiB;
constexpr size_t P_QP = 0, P_IDX = 216 * MiB, P_GW = 225 * MiB;

constexpr int CW_TMO = 0;
constexpr int CW_BAR = 4096;

constexpr int RING_BYTES = 131072;
constexpr int LDSCTL_OFF = RING_BYTES, MISC_OFF = LDSCTL_OFF + 320;
constexpr int LDS_BYTES = 147456;

#define GAS __attribute__((address_space(1)))
#define LAS __attribute__((address_space(3)))
typedef unsigned short bf16;
typedef unsigned v4u __attribute__((ext_vector_type(4)));
typedef unsigned v2u __attribute__((ext_vector_type(2)));
typedef float f32x4 __attribute__((ext_vector_type(4)));
typedef short bf16x8 __attribute__((ext_vector_type(8)));
typedef GAS unsigned gu32;
#define RLX_AGENT __ATOMIC_RELAXED, __HIP_MEMORY_SCOPE_AGENT
#define LDS_WAIT() asm volatile("s_waitcnt lgkmcnt(0)" ::: "memory")
#define VM_WAIT() asm volatile("s_waitcnt vmcnt(0)" ::: "memory")
__device__ __forceinline__ unsigned f2bf(float f) { unsigned u = __builtin_bit_cast(unsigned, f); return (u + 0x7fffu + ((u >> 16) & 1u)) >> 16; }
__device__ __forceinline__ unsigned pk2(float lo, float hi) { unsigned r; asm("v_cvt_pk_bf16_f32 %0, %1, %2" : "=v"(r) : "v"(lo), "v"(hi)); return r; }
__device__ __forceinline__ float bflo(unsigned w) { return __builtin_bit_cast(float, w << 16); }
__device__ __forceinline__ float bfhi(unsigned w) { return __builtin_bit_cast(float, w & 0xffff0000u); }
__device__ __forceinline__ float sigmoidf_(float x) { return __builtin_amdgcn_rcpf(1.0f + __expf(-x)); }
__device__ __forceinline__ float wave_sum(float v) {
#pragma unroll
    for (int o = 1; o < 64; o <<= 1) v += __shfl_xor(v, o);
    return v;
}
__device__ __forceinline__ float wave_max(float v) {
#pragma unroll
    for (int o = 1; o < 64; o <<= 1) v = fmaxf(v, __shfl_xor(v, o));
    return v;
}

#define XB_TMO      128
#define XB_XCNT(j)  (256  + 64 * (j))
#define XB_XSUB(j)  (1280 + 64 * (j))
#define XB_XGEN(j)  (2304 + 64 * (j))
#define XB_TOP      3328
#define XB_TOPGEN   3392
#define XCD_BAR_WORDS 3456
#define XB_SPIN_CAP (1u << 18)
__device__ __forceinline__ unsigned xb_ld(unsigned* p)              { return __hip_atomic_load(p, __ATOMIC_RELAXED, __HIP_MEMORY_SCOPE_AGENT); }
__device__ __forceinline__ unsigned xb_add(unsigned* p, unsigned v) { return __hip_atomic_fetch_add(p, v, __ATOMIC_RELAXED, __HIP_MEMORY_SCOPE_AGENT); }
__device__ __forceinline__ unsigned xb_xcc_id() { return (unsigned)__builtin_amdgcn_s_getreg((3 << 11) | 20) & 0xFu; }
#define XB_SPIN(cond, bar) do { unsigned _sp = 0; while (cond) { __builtin_amdgcn_s_sleep(1); \
    if ((++_sp & 255u) == 0u) { if (xb_ld(&(bar)[XB_TMO])) break; if (_sp > XB_SPIN_CAP) { atomicAdd(&(bar)[XB_TMO], 1u); break; } } } } while (0)
struct XcdBarrier { unsigned* bar; unsigned x; volatile LAS unsigned* st; };
__device__ __forceinline__ XcdBarrier xcd_barrier_post(unsigned* bar, volatile LAS unsigned* st) {
    XcdBarrier b; b.bar = bar; b.x = xb_xcc_id(); b.st = st;
    if (threadIdx.x == 0) (void)xb_add(&bar[XB_XCNT(b.x)], 1u);
    return b;
}
__device__ __forceinline__ void xcd_barrier_complete(unsigned* bar, unsigned x, unsigned& nloc, unsigned& nx) {
    const unsigned G = gridDim.x * gridDim.y * gridDim.z;
    unsigned sum, cnt, mine, sp = 0u;
    for (;;) {
        sum = 0u; cnt = 0u; mine = 0u;
#pragma unroll 1
        for (unsigned j = 0; j < 16; ++j) { const unsigned c = xb_ld(&bar[XB_XCNT(j)]); sum += c; cnt += (c > 0u) ? 1u : 0u; mine = (j == x) ? c : mine; }
        if (sum == G) break;
        __builtin_amdgcn_s_sleep(1);
        if ((++sp & 255u) == 0u) { if (xb_ld(&bar[XB_TMO])) break; if (sp > XB_SPIN_CAP) { atomicAdd(&bar[XB_TMO], 1u); break; } }
    }
    nloc = mine > 0u ? mine : 1u; nx = cnt > 0u ? cnt : 1u;
}
__device__ __forceinline__ void xcd_barrier(const XcdBarrier& b) {
    asm volatile("s_waitcnt vmcnt(0)" ::: "memory");
    __syncthreads();
    if (threadIdx.x == 0) {
        unsigned* bar = b.bar;
        asm volatile("" : "+s"(bar));
        __builtin_amdgcn_s_waitcnt(0);
        unsigned nloc = b.st[0], nx = b.st[1];
        if (nloc == 0u) { xcd_barrier_complete(bar, b.x, nloc, nx); b.st[0] = nloc; b.st[1] = nx; }
        const unsigned old = xb_add(&bar[XB_XSUB(b.x)], 1u);
        const unsigned gen = old / nloc;
        if (old + 1u == (gen + 1u) * nloc) {
            __builtin_amdgcn_fence(__ATOMIC_RELEASE, "agent");
            asm volatile("s_waitcnt vmcnt(0)" ::: "memory");
            const unsigned og = xb_add(&bar[XB_TOP], 1u);
            const unsigned tg = og / nx;
            if (og + 1u == (tg + 1u) * nx) xb_add(&bar[XB_TOPGEN], 1u);
            else XB_SPIN(xb_ld(&bar[XB_TOPGEN]) == tg, bar);
            __builtin_amdgcn_fence(__ATOMIC_ACQUIRE, "agent");
            xb_add(&bar[XB_XGEN(b.x)], 1u);
            asm volatile("s_waitcnt vmcnt(0)" ::: "memory");
        } else {
            XB_SPIN(xb_ld(&bar[XB_XGEN(b.x)]) == gen, bar);
            __builtin_amdgcn_fence(__ATOMIC_ACQUIRE, "agent");
            asm volatile("s_waitcnt vmcnt(0)" ::: "memory");
        }
    }
    __syncthreads();
}

struct Frame {
    LAS unsigned char* lds;
    int tid, lane, wave, vcu, G, bx;
    unsigned char* ws;
};
__device__ __forceinline__ Frame mkframe(unsigned char* lds_generic, unsigned char* ws) {
    Frame F; int t = threadIdx.x; asm volatile("" : "+v"(t)); asm volatile("" : "+s"(ws));
    F.lds = (LAS unsigned char*)lds_generic; F.tid = t; F.lane = t & 63; F.wave = __builtin_amdgcn_readfirstlane(t >> 6);
    { int bx = blockIdx.x, G = gridDim.x; asm volatile("" : "+s"(bx), "+s"(G));
      F.bx = bx; F.G = G; F.vcu = (G % 8 == 0) ? (bx % 8) * (G / 8) + bx / 8 : bx; }
    F.ws = ws; return F;
}
enum { I_X = 0, I_C, I_CTX, I_CCTX, I_WADA, I_BADA, I_WIN, I_QG, I_KG, I_WBR, I_WPOOL, I_PSCALE, I_WOUT, I_WQP, I_KEYS, I_PU, I_PV, I_FG, I_OUT };
template <int I> __device__ __forceinline__ const float* inp() {
    const float* p;
    asm volatile("s_load_dwordx2 %0, %1, %2\n\ts_waitcnt lgkmcnt(0)" : "=s"(p) : "s"(__builtin_amdgcn_kernarg_segment_ptr()), "i"(8 * I) : "memory");
    return p;
}
__device__ __forceinline__ const float* mod_ptr(const Frame& F, int layer, int row) {
    const int mr = row < TL ? (row >> 11) : 8;
    return (const float*)(F.ws + WS_MOD) + ((size_t)layer * 9 + mr) * (6 * DM);
}

__device__ __forceinline__ float clamp_fp8(float v) { return __builtin_amdgcn_fmed3f(v, -448.0f, 448.0f); }
__device__ __forceinline__ unsigned pk4_fp8(float a, float b, float c, float d) { int p = __builtin_amdgcn_cvt_pk_fp8_f32(clamp_fp8(a), clamp_fp8(b), 0, false); p = __builtin_amdgcn_cvt_pk_fp8_f32(clamp_fp8(c), clamp_fp8(d), p, true); return (unsigned)p; }
constexpr float W8_SCALE = 64.0f;
__device__ __forceinline__ void p0_transpose_item(const float* W, int K, int N, bf16* WT, unsigned char* WT8, int row_off, LAS float* scr, int item, int lane) {
    const int nblk = N / 64, kb = item / nblk, nb = item % nblk, k0 = 64 * kb, n0 = 64 * nb;
    const int n4 = (lane & 15) * 4, kr = lane >> 4;
#pragma unroll
    for (int i = 0; i < 16; ++i) { const int kk = kr + 4 * i;
        const f32x4 v = *(const GAS f32x4*)(W + (size_t)(k0 + kk) * N + n0 + n4);
        *(LAS f32x4*)(scr + kk * 64 + (n4 ^ ((kk >> 3) << 3))) = v; }
    LDS_WAIT(); asm volatile("" ::: "memory");
    const int c = lane & 7, nn = lane >> 3;
#pragma unroll
    for (int j = 0; j < 8; ++j) { const int n = nn + 8 * j; const LAS float* sp = scr + (8 * c) * 64 + (n ^ (c << 3));
        const float x0 = sp[0 * 64], x1 = sp[1 * 64], x2 = sp[2 * 64], x3 = sp[3 * 64], x4 = sp[4 * 64], x5 = sp[5 * 64], x6 = sp[6 * 64], x7 = sp[7 * 64];
        if (WT) { v4u o; o.x = pk2(x0, x1); o.y = pk2(x2, x3); o.z = pk2(x4, x5); o.w = pk2(x6, x7); *(GAS v4u*)(WT + (size_t)(row_off + n0 + n) * K + k0 + 8 * c) = o; }
        if (WT8) { v2u o; o.x = pk4_fp8(x0 * W8_SCALE, x1 * W8_SCALE, x2 * W8_SCALE, x3 * W8_SCALE); o.y = pk4_fp8(x4 * W8_SCALE, x5 * W8_SCALE, x6 * W8_SCALE, x7 * W8_SCALE);
            *(GAS v2u*)(WT8 + (size_t)(row_off + n0 + n) * K + k0 + 8 * c) = o; } }
    LDS_WAIT(); asm volatile("" ::: "memory");
}
__device__ __forceinline__ void cvt8(const float* src, bf16* dst) {
    const f32x4 a = *(const GAS f32x4*)src, b = *(const GAS f32x4*)(src + 4);
    v4u o; o.x = pk2(a.x, a.y); o.y = pk2(a.z, a.w); o.z = pk2(b.x, b.y); o.w = pk2(b.z, b.w);
    *(GAS v4u*)dst = o;
}
__device__ __forceinline__ void phase_prologue(Frame& F) {
    {
        LAS float* S = (LAS float*)F.lds;
        LAS float* red = (LAS float*)(F.lds + 16384);
        float* modp = (float*)(F.ws + WS_MODP);
        for (int u = F.bx; u < 96 * 8; u += F.G) {
            const int cb = u >> 3, kc = u & 7, layer = cb / 48, col0 = (cb % 48) * 256, kbase = kc * 256;
            for (int e = F.tid; e < 9 * 256; e += 512) { const int r = e >> 8, kk = e & 255;
                const float v = r < 8 ? inp<I_C>()[(size_t)r * DM + kbase + kk] : inp<I_CCTX>()[kbase + kk];
                S[e] = v / (1.0f + __expf(-v)); }
            __syncthreads();
            f32x4 acc[9];
#pragma unroll
            for (int r = 0; r < 9; ++r) acc[r] = (f32x4){0.f, 0.f, 0.f, 0.f};
            const float* wp = inp<I_WADA>() + ((size_t)layer * DM + kbase + F.wave * 32) * (6 * DM) + col0 + F.lane * 4;
#pragma unroll 8
            for (int kk = 0; kk < 32; ++kk) {
                const f32x4 w = *(const GAS f32x4*)(wp + (size_t)kk * (6 * DM));
#pragma unroll
                for (int r = 0; r < 9; ++r) { const float s = S[r * 256 + F.wave * 32 + kk]; acc[r] += w * s; }
            }
#pragma unroll
            for (int r = 0; r < 9; ++r) *(LAS f32x4*)(red + (F.wave * 9 + r) * 256 + F.lane * 4) = acc[r];
            __syncthreads();
            for (int e = F.tid; e < 9 * 256; e += 512) { const int r = e >> 8, cc = e & 255; float s = 0.f;
#pragma unroll
                for (int w = 0; w < 8; ++w) s += red[(w * 9 + r) * 256 + cc];
                modp[(((size_t)kc * 2 + layer) * 9 + r) * (6 * DM) + col0 + cc] = s; }
            __syncthreads();
        }
    }
    if (F.bx == F.G - 1) {
        float* rope = (float*)(F.ws + WS_ROPE);
        for (int e = F.tid; e < 64 * 32; e += 512) { const int pos = e >> 5, f = e & 31;
            const float inv = powf(10000.0f, -(float)f / 32.0f); const float ang = (float)pos * inv;
            rope[e] = cosf(ang); rope[2048 + e] = sinf(ang); }
    }
    LAS float* scr = (LAS float*)(F.lds + F.wave * 16384);
    const int gw = F.vcu * NWAVES + F.wave, NGW = F.G * NWAVES;
    constexpr int I_IN = (DM / 64) * (INW / 64), I_SQ = (DM / 64) * (DM / 64), I_PG = (256 / 64) * (512 / 64);
    constexpr int PER_LAYER = I_IN + 3 * I_SQ + 4 * I_PG;
    for (int it = gw; it < NLAYER * PER_LAYER; it += NGW) {
        const int layer = it / PER_LAYER; int r = it % PER_LAYER;
        if (r < I_IN) { const bool pool = (unsigned)(r % (INW / 64) - POOLOFF / 64) < 1024u / 64u;
            p0_transpose_item(inp<I_WIN>() + (size_t)layer * DM * INW, DM, INW, pool ? (bf16*)(F.ws + WS_WIN + (size_t)layer * 32 * MiB) : (bf16*)nullptr,
                              pool ? (unsigned char*)nullptr : F.ws + WS_WIN8 + (size_t)layer * 32 * MiB, 0, scr, r, F.lane); continue; } r -= I_IN;
        if (r < I_SQ) { p0_transpose_item(inp<I_WBR>() + (size_t)layer * DM * DM, DM, DM, nullptr, F.ws + WS_WBR8 + (size_t)layer * 32 * MiB, 0, scr, r, F.lane); continue; } r -= I_SQ;
        if (r < I_SQ) { p0_transpose_item(inp<I_WOUT>() + (size_t)layer * DM * DM, DM, DM, (bf16*)(F.ws + WS_WOUT + (size_t)layer * 8 * MiB), nullptr, 0, scr, r, F.lane); continue; } r -= I_SQ;
        if (r < I_SQ) { p0_transpose_item(inp<I_WQP>() + (size_t)layer * DM * DM, DM, DM, (bf16*)(F.ws + WS_WQP + (size_t)layer * 8 * MiB), nullptr, 0, scr, r, F.lane); continue; } r -= I_SQ;
        const int g = r / I_PG; r %= I_PG;
        p0_transpose_item(inp<I_WPOOL>() + ((size_t)layer * 4 + g) * 256 * 512, 256, 512, (bf16*)(F.ws + WS_WPOOL + (size_t)layer * 1 * MiB), nullptr, g * 512, scr, r, F.lane);
    }
    const size_t gt = (size_t)F.vcu * 512 + F.tid, NGT = (size_t)F.G * 512;
    for (size_t e = gt; e < (size_t)NLAYER * 2048 * 16; e += NGT) cvt8(inp<I_KEYS>() + e * 8, (bf16*)(F.ws + WS_KEYS) + e * 8);
    {
        typedef __bf16 bf32v __attribute__((ext_vector_type(32)));
        typedef unsigned v6u __attribute__((ext_vector_type(6)));
        const float* pu_ = inp<I_PU>(); const float* pv_ = inp<I_PV>();
        constexpr int NROWS = NLAYER * NEXP;
        for (int rr = gw; rr < 2 * NROWS; rr += NGW) {
            const bool isu = rr < NROWS; const int row = isu ? rr : rr - NROWS;
            const float* src = (isu ? pu_ : pv_) + (size_t)row * DM + F.lane * 4;
            f32x4 v[8];
#pragma unroll
            for (int j = 0; j < 8; ++j) v[j] = *(const GAS f32x4*)(src + 256 * j);
            float m = 0.f;
#pragma unroll
            for (int j = 0; j < 8; ++j) m = fmaxf(m, fmaxf(fmaxf(fabsf(v[j].x), fabsf(v[j].y)), fmaxf(fabsf(v[j].z), fabsf(v[j].w))));
            m = wave_max(m);
            float sc = 1.0f;
            if (m > 1e-30f) sc = fminf(6.0f / m, 1.0e30f);
            {
                unsigned pk[4];
#pragma unroll
                for (int d = 0; d < 4; ++d) { unsigned p = 0u;
                    p = __builtin_amdgcn_cvt_scalef32_pk_fp4_f32(p, v[2 * d].x * sc, v[2 * d].y * sc, 1.0f, 0); p = __builtin_amdgcn_cvt_scalef32_pk_fp4_f32(p, v[2 * d].z * sc, v[2 * d].w * sc, 1.0f, 1);
                    p = __builtin_amdgcn_cvt_scalef32_pk_fp4_f32(p, v[2 * d + 1].x * sc, v[2 * d + 1].y * sc, 1.0f, 2); p = __builtin_amdgcn_cvt_scalef32_pk_fp4_f32(p, v[2 * d + 1].z * sc, v[2 * d + 1].w * sc, 1.0f, 3);
                    pk[d] = p; }
                unsigned char* dst = F.ws + (isu ? WS_PU : WS_PV) + (size_t)(row / NEXP) * 32 * MiB + (size_t)(row % NEXP) * 1024 + F.lane * 16;
                *(GAS v4u*)dst = (v4u){pk[0], pk[1], pk[2], pk[3]};
            }
            if (F.lane == 0) ((float*)(F.ws + (isu ? WS_SCU : WS_SCV)))[row] = 1.0f / sc;
        }
    }
}
__device__ __forceinline__ void phase_mod_finalize(Frame& F) {
    const float* modp = (const float*)(F.ws + WS_MODP); float* mod = (float*)(F.ws + WS_MOD);
    constexpr int NMOD = NLAYER * 9 * 6 * DM;
    for (int e = F.vcu * 512 + F.tid; e < NMOD; e += F.G * 512) {
        const int layer = e / (9 * 6 * DM), col = e % (6 * DM);
        float s = inp<I_BADA>()[(size_t)layer * 6 * DM + col];
#pragma unroll
        for (int kc = 0; kc < 8; ++kc) s += modp[(size_t)kc * NMOD + e];
        mod[e] = s;
    }
}
__device__ __forceinline__ void phase_modulate(Frame& F, int layer, int which, int nrows, bool from_inputs, bool with_fp8) {
    const int gw = F.vcu * NWAVES + F.wave, NGW = F.G * NWAVES;
    bf16* H = (bf16*)(F.ws + WS_H);
    const float* x_ = inp<I_X>(); const float* ctx_ = inp<I_CTX>();
    for (int row = gw; row < nrows; row += NGW) {
        const float* mp = mod_ptr(F, layer, row) + (which ? 3 * DM : 0);
        f32x4 v[8]; float ss = 0.f;
        if (from_inputs) { const float* src = row < TL ? x_ + (size_t)row * DM : ctx_ + (size_t)(row - TL) * DM;
#pragma unroll
            for (int j = 0; j < 4; ++j) { v[2 * j] = *(const GAS f32x4*)(src + j * 512 + F.lane * 8); v[2 * j + 1] = *(const GAS f32x4*)(src + j * 512 + F.lane * 8 + 4); }
        } else { const bf16* src = (const bf16*)(F.ws + WS_X) + (size_t)row * DM; v4u r[4];
#pragma unroll
            for (int j = 0; j < 4; ++j) r[j] = *(const GAS v4u*)(src + j * 512 + F.lane * 8);
#pragma unroll
            for (int j = 0; j < 4; ++j) { v[2 * j] = (f32x4){bflo(r[j].x), bfhi(r[j].x), bflo(r[j].y), bfhi(r[j].y)}; v[2 * j + 1] = (f32x4){bflo(r[j].z), bfhi(r[j].z), bflo(r[j].w), bfhi(r[j].w)}; } }
#pragma unroll
        for (int j = 0; j < 8; ++j) ss += (v[j].x * v[j].x + v[j].y * v[j].y) + (v[j].z * v[j].z + v[j].w * v[j].w);
        const float rs = 1.0f / sqrtf(wave_sum(ss) * (1.0f / DM) + EPS);
#pragma unroll
        for (int j = 0; j < 4; ++j) { const int col = j * 512 + F.lane * 8;
            const f32x4 sh0 = *(const GAS f32x4*)(mp + col), sh1 = *(const GAS f32x4*)(mp + col + 4), sc0 = *(const GAS f32x4*)(mp + DM + col), sc1 = *(const GAS f32x4*)(mp + DM + col + 4);
            const f32x4 o0 = v[2 * j] * rs * (sc0 + 1.0f) + sh0, o1 = v[2 * j + 1] * rs * (sc1 + 1.0f) + sh1;
            v4u w; w.x = pk2(o0.x, o0.y); w.y = pk2(o0.z, o0.w); w.z = pk2(o1.x, o1.y); w.w = pk2(o1.z, o1.w);
            *(GAS v4u*)(H + (size_t)row * DM + col) = w;
            if (with_fp8) { v2u w8; w8.x = pk4_fp8(o0.x, o0.y, o0.z, o0.w); w8.y = pk4_fp8(o1.x, o1.y, o1.z, o1.w); *(GAS v2u*)(F.ws + WS_H8 + (size_t)row * DM + col) = w8; }
        }
    }
}

__device__ __forceinline__ v4u qk_item(const v4u raw, int row, int quad, int layer, int lane, const float* rope, const float* qg_, const float* kg_) {
    const int l16 = lane & 15, d0 = l16 * 8, head = quad * 4 + (lane >> 4);
    float v[8] = {bflo(raw.x), bfhi(raw.x), bflo(raw.y), bfhi(raw.y), bflo(raw.z), bfhi(raw.z), bflo(raw.w), bfhi(raw.w)};
    float ss = 0.f;
#pragma unroll
    for (int e = 0; e < 8; ++e) ss += v[e] * v[e];
    ss += __shfl_xor(ss, 1); ss += __shfl_xor(ss, 2); ss += __shfl_xor(ss, 4); ss += __shfl_xor(ss, 8);
    const float rs = 1.0f / sqrtf(ss * (1.0f / 128.0f) + EPS);
    const float* gain = (head < 16 ? qg_ : kg_) + (size_t)layer * 128 + d0;
    const f32x4 g0 = *(const GAS f32x4*)gain, g1 = *(const GAS f32x4*)(gain + 4);
    const float gg[8] = {g0.x, g0.y, g0.z, g0.w, g1.x, g1.y, g1.z, g1.w};
#pragma unroll
    for (int e = 0; e < 8; ++e) v[e] = v[e] * rs * gg[e];
    float part[8];
#pragma unroll
    for (int e = 0; e < 8; ++e) part[e] = __shfl_xor(v[e], 4);
    if (row < TL) {
        const int t = row & (SEQ - 1), pos = (d0 < 64) ? (t >> 6) : (t & 63), f0 = d0 & 31;
        const float* cs = rope + pos * 32 + f0; const float* sn = cs + 2048;
        const f32x4 c0 = *(const GAS f32x4*)cs, c1 = *(const GAS f32x4*)(cs + 4), s0 = *(const GAS f32x4*)sn, s1 = *(const GAS f32x4*)(sn + 4);
        const float cc[8] = {c0.x, c0.y, c0.z, c0.w, c1.x, c1.y, c1.z, c1.w}, sv[8] = {s0.x, s0.y, s0.z, s0.w, s1.x, s1.y, s1.z, s1.w};
        const float sgn = (l16 & 4) ? 1.0f : -1.0f;
#pragma unroll
        for (int e = 0; e < 8; ++e) v[e] = v[e] * cc[e] + sgn * part[e] * sv[e];
    }
    v4u o; o.x = pk2(v[0], v[1]); o.y = pk2(v[2], v[3]); o.z = pk2(v[4], v[5]); o.w = pk2(v[6], v[7]);
    return o;
}
__device__ __forceinline__ void phase_post(Frame& F, int layer) {
    const int gw = F.vcu * NWAVES + F.wave, NGW = F.G * NWAVES, lane = F.lane;
    bf16* P = (bf16*)(F.ws + WS_P);
    const float* rope = (const float*)(F.ws + WS_ROPE);
    const float* qg_ = inp<I_QG>(); const float* kg_ = inp<I_KG>();
    for (int it0 = gw; it0 < TT; it0 += 4 * NGW) {
        v4u raw[4]; bool ok[4];
#pragma unroll
        for (int q = 0; q < 4; ++q) { const int row = it0 + q * NGW; ok[q] = row < TT;
            if (ok[q]) raw[q] = *(const GAS v4u*)(P + (size_t)row * INW + 4 * 512 + lane * 8); }
#pragma unroll
        for (int q = 0; q < 4; ++q) if (ok[q]) { const int row = it0 + q * NGW;
            *(GAS v4u*)(P + (size_t)row * INW + 4 * 512 + lane * 8) = qk_item(raw[q], row, 4, layer, lane, rope, qg_, kg_); }
    }
    bf16* PO = (bf16*)(F.ws + WS_POOLED);
    const int prow = (layer == NLAYER - 1) ? TL : TT;
    for (int it = gw; it < prow * 2; it += NGW) {
        const int row = it >> 1, hsel = it & 1, c8 = hsel * 64 + lane, g = c8 >> 5, half = 1 << g;
        int base, t, L;
        if (row < TL) { base = row & ~(SEQ - 1); t = row & (SEQ - 1); L = SEQ; } else { const int j = row - TL; base = TL + (j & ~(CTXL - 1)); t = j & (CTXL - 1); L = CTXL; }
        const int lo = max(t - half, 0), hi = min(t + half, L);
        float acc[8] = {0.f, 0.f, 0.f, 0.f, 0.f, 0.f, 0.f, 0.f};
        const bf16* pp = P + (size_t)base * INW + POOLOFF + c8 * 8;
        const v4u selfraw = *(const GAS v4u*)(pp + (size_t)t * INW);
#define POOL_ACC(NW, H0) do { v4u rw_[NW]; \
            _Pragma("unroll") for (int d = 0; d < NW; ++d) { const int tt = min(max(t - (H0) + d, 0), L - 1); rw_[d] = *(const GAS v4u*)(pp + (size_t)tt * INW); } \
            _Pragma("unroll") for (int d = 0; d < NW; ++d) { const int tt = t - (H0) + d; const float wgt = (tt >= lo && tt < hi) ? 1.0f : 0.0f; \
                acc[0] += wgt * bflo(rw_[d].x); acc[1] += wgt * bfhi(rw_[d].x); acc[2] += wgt * bflo(rw_[d].y); acc[3] += wgt * bfhi(rw_[d].y); \
                acc[4] += wgt * bflo(rw_[d].z); acc[5] += wgt * bfhi(rw_[d].z); acc[6] += wgt * bflo(rw_[d].w); acc[7] += wgt * bfhi(rw_[d].w); } } while (0)
        if (hsel == 0) POOL_ACC(4, 2); else POOL_ACC(16, 8);
#undef POOL_ACC
        const float self[8] = {bflo(selfraw.x), bfhi(selfraw.x), bflo(selfraw.y), bfhi(selfraw.y), bflo(selfraw.z), bfhi(selfraw.z), bflo(selfraw.w), bfhi(selfraw.w)};
        const float inv = 1.0f / (float)(hi - lo);
        v4u o; o.x = pk2(acc[0] * inv - self[0], acc[1] * inv - self[1]); o.y = pk2(acc[2] * inv - self[2], acc[3] * inv - self[3]);
        o.z = pk2(acc[4] * inv - self[4], acc[5] * inv - self[5]); o.w = pk2(acc[6] * inv - self[6], acc[7] * inv - self[7]);
        *(GAS v4u*)(PO + (size_t)row * 1024 + c8 * 8) = o;
    }
}

namespace attn {
constexpr int D = 128, NW = 8, QBLK = 32, KVBLK = 64;
constexpr float SCALE = 0.088388347648318440f;
constexpr float THR = 8.f;
constexpr int LDQ = INW, LDK = INW, LDO = DM;
constexpr size_t SHM_V = KVBLK * D * 2, SHM_K = KVBLK * D * 2;
constexpr size_t OFF_WS = 2 * SHM_V + 2 * SHM_K, OFF_OST = OFF_WS + NW * 64 * 4, SHM_ATTN = OFF_OST + NW * 4096;
using s16x4  = __attribute__((ext_vector_type(4))) short;
using f32x16 = __attribute__((ext_vector_type(16))) float;
using u32x4  = __attribute__((ext_vector_type(4))) unsigned;
#define KSWZ(row, colB) ((row) * 256 + ((colB) ^ (((row) & 7) << 4)))
#define SBAR() __builtin_amdgcn_sched_barrier(0)
__device__ __forceinline__ int crow(int r, int hi) { return (r & 3) + 8 * (r >> 2) + 4 * hi; }
__device__ __forceinline__ unsigned cvtpk(float lo, float hi) { unsigned r; asm volatile("v_cvt_pk_bf16_f32 %0, %1, %2" : "=v"(r) : "v"(lo), "v"(hi)); return r; }
__device__ __forceinline__ void partialSM(f32x16& p0, f32x16& p1, float& m_reg, float& mn, float& alpha) {
  constexpr float C = SCALE * 1.4426950408889634f;
  float pmax = p0[0]; for (int r = 1; r < 16; ++r) pmax = fmaxf(pmax, p0[r]); for (int r = 0; r < 16; ++r) pmax = fmaxf(pmax, p1[r]);
  { auto rr = __builtin_amdgcn_permlane32_swap(__float_as_uint(pmax), __float_as_uint(pmax), false, false);
    pmax = fmaxf(__uint_as_float(rr[0]), __uint_as_float(rr[1])); }
  if (__builtin_expect(__all(pmax - m_reg <= THR / SCALE), 1)) { mn = m_reg; alpha = 1.f; }
  else { mn = fmaxf(m_reg, pmax); alpha = __builtin_amdgcn_exp2f((m_reg - mn) * C); m_reg = mn; }
  float mnC = -mn * C;
  for (int r = 0; r < 16; ++r) p0[r] = fmaf(p0[r], C, mnC); for (int r = 0; r < 16; ++r) p1[r] = fmaf(p1[r], C, mnC);
  for (int r = 0; r < 16; ++r) p0[r] = __builtin_amdgcn_exp2f(p0[r]);
}
__device__ __forceinline__ void finishSM(f32x16& p0, f32x16& p1, float alpha, float& l_reg, bf16x8& pa0, bf16x8& pa1, bf16x8& pa2, bf16x8& pa3) {
  for (int r = 0; r < 16; ++r) p1[r] = __builtin_amdgcn_exp2f(p1[r]);
  float ps = 0; for (int r = 0; r < 16; ++r) ps += p0[r]; for (int r = 0; r < 16; ++r) ps += p1[r];
  { auto rr = __builtin_amdgcn_permlane32_swap(__float_as_uint(ps), __float_as_uint(ps), false, false);
    ps = __uint_as_float(rr[0]) + __uint_as_float(rr[1]); }
  l_reg = l_reg * alpha + ps;
#define PK4(P, BASE, OUT) do { unsigned a0 = cvtpk(P[BASE + 0], P[BASE + 1]), a1 = cvtpk(P[BASE + 2], P[BASE + 3]);   \
    unsigned b0 = cvtpk(P[BASE + 4], P[BASE + 5]), b1 = cvtpk(P[BASE + 6], P[BASE + 7]);                              \
    auto r0 = __builtin_amdgcn_permlane32_swap(a0, b0, false, false); auto r1 = __builtin_amdgcn_permlane32_swap(a1, b1, false, false); \
    u32x4 w = {r0[0], r1[0], r0[1], r1[1]}; OUT = *reinterpret_cast<bf16x8*>(&w); } while (0)
  PK4(p0, 0, pa0); PK4(p0, 8, pa1); PK4(p1, 0, pa2); PK4(p1, 8, pa3);
#undef PK4
}
__device__ __forceinline__ void qkt(f32x16& p0, f32x16& p1, const bf16* Ks, const bf16x8* qr, int r32, int hi) {
  p0 = f32x16{}; p1 = f32x16{};
  for (int d0 = 0; d0 < 8; ++d0) { int cb = (d0 * 16 + hi * 8) * 2;
    bf16x8 b0 = *reinterpret_cast<const bf16x8*>((const char*)Ks + KSWZ(r32, cb));
    bf16x8 b1 = *reinterpret_cast<const bf16x8*>((const char*)Ks + KSWZ(32 + r32, cb));
    p0 = __builtin_amdgcn_mfma_f32_32x32x16_bf16(b0, qr[d0], p0, 0, 0, 0);
    p1 = __builtin_amdgcn_mfma_f32_32x32x16_bf16(b1, qr[d0], p1, 0, 0, 0); }
}
__device__ __forceinline__ int v_st(int k, int c) { const int kk = (k & ~0xC) | ((k & 4) << 1) | ((k & 8) >> 1); return ((kk >> 3) * 4 + (c >> 5)) * 512 + ((kk & 7) * 32 + (c & 31)) * 2; }
__device__ __forceinline__ int v_rd_base(int lane) { return ((lane & 3) << 3) | (((lane >> 2) & 3) << 6) | (((lane >> 4) & 1) << 5) | (((lane >> 5) & 1) << 8); }
constexpr int v_rd_off(int d0, int ks, int half) { return d0 * 512 + ks * 4096 + half * 2048; }
template <int OFF> __device__ __forceinline__ s16x4 tr_read(int vb) {
  s16x4 r; asm volatile("ds_read_b64_tr_b16 %0, %1 offset:%2" : "=&v"(r) : "v"(vb), "i"(OFF) : "memory"); return r;
}
template <int D0> __device__ __forceinline__ void pv_one(f32x16& od, int vb, bf16x8 pa0, bf16x8 pa1, bf16x8 pa2, bf16x8 pa3) {
  const s16x4 l0 = tr_read<v_rd_off(D0, 0, 0)>(vb), h0 = tr_read<v_rd_off(D0, 0, 1)>(vb), l1 = tr_read<v_rd_off(D0, 1, 0)>(vb), h1 = tr_read<v_rd_off(D0, 1, 1)>(vb);
  const s16x4 l2 = tr_read<v_rd_off(D0, 2, 0)>(vb), h2 = tr_read<v_rd_off(D0, 2, 1)>(vb), l3 = tr_read<v_rd_off(D0, 3, 0)>(vb), h3 = tr_read<v_rd_off(D0, 3, 1)>(vb);
  asm volatile("s_waitcnt lgkmcnt(0)" ::: "memory"); SBAR();
#define PK(L, H) (bf16x8){L[0], L[1], L[2], L[3], H[0], H[1], H[2], H[3]}
  od = __builtin_amdgcn_mfma_f32_32x32x16_bf16(pa0, PK(l0, h0), od, 0, 0, 0);
  od = __builtin_amdgcn_mfma_f32_32x32x16_bf16(pa1, PK(l1, h1), od, 0, 0, 0);
  od = __builtin_amdgcn_mfma_f32_32x32x16_bf16(pa2, PK(l2, h2), od, 0, 0, 0);
  od = __builtin_amdgcn_mfma_f32_32x32x16_bf16(pa3, PK(l3, h3), od, 0, 0, 0);
#undef PK
}
__device__ __forceinline__ void pv_d0(f32x16* o, int vb, bf16x8 pa0, bf16x8 pa1, bf16x8 pa2, bf16x8 pa3) {
  pv_one<0>(o[0], vb, pa0, pa1, pa2, pa3); pv_one<1>(o[1], vb, pa0, pa1, pa2, pa3); pv_one<2>(o[2], vb, pa0, pa1, pa2, pa3); pv_one<3>(o[3], vb, pa0, pa1, pa2, pa3);
}
__device__ __forceinline__ void attn_unit(const bf16* __restrict__ Qb, const bf16* __restrict__ K1, const bf16* __restrict__ K2,
                                          int len1, int seq, unsigned char* __restrict__ Ob, char* lds, const float* __restrict__ qgain, const float* __restrict__ rope, int tq0) {
  int tid_ = threadIdx.x; asm volatile("" : "+v"(tid_));
  const int tid = tid_, wid = tid >> 6, lane = tid & 63, r32 = lane & 31, hi = lane >> 5;
  bf16* V_lds = (bf16*)lds; bf16* K_lds = (bf16*)(lds + 2 * SHM_V);
  float* ws = (float*)(lds + OFF_WS) + wid * 64; float* li_l = ws; float* al_l = ws + 32;
  float m_reg = -1e30f, l_reg = 0; f32x16 o[4] = {}; bf16x8 qr[8];
  const bf16* Qw = Qb + (long)(wid * QBLK + r32) * LDQ + hi * 8;
#pragma unroll
  for (int d0 = 0; d0 < 8; ++d0) qr[d0] = *(const GAS bf16x8*)(Qw + d0 * 16);
  {
    float qf[8][8]; float ss = 0.f;
#pragma unroll
    for (int d0 = 0; d0 < 8; ++d0) { const u32x4 w = __builtin_bit_cast(u32x4, qr[d0]);
      qf[d0][0] = bflo(w[0]); qf[d0][1] = bfhi(w[0]); qf[d0][2] = bflo(w[1]); qf[d0][3] = bfhi(w[1]); qf[d0][4] = bflo(w[2]); qf[d0][5] = bfhi(w[2]); qf[d0][6] = bflo(w[3]); qf[d0][7] = bfhi(w[3]);
#pragma unroll
      for (int e = 0; e < 8; ++e) ss += qf[d0][e] * qf[d0][e]; }
    { auto rr = __builtin_amdgcn_permlane32_swap(__float_as_uint(ss), __float_as_uint(ss), false, false); ss = __uint_as_float(rr[0]) + __uint_as_float(rr[1]); }
    const float rs = 1.0f / sqrtf(ss * (1.0f / 128.0f) + EPS);
#pragma unroll
    for (int d0 = 0; d0 < 8; ++d0) { const float* gp = qgain + d0 * 16 + hi * 8; const f32x4 g0 = *(const GAS f32x4*)gp, g1 = *(const GAS f32x4*)(gp + 4);
      qf[d0][0] *= rs * g0.x; qf[d0][1] *= rs * g0.y; qf[d0][2] *= rs * g0.z; qf[d0][3] *= rs * g0.w; qf[d0][4] *= rs * g1.x; qf[d0][5] *= rs * g1.y; qf[d0][6] *= rs * g1.z; qf[d0][7] *= rs * g1.w; }
    if (tq0 >= 0) {
      const int t = tq0 + wid * QBLK + r32;
#pragma unroll
      for (int ch = 0; ch < 2; ++ch) { const int pos = ch == 0 ? (t >> 6) : (t & 63);
#pragma unroll
        for (int dd = 0; dd < 2; ++dd) { const int dA = ch * 4 + dd, dB = dA + 2; const float* cs = rope + pos * 32 + dd * 16 + hi * 8; const float* sn = cs + 2048;
          const f32x4 c0 = *(const GAS f32x4*)cs, c1 = *(const GAS f32x4*)(cs + 4), s0 = *(const GAS f32x4*)sn, s1 = *(const GAS f32x4*)(sn + 4);
          const float cc[8] = {c0.x, c0.y, c0.z, c0.w, c1.x, c1.y, c1.z, c1.w}, sv[8] = {s0.x, s0.y, s0.z, s0.w, s1.x, s1.y, s1.z, s1.w};
#pragma unroll
          for (int e = 0; e < 8; ++e) { const float x1 = qf[dA][e], x2 = qf[dB][e]; qf[dA][e] = x1 * cc[e] - x2 * sv[e]; qf[dB][e] = x2 * cc[e] + x1 * sv[e]; } } }
    }
#pragma unroll
    for (int d0 = 0; d0 < 8; ++d0) { u32x4 w; w[0] = cvtpk(qf[d0][0], qf[d0][1]); w[1] = cvtpk(qf[d0][2], qf[d0][3]); w[2] = cvtpk(qf[d0][4], qf[d0][5]); w[3] = cvtpk(qf[d0][6], qf[d0][7]); qr[d0] = __builtin_bit_cast(bf16x8, w); }
  }
  const int sr = tid >> 4, sc = (tid & 15) * 8, vst0 = v_st(sr, sc), vst1 = v_st(32 + sr, sc);
  const int vb0 = (int)(uintptr_t)V_lds + v_rd_base(lane);
  struct { bf16x8 vs0, vs1, ks0, ks1; } sr_[2];
  const unsigned lo0_ = (unsigned)(sr * LDK + sc) * 2u, lo1_ = lo0_ + 32u * LDK * 2u;
  constexpr int VKB = (VOFF - KVOFF) * 2;
#define SLOAD(i, k0) do { const int k0_ = (k0); const char* Kt_ = (const char*)((k0_ < len1) ? K1 + (long)k0_ * LDK : K2 + (long)(k0_ - len1) * LDK); \
    sr_[i].vs0 = *(const GAS bf16x8*)(Kt_ + lo0_ + VKB); sr_[i].vs1 = *(const GAS bf16x8*)(Kt_ + lo1_ + VKB); \
    sr_[i].ks0 = *(const GAS bf16x8*)(Kt_ + lo0_); sr_[i].ks1 = *(const GAS bf16x8*)(Kt_ + lo1_); } while (0)
#define SWRITE(b, i) do { *(bf16x8*)((char*)V_lds + (b) * SHM_V + vst0) = sr_[i].vs0;          \
    *(bf16x8*)((char*)V_lds + (b) * SHM_V + vst1) = sr_[i].vs1; int kc = sc * 2;               \
    *(bf16x8*)((char*)K_lds + (b) * SHM_K + KSWZ(sr, kc)) = sr_[i].ks0;                       \
    *(bf16x8*)((char*)K_lds + (b) * SHM_K + KSWZ(32 + sr, kc)) = sr_[i].ks1; } while (0)
#define SWAIT() asm volatile("s_waitcnt vmcnt(4)" ::: "memory")
#define RESC(a) do { if (__any((a) < 1.f)) { if (hi == 0) al_l[r32] = (a); asm volatile("s_waitcnt lgkmcnt(0)" ::: "memory"); \
    for (int d = 0; d < 4; ++d) for (int r = 0; r < 16; ++r) o[d][r] *= al_l[crow(r, hi)]; } } while (0)
  f32x16 pA0, pA1, pB0, pB1; float mnA, mnB, alA, alB; bf16x8 pa0, pa1, pa2, pa3; const int NT = seq / KVBLK;
  constexpr int SE = 0, SO = 1;
  SLOAD(SE, 0); asm volatile("s_waitcnt vmcnt(0)" ::: "memory"); SWRITE(0, SE); __syncthreads();
  qkt(pA0, pA1, K_lds, qr, r32, hi); partialSM(pA0, pA1, m_reg, mnA, alA);
  SLOAD(SO, KVBLK); if (2 < NT) SLOAD(SE, 2 * KVBLK);
  SWAIT(); SWRITE(1, SO); __syncthreads();
  for (int j = 1; j + 1 < NT; j += 2) {
    SBAR(); qkt(pB0, pB1, (bf16*)((char*)K_lds + SHM_K), qr, r32, hi);
    finishSM(pA0, pA1, alA, l_reg, pa0, pa1, pa2, pa3); SBAR();
    SLOAD(SO, (j + 2) * KVBLK); SBAR();
    pv_d0(o, vb0, pa0, pa1, pa2, pa3); partialSM(pB0, pB1, m_reg, mnB, alB);
    __syncthreads(); SWAIT(); SWRITE(0, SE);
    RESC(alB); __syncthreads();
    SBAR(); qkt(pA0, pA1, K_lds, qr, r32, hi);
    finishSM(pB0, pB1, alB, l_reg, pa0, pa1, pa2, pa3); SBAR();
    if (j + 3 < NT) SLOAD(SE, (j + 3) * KVBLK); SBAR();
    pv_d0(o, vb0 + (int)SHM_V, pa0, pa1, pa2, pa3); partialSM(pA0, pA1, m_reg, mnA, alA);
    __syncthreads(); SWAIT(); SWRITE(1, SO);
    RESC(alA); __syncthreads();
  }
  SBAR(); qkt(pB0, pB1, (bf16*)((char*)K_lds + SHM_K), qr, r32, hi);
  finishSM(pA0, pA1, alA, l_reg, pa0, pa1, pa2, pa3); SBAR();
  pv_d0(o, vb0, pa0, pa1, pa2, pa3); partialSM(pB0, pB1, m_reg, mnB, alB);
  __syncthreads(); RESC(alB);
  finishSM(pB0, pB1, alB, l_reg, pa0, pa1, pa2, pa3); SBAR();
  pv_d0(o, vb0 + (int)SHM_V, pa0, pa1, pa2, pa3);
  if (hi == 0) li_l[r32] = l_reg; asm volatile("s_waitcnt lgkmcnt(0)" ::: "memory");
  float rli[16];
#pragma unroll
  for (int r = 0; r < 16; ++r) rli[r] = __builtin_amdgcn_rcpf(li_l[crow(r, hi)]);
  unsigned char* Ow = (unsigned char*)Ob + (long)(wid * QBLK) * LDO;
  unsigned char* stg = (unsigned char*)(lds + OFF_OST) + wid * 4096;
#pragma unroll
  for (int r = 0; r < 16; ++r) { const int orow = crow(r, hi);
#pragma unroll
    for (int d0 = 0; d0 < 4; ++d0) { const float v = __builtin_amdgcn_fmed3f(o[d0][r] * rli[r] * 64.0f, -448.0f, 448.0f); stg[orow * 128 + d0 * 32 + r32] = (unsigned char)__builtin_amdgcn_cvt_pk_fp8_f32(v, v, 0, false); } }
  asm volatile("s_waitcnt lgkmcnt(0)" ::: "memory");
#pragma unroll
  for (int i = 0; i < 4; ++i) { const int row = i * 8 + (lane >> 3), ch = lane & 7; const u32x4 v = *(const u32x4*)(stg + row * 128 + ch * 16); *(GAS u32x4*)(Ow + (long)row * LDO + ch * 16) = v; }
  asm volatile("s_waitcnt lgkmcnt(0)" ::: "memory");
#undef SLOAD
#undef SWRITE
#undef SWAIT
#undef RESC
}
#undef KSWZ
#undef SBAR
}

__device__ __forceinline__ void phase_attention(Frame& F, int layer, char* lds) {
    const bf16* P = (const bf16*)(F.ws + WS_P); unsigned char* AO = F.ws + WS_AO;
    const float* qg_ = inp<I_QG>() + (size_t)layer * 128; const float* rope_ = (const float*)(F.ws + WS_ROPE);
    const int nunits = 1024 + (layer == NLAYER - 1 ? 0 : 128);
    for (int L = F.vcu; L < nunits; L += F.G) {
        const bool lat = L < 1024; const int cidx = L - 1024;
        const int combo = L >> 5, loc = L & 31, b = lat ? (combo >> 2) : (cidx >> 4), h = lat ? ((combo & 3) * 4 + (loc >> 3)) : (cidx & 15), kvh = h >> 2, qb = loc & 7;
        const size_t crow = (size_t)TL + b * CTXL, qrow = lat ? (size_t)b * SEQ + qb * 256 : crow, k1row = lat ? (size_t)b * SEQ : crow;
        attn::attn_unit(P + qrow * INW + h * 128, P + k1row * INW + KVOFF + kvh * 128, P + crow * INW + KVOFF + kvh * 128, lat ? SEQ : CTXL, lat ? SEQ + CTXL : CTXL, AO + qrow * DM + h * 128, lds, qg_, rope_, lat ? qb * 256 : -1);
    }
}

using pg8::f32x4;
struct FNone {};
struct FStoreBf16 { bf16* O; int ldc; float scale;
    typedef FNone Pre; typedef FNone Col;
    __device__ __forceinline__ Col col_load(int, int) const { return Col{}; }
    __device__ __forceinline__ Pre load(int, int) const { return Pre{}; }
    __device__ __forceinline__ void apply(int row, int col, f32x4 v0, f32x4 v1, Pre, Col) const {
        v0 = v0 * scale; v1 = v1 * scale;
        v4u w; w.x = pk2(v0[0], v0[1]); w.y = pk2(v0[2], v0[3]); w.z = pk2(v1[0], v1[1]); w.w = pk2(v1[2], v1[3]);
        *(GAS v4u*)(O + (size_t)row * ldc + col) = w; } };
__device__ __forceinline__ void unpack8(v4u raw, float* v) { v[0] = bflo(raw.x); v[1] = bfhi(raw.x); v[2] = bflo(raw.y); v[3] = bfhi(raw.y); v[4] = bflo(raw.z); v[5] = bfhi(raw.z); v[6] = bflo(raw.w); v[7] = bfhi(raw.w); }
struct FPool { bf16* YB; const bf16* P; const float* pscale;
    struct Pre { v4u g; }; struct Col { f32x4 s0, s1; };
    __device__ __forceinline__ Col col_load(int, int col) const { Col c; c.s0 = *(const GAS f32x4*)(pscale + col); c.s1 = *(const GAS f32x4*)(pscale + col + 4); return c; }
    __device__ __forceinline__ Pre load(int row, int col) const { Pre p; p.g = *(const GAS v4u*)(P + (size_t)row * INW + GBOFF + col); return p; }
    __device__ __forceinline__ void apply(int row, int col, f32x4 v0, f32x4 v1, Pre p, Col c) const {
        float gt[8]; unpack8(p.g, gt);
        float o[8];
#pragma unroll
        for (int e = 0; e < 4; ++e) { o[e] = v0[e] * c.s0[e] * sigmoidf_(gt[e]); o[4 + e] = v1[e] * c.s1[e] * sigmoidf_(gt[4 + e]); }
        v4u w; w.x = pk2(o[0], o[1]); w.y = pk2(o[2], o[3]); w.z = pk2(o[4], o[5]); w.w = pk2(o[6], o[7]);
        *(GAS v4u*)(YB + (size_t)row * DM + col) = w; } };
struct FMerge { bf16* MG; const bf16* P; const bf16* YB; float scale;
    struct Pre { v4u g, y; }; typedef FNone Col;
    __device__ __forceinline__ Col col_load(int, int) const { return Col{}; }
    __device__ __forceinline__ Pre load(int row, int col) const { Pre p; p.g = *(const GAS v4u*)(P + (size_t)row * INW + GAOFF + col); p.y = *(const GAS v4u*)(YB + (size_t)row * DM + col); return p; }
    __device__ __forceinline__ void apply(int row, int col, f32x4 v0, f32x4 v1, Pre p, Col) const {
        v0 = v0 * scale; v1 = v1 * scale;
        float gt[8], yb[8]; unpack8(p.g, gt); unpack8(p.y, yb);
        float o[8];
#pragma unroll
        for (int e = 0; e < 4; ++e) { o[e] = v0[e] * sigmoidf_(gt[e]) + yb[e]; o[4 + e] = v1[e] * sigmoidf_(gt[4 + e]) + yb[4 + e]; }
        v4u w; w.x = pk2(o[0], o[1]); w.y = pk2(o[2], o[3]); w.z = pk2(o[4], o[5]); w.w = pk2(o[6], o[7]);
        *(GAS v4u*)(MG + (size_t)row * DM + col) = w; } };
constexpr float SG_MIN = 1e-20f;
struct FMid { const bf16* P; const float* pscale; float inv_scale;
    struct Pre { v4u ga, gb; }; struct Col { f32x4 s0, s1; };
    __device__ __forceinline__ Col col_load(int, int col) const { Col c; c.s0 = *(const GAS f32x4*)(pscale + col); c.s1 = *(const GAS f32x4*)(pscale + col + 4); return c; }
    __device__ __forceinline__ Pre load(int row, int col) const { Pre p; p.ga = *(const GAS v4u*)(P + (size_t)row * INW + GAOFF + col); p.gb = *(const GAS v4u*)(P + (size_t)row * INW + GBOFF + col); return p; }
    __device__ __forceinline__ f32x4 factor(unsigned ga2a, unsigned ga2b, unsigned gb2a, unsigned gb2b, f32x4 ps) const {
        const float ga[4] = {bflo(ga2a), bfhi(ga2a), bflo(ga2b), bfhi(ga2b)}, gb[4] = {bflo(gb2a), bfhi(gb2a), bflo(gb2b), bfhi(gb2b)};
        f32x4 r;
#pragma unroll
        for (int e = 0; e < 4; ++e) r[e] = ps[e] * sigmoidf_(gb[e]) * (inv_scale * __builtin_amdgcn_rcpf(fmaxf(sigmoidf_(ga[e]), SG_MIN)));
        return r; }
    __device__ __forceinline__ void xform(f32x4& v0, f32x4& v1, Pre p, Col c) const {
        const f32x4 f0 = factor(p.ga.x, p.ga.y, p.gb.x, p.gb.y, c.s0); asm volatile("" ::: "memory"); const f32x4 f1 = factor(p.ga.z, p.ga.w, p.gb.z, p.gb.w, c.s1);
        v0 = v0 * f0; v1 = v1 * f1; } };
struct FMergeC { bf16* MG; const bf16* P; float scale;
    struct Pre { v4u g; }; typedef FNone Col;
    __device__ __forceinline__ Col col_load(int, int) const { return Col{}; }
    __device__ __forceinline__ Pre load(int row, int col) const { Pre p; p.g = *(const GAS v4u*)(P + (size_t)row * INW + GAOFF + col); return p; }
    __device__ __forceinline__ void apply(int row, int col, f32x4 v0, f32x4 v1, Pre p, Col) const {
        float gt[8]; unpack8(p.g, gt);
        float o[8];
#pragma unroll
        for (int e = 0; e < 4; ++e) { o[e] = v0[e] * (scale * fmaxf(sigmoidf_(gt[e]), SG_MIN)); o[4 + e] = v1[e] * (scale * fmaxf(sigmoidf_(gt[4 + e]), SG_MIN)); }
        v4u w; w.x = pk2(o[0], o[1]); w.y = pk2(o[2], o[3]); w.z = pk2(o[4], o[5]); w.w = pk2(o[6], o[7]);
        *(GAS v4u*)(MG + (size_t)row * DM + col) = w; } };
struct FResid { bf16* X; const float* xin; const float* cin; const float* mod; int from_inputs;
    struct Pre { f32x4 x0, x1; }; struct Col { f32x4 g0, g1; };
    __device__ __forceinline__ Col col_load(int row, int col) const {
        const int mr = row < TL ? (row >> 11) : 8;
        const float* g = mod + (size_t)mr * (6 * DM) + 2 * DM + col;
        Col c; c.g0 = *(const GAS f32x4*)g; c.g1 = *(const GAS f32x4*)(g + 4); return c; }
    __device__ __forceinline__ Pre load(int row, int col) const {
        Pre p;
        if (from_inputs) { const float* src = (row < TL ? xin : cin - (size_t)TL * DM) + (size_t)row * DM + col; p.x0 = *(const GAS f32x4*)src; p.x1 = *(const GAS f32x4*)(src + 4); }
        else { p.x0 = *(const GAS f32x4*)(X + (size_t)row * DM + col); p.x1 = p.x0; }
        return p; }
    __device__ __forceinline__ void apply(int row, int col, f32x4 v0, f32x4 v1, Pre p, Col c) const {
        f32x4 x0 = p.x0, x1 = p.x1;
        if (!from_inputs) { const v4u raw = __builtin_bit_cast(v4u, p.x0); x0 = (f32x4){bflo(raw.x), bfhi(raw.x), bflo(raw.y), bfhi(raw.y)}; x1 = (f32x4){bflo(raw.z), bfhi(raw.z), bflo(raw.w), bfhi(raw.w)}; }
        const f32x4 o0 = x0 + c.g0 * v0, o1 = x1 + c.g1 * v1;
        v4u w; w.x = pk2(o0[0], o0[1]); w.y = pk2(o0[2], o0[3]); w.z = pk2(o1[0], o1[1]); w.w = pk2(o1[2], o1[3]);
        *(GAS v4u*)(X + (size_t)row * DM + col) = w; } };

namespace pk {
using f32x16 = __attribute__((ext_vector_type(16))) float;
__device__ __forceinline__ float vmaxf(float a, float b) { float r; asm("v_max_f32 %0, %1, %2" : "=v"(r) : "v"(a), "v"(b)); return r; }
__device__ __forceinline__ float vminf(float a, float b) { float r; asm("v_min_f32 %0, %1, %2" : "=v"(r) : "v"(a), "v"(b)); return r; }
#define PK_CE(x, y) do { const float mx_ = vmaxf(x, y), mn_ = vminf(x, y); x = mx_; y = mn_; } while (0)
template <int OFF> __device__ __forceinline__ void sort16(float (&a)[64]) {
#pragma unroll
    for (int k = 2; k <= 16; k <<= 1)
#pragma unroll
        for (int j = k >> 1; j > 0; j >>= 1)
#pragma unroll
            for (int i = 0; i < 16; ++i) { const int l = i ^ j; if (l > i) { if ((i & k) == 0) PK_CE(a[OFF + i], a[OFF + l]); else PK_CE(a[OFF + l], a[OFF + i]); } }
}
template <int A, int B> __device__ __forceinline__ void merge16(float (&a)[64]) {
#pragma unroll
    for (int i = 0; i < 16; ++i) a[A + i] = vmaxf(a[A + i], a[B + 15 - i]);
#pragma unroll
    for (int j = 8; j > 0; j >>= 1)
#pragma unroll
        for (int i = 0; i < 16; ++i) { const int l = i ^ j; if (l > i) PK_CE(a[A + i], a[A + l]); }
}
__device__ __forceinline__ void top16_of_64(float (&a)[64]) {
    sort16<0>(a); sort16<16>(a); sort16<32>(a); sort16<48>(a);
    merge16<0, 16>(a); merge16<32, 48>(a); merge16<0, 32>(a);
}
struct Cand { int a[50], b[50]; };
constexpr Cand make_cand() { Cand c{}; int n = 0; for (int a = 0; a < 16; ++a) for (int b = 0; b < 16; ++b) if ((a + 1) * (b + 1) <= 16) { c.a[n] = a; c.b[n] = b; ++n; } return c; }
constexpr Cand CAND = make_cand();
constexpr int LDS_KEYS = 0, LDS_IDX = 65536;
}
__device__ __forceinline__ void phase_pk(Frame& F, int layer, int nrows) {
    using namespace pk;
    const int lane = F.lane, r32 = lane & 31, hi = lane >> 5, wave = F.wave;
    const bf16* QP = (const bf16*)(F.ws + WS_P + P_QP);
    int* IDX = (int*)(F.ws + WS_P + P_IDX); float* GW = (float*)(F.ws + WS_P + P_GW);
    const bf16* KB = (const bf16*)(F.ws + WS_KEYS) + (size_t)layer * 2048 * 128;
    const int nunits = (nrows / 256) * 8;
    int cur_hd = -1;
    for (int u = F.bx; u < nunits; u += F.G) {
        const int hd = u & 7, tb = u >> 3;
        if (hd != cur_hd) {
            __syncthreads();
#pragma unroll
            for (int i = 0; i < 8; ++i) { const int idx = F.tid + 512 * i, row = idx >> 4, c = idx & 15;
                const v4u v = *(const GAS v4u*)(KB + ((size_t)hd * 256 + row) * 128 + c * 8);
                *(LAS v4u*)(F.lds + LDS_KEYS + row * 256 + ((c ^ (row & 15)) << 4)) = v; }
            __syncthreads();
            cur_hd = hd;
        }
        const int t0 = tb * 256 + wave * 32;
        float v01[2][16];
#pragma unroll
        for (int p = 0; p < 2; ++p) {
            bf16x8 bq[8];
            const bf16* qrow = QP + (size_t)(t0 + r32) * DM + hd * 256 + p * 128 + hi * 8;
#pragma unroll
            for (int ks = 0; ks < 8; ++ks) bq[ks] = *(const GAS bf16x8*)(qrow + ks * 16);
            f32x16 acc[4];
#pragma unroll
            for (int nb = 0; nb < 4; ++nb) acc[nb] = f32x16{};
            const LAS unsigned char* kbase = F.lds + LDS_KEYS + (p * 128 + r32) * 256;
#pragma unroll
            for (int ks = 0; ks < 8; ++ks) { const int coff = ((2 * ks + hi) ^ (r32 & 15)) << 4;
#pragma unroll
                for (int nb = 0; nb < 4; ++nb) { const bf16x8 ak = *(const LAS bf16x8*)(kbase + nb * 32 * 256 + coff);
                    acc[nb] = __builtin_amdgcn_mfma_f32_32x32x16_bf16(ak, bq[ks], acc[nb], 0, 0, 0); } }
            float a[64]; const unsigned hib = (unsigned)hi << 2;
#pragma unroll
            for (int nb = 0; nb < 4; ++nb)
#pragma unroll
                for (int r = 0; r < 16; ++r) { const unsigned n0 = 32u * nb + (r & 3) + 8u * (r >> 2);
                    a[nb * 16 + r] = __uint_as_float(((__float_as_uint(acc[nb][r]) & ~127u) | n0) | hib); }
            top16_of_64(a);
            float m0[64];
#pragma unroll
            for (int i = 0; i < 16; ++i) { auto rr = __builtin_amdgcn_permlane32_swap(__float_as_uint(a[i]), __float_as_uint(a[i]), false, false);
                m0[i] = __uint_as_float(rr[0]); m0[16 + i] = __uint_as_float(rr[1]); }
            merge16<0, 16>(m0);
#pragma unroll
            for (int i = 0; i < 16; ++i) v01[p][i] = m0[i];
        }
        LAS unsigned* tab = (LAS unsigned*)(F.lds + LDS_IDX + wave * 8192);
#pragma unroll
        for (int i = 0; i < 16; ++i) { tab[i * 64 + lane] = __float_as_uint(v01[0][i]) & 127u; tab[(16 + i) * 64 + lane] = __float_as_uint(v01[1][i]) & 127u; }
        float c[64];
        float f0[16], f1[16];
#pragma unroll
        for (int i = 0; i < 16; ++i) { f0[i] = __uint_as_float(__float_as_uint(v01[0][i]) & ~127u); f1[i] = __uint_as_float(__float_as_uint(v01[1][i]) & ~127u); }
#pragma unroll
        for (int i = 0; i < 50; ++i) c[i] = __uint_as_float((__float_as_uint(f0[CAND.a[i]] + f1[CAND.b[i]]) & ~255u) | (unsigned)(CAND.a[i] * 16 + CAND.b[i]));
#pragma unroll
        for (int i = 50; i < 64; ++i) c[i] = -INFINITY;
        top16_of_64(c);
        float ev[16], sum = 0.f;
#pragma unroll
        for (int i = 0; i < 16; ++i) { ev[i] = __expf(__uint_as_float(__float_as_uint(c[i]) & ~255u) - __uint_as_float(__float_as_uint(c[0]) & ~255u)); sum += ev[i]; }
        const float rinv = 1.0f / sum;
        LDS_WAIT();
        int eid[8]; float gw[8];
#pragma unroll
        for (int j = 0; j < 8; ++j) { const float cj = hi ? c[8 + j] : c[j]; const unsigned bits = __float_as_uint(cj);
            const unsigned ia = tab[((bits >> 4) & 15u) * 64 + lane], ib = tab[(16u + (bits & 15u)) * 64 + lane];
            eid[j] = (int)(ia * 128u + ib); gw[j] = (hi ? ev[8 + j] : ev[j]) * rinv; }
        const size_t o = (size_t)(t0 + r32) * NSEL + hd * 16 + hi * 8;
        *(GAS v4u*)(IDX + o) = (v4u){(unsigned)eid[0], (unsigned)eid[1], (unsigned)eid[2], (unsigned)eid[3]}; *(GAS v4u*)(IDX + o + 4) = (v4u){(unsigned)eid[4], (unsigned)eid[5], (unsigned)eid[6], (unsigned)eid[7]};
        *(GAS f32x4*)(GW + o) = (f32x4){gw[0], gw[1], gw[2], gw[3]}; *(GAS f32x4*)(GW + o + 4) = (f32x4){gw[4], gw[5], gw[6], gw[7]};
        LDS_WAIT();
    }
}

typedef float f32x2 __attribute__((ext_vector_type(2)));
typedef __bf16 bf16x2_t __attribute__((ext_vector_type(2)));
struct RowV { v4u a, b; };
__device__ __forceinline__ void rowv_load(RowV& r, const unsigned char* tab, int idA, int idB, int hi, int j32) {
    const unsigned off = (unsigned)(hi ? idB : idA) * 1024u + (unsigned)j32;
    const unsigned char* p = tab + off;
    r.a = *(const GAS v4u*)p; r.b = *(const GAS v4u*)(p + 16);
}
#define DW_B(b) do { const f32x2 d_ = __builtin_amdgcn_cvt_scalef32_pk_f32_fp4(dw, 1.0f, b); asm("v_pk_fma_f32 %0, %1, %2, %0" : "+v"(o[b]) : "v"(d_), "v"(w2)); } while (0)
__device__ __forceinline__ void dw_axpy(unsigned dw, f32x2 w2, f32x2* o) { DW_B(0); DW_B(1); DW_B(2); DW_B(3);
    __builtin_amdgcn_sched_barrier(0); }
__device__ __forceinline__ void rowv_axpy(const RowV& r, float w, f32x2 (&o)[32]) {
    const f32x2 w2 = {w, w};
    dw_axpy(r.a.x, w2, o); dw_axpy(r.a.y, w2, o + 4); dw_axpy(r.a.z, w2, o + 8); dw_axpy(r.a.w, w2, o + 12);
    dw_axpy(r.b.x, w2, o + 16); dw_axpy(r.b.y, w2, o + 20); dw_axpy(r.b.z, w2, o + 24); dw_axpy(r.b.w, w2, o + 28);
}
#define DW_D(dw, b, hidx) acc = __builtin_amdgcn_fdot2_f32_bf16(__builtin_amdgcn_cvt_scalef32_pk_bf16_fp4(dw, 1.0f, b), __builtin_bit_cast(bf16x2_t, h[hidx]), acc, false)
__device__ __forceinline__ float rowv_dot(const RowV& r, const unsigned (&h)[32]) {
    float acc = 0.f;
    DW_D(r.a.x, 0, 0); DW_D(r.a.x, 1, 1); DW_D(r.a.x, 2, 2); DW_D(r.a.x, 3, 3);       DW_D(r.a.y, 0, 4); DW_D(r.a.y, 1, 5); DW_D(r.a.y, 2, 6); DW_D(r.a.y, 3, 7);
    DW_D(r.a.z, 0, 8); DW_D(r.a.z, 1, 9); DW_D(r.a.z, 2, 10); DW_D(r.a.z, 3, 11);    DW_D(r.a.w, 0, 12); DW_D(r.a.w, 1, 13); DW_D(r.a.w, 2, 14); DW_D(r.a.w, 3, 15);
    DW_D(r.b.x, 0, 16); DW_D(r.b.x, 1, 17); DW_D(r.b.x, 2, 18); DW_D(r.b.x, 3, 19);  DW_D(r.b.y, 0, 20); DW_D(r.b.y, 1, 21); DW_D(r.b.y, 2, 22); DW_D(r.b.y, 3, 23);
    DW_D(r.b.z, 0, 24); DW_D(r.b.z, 1, 25); DW_D(r.b.z, 2, 26); DW_D(r.b.z, 3, 27);  DW_D(r.b.w, 0, 28); DW_D(r.b.w, 1, 29); DW_D(r.b.w, 2, 30); DW_D(r.b.w, 3, 31);
    return acc;
}
template <int CTRL, int ROWMASK> __device__ __forceinline__ float dpp_add(float v) {
    return v + __uint_as_float((unsigned)__builtin_amdgcn_update_dpp(0, (int)__float_as_uint(v), CTRL, ROWMASK, 0xF, false)); }
__device__ __forceinline__ void reduce4x2(const float (&p)[4], float (&tot)[8]) {
    float r[4];
#pragma unroll
    for (int i = 0; i < 4; ++i) r[i] = dpp_add<0xB1, 0xF>(p[i]);
#pragma unroll
    for (int i = 0; i < 4; ++i) r[i] = dpp_add<0x4E, 0xF>(r[i]);
#pragma unroll
    for (int i = 0; i < 4; ++i) r[i] = dpp_add<0x141, 0xF>(r[i]);
#pragma unroll
    for (int i = 0; i < 4; ++i) r[i] = dpp_add<0x140, 0xF>(r[i]);
#pragma unroll
    for (int i = 0; i < 4; ++i) r[i] = dpp_add<0x142, 0xA>(r[i]);
#pragma unroll
    for (int i = 0; i < 4; ++i) { tot[2 * i] = __uint_as_float(__builtin_amdgcn_readlane(__float_as_uint(r[i]), 31)); tot[2 * i + 1] = __uint_as_float(__builtin_amdgcn_readlane(__float_as_uint(r[i]), 63)); }
}
__device__ __forceinline__ float gelu_erf(float s) { return 0.5f * s * (1.0f + erff(s * 0.70710678118654752f)); }
__device__ __forceinline__ float rdl(float v, int l) { return __uint_as_float(__builtin_amdgcn_readlane(__float_as_uint(v), l)); }
__device__ __forceinline__ void phase_peer(Frame& F, int layer, int nrows) {
    const int gw = F.vcu * NWAVES + F.wave, NGW = F.G * NWAVES, lane = F.lane, hi = lane >> 5;
    const int* IDX = (const int*)(F.ws + WS_P + P_IDX); const float* GW = (const float*)(F.ws + WS_P + P_GW);
    const unsigned char* PU = F.ws + WS_PU + (size_t)layer * 32 * MiB; const unsigned char* PV = F.ws + WS_PV + (size_t)layer * 32 * MiB;
    const float* SCU = (const float*)(F.ws + WS_SCU) + (size_t)layer * NEXP; const float* SCV = (const float*)(F.ws + WS_SCV) + (size_t)layer * NEXP;
    bf16* H = (bf16*)(F.ws + WS_H); bf16* X = (bf16*)(F.ws + WS_X);
    const float* fg_ = inp<I_FG>(); float* out_ = (float*)inp<I_OUT>();
    for (int t = gw; t < nrows; t += NGW) {
        const int id0 = *(const GAS int*)(IDX + (size_t)t * NSEL + lane), id1 = *(const GAS int*)(IDX + (size_t)t * NSEL + 64 + lane);
        const float g0 = *(const GAS float*)(GW + (size_t)t * NSEL + lane), g1 = *(const GAS float*)(GW + (size_t)t * NSEL + 64 + lane);
        const float su0 = *(const GAS float*)(SCU + id0), su1 = *(const GAS float*)(SCU + id1), sv0 = *(const GAS float*)(SCV + id0), sv1 = *(const GAS float*)(SCV + id1);
        unsigned hp[32];
        { const bf16* hrow = H + (size_t)t * DM + (lane & 31) * 8;
#pragma unroll
          for (int jj = 0; jj < 8; ++jj) { const v4u q = *(const GAS v4u*)(hrow + 256 * jj); hp[2 * jj] = q.x; hp[2 * jj + 1] = q.y; hp[16 + 2 * jj] = q.z; hp[16 + 2 * jj + 1] = q.w; } }
        float s0 = 0.f, s1 = 0.f;
        const int j32 = (lane & 31) * 32;
        RowV A[2], B[2];
#define LOAD2(buf, tab, idv, base) do { _Pragma("unroll") for (int q = 0; q < 2; ++q) rowv_load(buf[q], tab, __builtin_amdgcn_readlane(idv, (base) + 2 * q), __builtin_amdgcn_readlane(idv, (base) + 2 * q + 1), hi, j32); } while (0)
#define USTEP(sv_, base, tabn, idn, basen) do { float p_[4], tt_[8]; \
        _Pragma("unroll") for (int q = 0; q < 2; ++q) { p_[q] = rowv_dot(A[q], hp); __builtin_amdgcn_sched_barrier(0); } LOAD2(A, tabn, idn, basen); __builtin_amdgcn_sched_barrier(0); \
        _Pragma("unroll") for (int q = 0; q < 2; ++q) { p_[2 + q] = rowv_dot(B[q], hp); __builtin_amdgcn_sched_barrier(0); } LOAD2(B, tabn, idn, (basen) + 4); __builtin_amdgcn_sched_barrier(0); \
        reduce4x2(p_, tt_); _Pragma("unroll") for (int q = 0; q < 8; ++q) sv_ = (lane == (base) + q) ? tt_[q] : sv_; } while (0)
        LOAD2(A, PU, id0, 0); LOAD2(B, PU, id0, 4);
#pragma unroll 1
        for (int b = 0; b < 56; b += 8) USTEP(s0, b, PU, id0, b + 8);
        USTEP(s0, 56, PU, id1, 0);
#pragma unroll 1
        for (int b = 0; b < 56; b += 8) USTEP(s1, b, PU, id1, b + 8);
        USTEP(s1, 56, PV, id0, 0);
        const float w0 = g0 * gelu_erf(s0 * su0) * sv0, w1 = g1 * gelu_erf(s1 * su1) * sv1;
        f32x2 av[32];
#pragma unroll
        for (int i = 0; i < 32; ++i) av[i] = (f32x2){0.f, 0.f};
#define VSTEP(wv_, base, idn, basen) do { \
        _Pragma("unroll") for (int q = 0; q < 2; ++q) { const float we_ = rdl(wv_, (base) + 2 * q), wo_ = rdl(wv_, (base) + 2 * q + 1); rowv_axpy(A[q], hi ? wo_ : we_, av); } LOAD2(A, PV, idn, basen); \
        _Pragma("unroll") for (int q = 0; q < 2; ++q) { const float we_ = rdl(wv_, (base) + 4 + 2 * q), wo_ = rdl(wv_, (base) + 4 + 2 * q + 1); rowv_axpy(B[q], hi ? wo_ : we_, av); } LOAD2(B, PV, idn, (basen) + 4); } while (0)
#pragma unroll 1
        for (int b = 0; b < 56; b += 8) VSTEP(w0, b, id0, b + 8);
        VSTEP(w0, 56, id1, 0);
        const int col0 = (lane & 31) * 8 + hi * 4;
        const float* mp = mod_ptr(F, layer, t);
        v2u xr_[8]; f32x4 gf_[8];
#pragma unroll
        for (int j = 0; j < 8; ++j) { const int col = col0 + 256 * j; xr_[j] = *(const GAS v2u*)(X + (size_t)t * DM + col); gf_[j] = *(const GAS f32x4*)(mp + 5 * DM + col); }
#pragma unroll 1
        for (int b = 0; b < 56; b += 8) VSTEP(w1, b, id1, b + 8);
        VSTEP(w1, 56, id1, 56);
#undef LOAD2
#undef USTEP
#undef VSTEP
        float acc[32];
#pragma unroll
        for (int i = 0; i < 32; ++i) { auto rr = __builtin_amdgcn_permlane32_swap(__float_as_uint(av[i >> 1][i & 1]), __float_as_uint(av[16 + (i >> 1)][i & 1]), false, false);
            acc[i] = __uint_as_float(rr[0]) + __uint_as_float(rr[1]); }
        float xn[32]; float ss = 0.f;
#pragma unroll
        for (int j = 0; j < 8; ++j) {
            const v2u xr = xr_[j]; const f32x4 x0 = {bflo(xr.x), bfhi(xr.x), bflo(xr.y), bfhi(xr.y)}, gf = gf_[j];
            float* o = xn + 4 * j;
            o[0] = x0.x + gf.x * acc[4 * j]; o[1] = x0.y + gf.y * acc[4 * j + 1]; o[2] = x0.z + gf.z * acc[4 * j + 2]; o[3] = x0.w + gf.w * acc[4 * j + 3];
            ss += (o[0] * o[0] + o[1] * o[1]) + (o[2] * o[2] + o[3] * o[3]); }
        const float rs = 1.0f / sqrtf(wave_sum(ss) * (1.0f / DM) + EPS);
        if (layer == NLAYER - 1) {
#pragma unroll
            for (int j = 0; j < 8; ++j) { const int col = col0 + 256 * j; const float* o = xn + 4 * j;
                const f32x4 fg = *(const GAS f32x4*)(fg_ + col);
                *(GAS f32x4*)(out_ + (size_t)t * DM + col) = (f32x4){o[0] * rs * fg.x, o[1] * rs * fg.y, o[2] * rs * fg.z, o[3] * rs * fg.w}; }
        } else {
            const float* mn = mod_ptr(F, layer + 1, t);
#pragma unroll
            for (int j = 0; j < 8; ++j) { const int col = col0 + 256 * j; const float* o = xn + 4 * j;
                { v2u xw; xw.x = pk2(o[0], o[1]); xw.y = pk2(o[2], o[3]); *(GAS v2u*)(X + (size_t)t * DM + col) = xw; }
                const f32x4 sh = *(const GAS f32x4*)(mn + col), sc = *(const GAS f32x4*)(mn + DM + col);
                v2u w; w.x = pk2(o[0] * rs * (1.0f + sc.x) + sh.x, o[1] * rs * (1.0f + sc.y) + sh.y); w.y = pk2(o[2] * rs * (1.0f + sc.z) + sh.z, o[3] * rs * (1.0f + sc.w) + sh.w);
                *(GAS v2u*)(H + (size_t)t * DM + col) = w;
                *(GAS unsigned*)(F.ws + WS_H8 + (size_t)t * DM + col) = pk4_fp8(o[0] * rs * (1.0f + sc.x) + sh.x, o[1] * rs * (1.0f + sc.y) + sh.y, o[2] * rs * (1.0f + sc.z) + sh.z, o[3] * rs * (1.0f + sc.w) + sh.w); }
        }
    }
}

constexpr int PH_PER_LAYER = 10, PH_BASE = 3, N_PHASES = PH_BASE + NLAYER * PH_PER_LAYER;
struct Args { const float* in[18]; float* out; unsigned char* ws; int ph_lo, ph_hi; };
__global__ void __launch_bounds__(NWAVES * 64, 2) mk_fwd(Args args) {
    extern __shared__ __attribute__((aligned(16))) unsigned char lds[];
    unsigned char* const wsbase = args.ws;
    for (int u = threadIdx.x; u < (LDS_BYTES - LDSCTL_OFF) / 4; u += NWAVES * 64) ((LAS unsigned*)((LAS unsigned char*)lds + LDSCTL_OFF))[u] = 0u;
    __syncthreads();
    unsigned* ctl = (unsigned*)(args.ws + WS_CTL);
    XcdBarrier bar; bar.bar = ctl + CW_BAR; bar.x = 0; bar.st = nullptr;
#if !MK_PER_PHASE
    bar = xcd_barrier_post(ctl + CW_BAR, (volatile LAS unsigned*)((LAS unsigned char*)lds + MISC_OFF) + 8);
#endif
    const int lo = args.ph_lo, hi = args.ph_hi;
#ifndef PHM
#define PHM 0xFFFF
#endif
#define EN(b) ((PHM >> (b)) & 1)
#define IN(k) (lo <= (k) && (k) < hi)
#define SEAM(k) do { if (IN(k) && IN((k) + 1)) xcd_barrier(bar); } while (0)
    if (EN(0) && IN(0)) { Frame F = mkframe(lds, wsbase); phase_prologue(F); } SEAM(0);
    if (EN(1) && IN(1)) { Frame F = mkframe(lds, wsbase); phase_mod_finalize(F); } SEAM(1);
    if (EN(2) && IN(2)) { Frame F = mkframe(lds, wsbase); phase_modulate(F, 0, 0, TT, true, true); } SEAM(2);
#pragma unroll 1
    for (int layer = 0; layer < NLAYER; ++layer) {
        const int pb = PH_BASE + layer * PH_PER_LAYER;
        const bool lastl = (layer == NLAYER - 1);
        const int MR = lastl ? TL : TT;
        if (EN(3) && IN(pb + 0)) {
            Frame F = mkframe(lds, wsbase); bf16* P = (bf16*)(F.ws + WS_P); bf16* H = (bf16*)(F.ws + WS_H); (void)P; (void)H;
            {
                pg8::Gemm<DM, DM, DM, 0, 0, 2> g{H, F.ws + WS_WIN + (size_t)layer * 32 * MiB};
                pg8::SplitOrder S; S.S.init(MR, 4 * 256, F.G, F.bx); S.kind = 0; S.pm0 = 0; S.nMx = 0;
                pg8::EpiRow8<FStoreBf16> E{{P, INW, 1.0f}};
                pg8::gemm_phase(F.lds, g, S, E); }
            {
                pg8::Gemm<DM, DM, DM, 0, 0, 1> g{F.ws + WS_H8, F.ws + WS_WIN8 + (size_t)layer * 32 * MiB};
                pg8::SplitOrder S; S.S.init(MR, 28 * 256, F.G, F.G - 1 - F.bx); S.kind = 1; S.pm0 = TL / 256; S.nMx = 0;
                pg8::EpiRow8<FStoreBf16> E{{P, INW, 1.0f / W8_SCALE}};
                pg8::gemm_phase(F.lds, g, S, E);
                if (lastl)
                    for (int q = F.vcu; q < (TC / 128) * 8; q += F.G) pg8::gemm_quarter(F.lds, g, TL / 128 + (q >> 3), KVOFF / 128 + (q & 7), E); }
        }
        SEAM(pb + 0);
        if (EN(4) && IN(pb + 1)) { Frame F = mkframe(lds, wsbase); phase_post(F, layer); }
        SEAM(pb + 1);
        if (EN(5) && IN(pb + 2)) {
            Frame F = mkframe(lds, wsbase); bf16* P = (bf16*)(F.ws + WS_P); bf16* H = (bf16*)(F.ws + WS_H); (void)P; (void)H;
            if (!lastl) {
              pg8::Gemm<1024, 256, 256, 256, 1> g{(const bf16*)(F.ws + WS_POOLED), (const bf16*)(F.ws + WS_WPOOL + (size_t)layer * 1 * MiB)};
              pg8::EpiRow8<FPool> E{{(bf16*)(F.ws + WS_YB), P, inp<I_PSCALE>() + (size_t)layer * DM}};
              for (int q = F.vcu; q < (TC / 128) * (DM / 128); q += F.G) { const int grp = q >> 5, r = q & 31; pg8::gemm_quarter(F.lds, g, TL / 128 + (grp >> 1) * 4 + (r & 3), (grp & 1) * 8 + (r >> 2), E); } }
            phase_attention(F, layer, (char*)lds);
        }
        SEAM(pb + 2);
        if (EN(6) && IN(pb + 3)) {
            Frame F = mkframe(lds, wsbase); bf16* P = (bf16*)(F.ws + WS_P); bf16* H = (bf16*)(F.ws + WS_H); (void)P; (void)H;
            pg8::Gemm<DM, DM, DM, 0, 0, 1> g{F.ws + WS_AO, F.ws + WS_WBR8 + (size_t)layer * 32 * MiB};
            pg8::StaticOrder S; S.init(TL, DM, F.G, F.bx);
            pg8::EpiRow8<FMerge> E{{H, P, (const bf16*)(F.ws + WS_YB), 1.0f / (64.0f * W8_SCALE)}};
            {
                pg8::Gemm<1024, 256, 256, 256, 1> gp{(const bf16*)(F.ws + WS_POOLED), (const bf16*)(F.ws + WS_WPOOL + (size_t)layer * 1 * MiB)};
                pg8::MidRow8<FMid> Mx{{P, inp<I_PSCALE>() + (size_t)layer * DM, 64.0f * W8_SCALE}};
                pg8::EpiRow8<FMergeC> Ec{{H, P, 1.0f / (64.0f * W8_SCALE)}};
                pg8::gemm_chain(F.lds, gp, g, S, Mx, Ec); }
            if (!lastl)
                for (int q = F.vcu; q < (TC / 128) * (DM / 128); q += F.G) { const int grp = q >> 5, r = q & 31; pg8::gemm_quarter(F.lds, g, TL / 128 + (grp >> 1) * 4 + (r & 3), (grp & 1) * 8 + (r >> 2), E); }
        }
        SEAM(pb + 3);
        if (EN(7) && IN(pb + 4)) {
            Frame F = mkframe(lds, wsbase); bf16* P = (bf16*)(F.ws + WS_P); bf16* H = (bf16*)(F.ws + WS_H); (void)P; (void)H;
            pg8::Gemm<DM, DM, DM, 0, 0> g{H, (const bf16*)(F.ws + WS_WOUT + (size_t)layer * 8 * MiB)};
            pg8::StaticOrder S; S.init(TL, DM, F.G, F.bx);
            pg8::EpiRow8<FResid> E{{(bf16*)(F.ws + WS_X), inp<I_X>(), inp<I_CTX>(), (const float*)(F.ws + WS_MOD) + (size_t)layer * 9 * 6 * DM, layer == 0 ? 1 : 0}};
            pg8::gemm_phase(F.lds, g, S, E);
            if (!lastl)
                for (int q = F.vcu; q < (TC / 128) * (DM / 128); q += F.G) { const int grp = q >> 5, r = q & 31; pg8::gemm_quarter(F.lds, g, TL / 128 + (grp >> 1) * 4 + (r & 3), (grp & 1) * 8 + (r >> 2), E); }
        }
        SEAM(pb + 4);
        if (EN(8) && IN(pb + 5)) { Frame F = mkframe(lds, wsbase); phase_modulate(F, layer, 1, MR, false, false); }
        SEAM(pb + 5);
        if (EN(9) && IN(pb + 6)) {
            Frame F = mkframe(lds, wsbase); bf16* P = (bf16*)(F.ws + WS_P); bf16* H = (bf16*)(F.ws + WS_H); (void)P; (void)H;
            pg8::Gemm<DM, DM, DM, 0, 0> g{H, (const bf16*)(F.ws + WS_WQP + (size_t)layer * 8 * MiB)};
            pg8::StaticOrder S; S.init(TL, DM, F.G, F.bx);
            pg8::EpiRow8<FStoreBf16> E{{(bf16*)(F.ws + WS_P + P_QP), DM, 1.0f}};
            pg8::gemm_phase(F.lds, g, S, E);
            if (!lastl)
                for (int q = F.vcu; q < (TC / 128) * (DM / 128); q += F.G) { const int grp = q >> 5, r = q & 31; pg8::gemm_quarter(F.lds, g, TL / 128 + (grp >> 1) * 4 + (r & 3), (grp & 1) * 8 + (r >> 2), E); }
        }
        if (IN(pb + 6) && IN(pb + 8)) xcd_barrier(bar);
        if (EN(11) && IN(pb + 8)) { Frame F = mkframe(lds, wsbase); phase_pk(F, layer, MR); }
        SEAM(pb + 8);
        if (EN(12) && IN(pb + 9)) { Frame F = mkframe(lds, wsbase); phase_peer(F, layer, MR); }
        if (!lastl) SEAM(pb + 9);
    }
#undef IN
#undef SEAM
}

extern "C" void kernel_launch(void* const* d_in, const int* in_sizes, int n_in, void* d_out, int out_size, void* d_ws, size_t ws_size, hipStream_t stream) {
    static int grid = 0;
    if (grid == 0) {
        if (n_in != 18 || out_size != TL * DM || ws_size < WS_END) { fprintf(stderr, "kernel_launch: unexpected shapes (n_in %d out %d ws %zu need %zu)\n", n_in, out_size, ws_size, (size_t)WS_END); grid = -1; return; }
        int dev = 0, cus = 0, per_cu = 0;
        if (hipGetDevice(&dev) != hipSuccess || hipDeviceGetAttribute(&cus, hipDeviceAttributeMultiprocessorCount, dev) != hipSuccess) { grid = -1; return; }
        if (hipFuncSetAttribute((const void*)mk_fwd, hipFuncAttributeMaxDynamicSharedMemorySize, LDS_BYTES) != hipSuccess) { fprintf(stderr, "kernel_launch: hipFuncSetAttribute failed\n"); grid = -1; return; }
        if (hipOccupancyMaxActiveBlocksPerMultiprocessor(&per_cu, (const void*)mk_fwd, NWAVES * 64, LDS_BYTES) != hipSuccess || per_cu < 1)
            fprintf(stderr, "kernel_launch: occupancy query reports %d\n", per_cu);
        (void)hipGetLastError();
        grid = cus;
    }
    if (grid < 0) return;
    if (hipMemsetAsync((char*)d_ws + WS_CTL, 0, CTL_ZERO_BYTES, stream) != hipSuccess) return;
    Args a{};
    for (int i = 0; i < 18; ++i) a.in[i] = (const float*)d_in[i];
    a.out = (float*)d_out; a.ws = (unsigned char*)d_ws;
#if MK_PER_PHASE
    for (int p = 0; p < N_PHASES; ++p) { a.ph_lo = p; a.ph_hi = p + 1; hipLaunchKernelGGL(mk_fwd, dim3(grid), dim3(NWAVES * 64), LDS_BYTES, stream, a); }
#else
    a.ph_lo = 0; a.ph_hi = N_PHASES;
    hipLaunchKernelGGL(mk_fwd, dim3(grid), dim3(NWAVES * 64), LDS_BYTES, stream, a);
#endif
    const hipError_t le = hipPeekAtLastError();
    if (le != hipSuccess) fprintf(stderr, "kernel_launch: launch failed: %s\n", hipGetErrorName(le));
}
```

```cpp
#include <hip/hip_runtime.h>
#include <cstdio>
#include <cstdint>

#ifndef MK_PER_PHASE
#define MK_PER_PHASE 0
#endif

namespace pg8 {
#define PG8_LAS __attribute__((address_space(3)))
typedef unsigned short bf16_t;
typedef short bf16x8 __attribute__((ext_vector_type(8)));
typedef float f32x4 __attribute__((ext_vector_type(4)));
typedef unsigned u32x4 __attribute__((ext_vector_type(4)));
constexpr int BM = 256, BK = 64, HALF = 128, HTB = HALF * BK * 2, STAGE_BYTES = 8 * HTB, NXCD = 8, WGM = 8;

__host__ __device__ __forceinline__ int lds_byte(int r, int c) { const int st = (r >> 4) * 2 + (c >> 5), rr = r & 15, cc = c & 31, ob = rr * 64 + cc * 2; return st * 1024 + (ob ^ (((ob >> 9) & 1) << 5)); }
__host__ __device__ __forceinline__ void stage_rc(int b, int& R, int& C) { const int st = b / 1024, sb = b % 1024, swz = sb ^ (((sb >> 9) & 1) << 5); R = (st >> 1) * 16 + swz / 64; C = (st & 1) * 32 + (swz % 64) / 2; }
__host__ __device__ __forceinline__ int perm32(int rho) { const int n = rho >> 4, i = rho & 15; return 8 * (i >> 2) + 4 * n + (i & 3); }

struct Unit { int pm, pn; };
template <int LDA, int LDB, int KK, int AKSTEP, int AKSHIFT, int EB_ = 2> struct Gemm { const void* A; const void* Bt;
    static constexpr int lda = LDA, ldb = LDB, K = KK, akstep = AKSTEP, akshift = AKSHIFT, EB = EB_; };

struct StaticOrder {
    int nM, nN, nwg, G, c;
    __device__ void init(int M, int N, int G_, int c_) { nM = M / BM; nN = N / BM; nwg = nM * nN; G = G_; c = c_; }
    __device__ bool next(int i, Unit& u) const {
        const long L = (long)i * G + c; if (L >= nwg) return false;
        int wgid = (int)L; { const int q = nwg / NXCD, r = nwg % NXCD, xcd = wgid % NXCD, off = wgid / NXCD; wgid = (xcd < r ? xcd * (q + 1) : r * (q + 1) + (xcd - r) * q) + off; }
        const int nig = WGM * nN, gid = wgid / nig, fm = gid * WGM, gsz = (nM - fm) < WGM ? (nM - fm) : WGM;
        u.pm = fm + ((wgid % nig) % gsz); u.pn = (wgid % nig) / gsz; return true;
    }
};
struct SplitOrder {
    StaticOrder S; int kind, pm0, nMx;
    __device__ bool next(int i, Unit& u) const {
        const long L = (long)i * S.G + S.c;
        if (L < S.nwg) { S.next(i, u); u.pn = kind == 0 ? 12 + u.pn : (u.pn < 12 ? u.pn : u.pn + 4); return true; }
        const int j = (int)(L - S.nwg); if (j >= nMx * 4) return false;
        u.pm = pm0 + j / 4; u.pn = 8 + j % 4; return true;
    }
};

template <class F> struct EpiRow8 {
    static constexpr bool PERM = true;
    F f;
    __device__ __forceinline__ void operator()(const f32x4 (&acc)[2][2][4][2], const Unit& u, int wr, int wc, int fr, int fq) const {
        const int row0 = u.pm * BM + wr * 64 + fr, col0 = u.pn * BM + wc * 32 + 8 * fq;
        typename F::Col cp[2];
#pragma unroll
        for (int bj = 0; bj < 2; ++bj) cp[bj] = f.col_load(row0, col0 + bj * HALF);
#pragma unroll
        for (int ai = 0; ai < 2; ++ai) {
            typename F::Pre pre[4][2];
#pragma unroll
            for (int m = 0; m < 4; ++m)
#pragma unroll
                for (int bj = 0; bj < 2; ++bj) pre[m][bj] = f.load(row0 + ai * HALF + m * 16, col0 + bj * HALF);
#pragma unroll
            for (int m = 0; m < 4; ++m)
#pragma unroll
                for (int bj = 0; bj < 2; ++bj) f.apply(row0 + ai * HALF + m * 16, col0 + bj * HALF, acc[ai][bj][m][0], acc[ai][bj][m][1], pre[m][bj], cp[bj]);
            asm volatile("" ::: "memory");
        }
    }
    __device__ __forceinline__ void quarter(const f32x4 (&acc)[1][1][4][2], int rowo, int colo, int wr, int wc, int fr, int fq) const {
        const int row0 = rowo + wr * 64 + fr, col0 = colo + wc * 32 + 8 * fq;
        const typename F::Col cp = f.col_load(row0, col0);
        typename F::Pre pre[4];
#pragma unroll
        for (int m = 0; m < 4; ++m) pre[m] = f.load(row0 + m * 16, col0);
#pragma unroll
        for (int m = 0; m < 4; ++m) f.apply(row0 + m * 16, col0, acc[0][0][m][0], acc[0][0][m][1], pre[m], cp);
    }
};

template <class F> struct MidRow8 {
    F f;
    __device__ __forceinline__ void operator()(f32x4 (&acc)[2][2][4][2], const Unit& u, int wr, int wc, int fr, int fq) const {
        const int row0 = u.pm * BM + wr * 64 + fr, col0 = u.pn * BM + wc * 32 + 8 * fq;
        typename F::Col cp[2];
#pragma unroll
        for (int bj = 0; bj < 2; ++bj) cp[bj] = f.col_load(row0, col0 + bj * HALF);
#pragma unroll
        for (int ai = 0; ai < 2; ++ai) {
            typename F::Pre pre[4][2];
#pragma unroll
            for (int m = 0; m < 4; ++m)
#pragma unroll
                for (int bj = 0; bj < 2; ++bj) pre[m][bj] = f.load(row0 + ai * HALF + m * 16, col0 + bj * HALF);
#pragma unroll
            for (int m = 0; m < 4; ++m)
#pragma unroll
                for (int bj = 0; bj < 2; ++bj) f.xform(acc[ai][bj][m][0], acc[ai][bj][m][1], pre[m][bj], cp[bj]);
            asm volatile("" ::: "memory");
        }
    }
};
struct BlockOrder {
    int pm0, nM, nN, G, c;
    __device__ bool next(int i, Unit& u) const { const long k = (long)i * G + c; if (k >= (long)nM * nN) return false; u.pm = pm0 + (int)(k / nN); u.pn = (int)(k % nN); return true; }
};

template <class GemmT, class Epi, class Sched>
__device__ __forceinline__ void gemm_phase(PG8_LAS unsigned char* lds, const GemmT g, const Sched& S, const Epi& E) {
    int tid_ = threadIdx.x; asm volatile("" : "+v"(tid_));
    const int tid = tid_, wid = __builtin_amdgcn_readfirstlane(tid >> 6), lane = tid & 63, wr = wid >> 2, wc = wid & 3, fr = lane & 15, fq = lane >> 4;
    constexpr int K = GemmT::K, EB = GemmT::EB, nt = K * EB / 128;
    typedef int v8i __attribute__((ext_vector_type(8))); typedef int v4i __attribute__((ext_vector_type(4)));
    unsigned voffA[2], voffB[2];
#pragma unroll
    for (int i = 0; i < 2; ++i) { int R, C; stage_rc(tid * 16 + i * 8192, R, C); const int Rb = Epi::PERM ? ((R & ~31) + perm32(R & 31)) : R;
        voffA[i] = (unsigned)(R * GemmT::lda * EB + C * 2); voffB[i] = (unsigned)(Rb * GemmT::ldb * EB + C * 2); }
    constexpr size_t kstep = (size_t)(BK * 2);
    constexpr size_t hstepA = (size_t)HALF * GemmT::lda * EB, hstepB = (size_t)HALF * GemmT::ldb * EB;
    constexpr size_t tstepA = 2 * hstepA, tstepB = 2 * hstepB;
    constexpr size_t akb = (size_t)GemmT::akstep * EB;
    const unsigned ldsw = (unsigned)wid * 1024u;
    const int aoff0 = lds_byte(wr * 64 + fr, EB == 2 ? fq * 8 : fq * 16) + (EB == 2 ? 0 : 16 * (fq & 1)), boff0 = lds_byte(wc * 32 + fr, EB == 2 ? fq * 8 : fq * 16) + (EB == 2 ? 0 : 16 * (fq & 1));
    const int aoff1 = EB == 2 ? aoff0 + 1024 : (aoff0 ^ 16), boff1 = EB == 2 ? boff0 + 1024 : (boff0 ^ 16);
#define PG8_SA(b, h) (((b) * 2 + (h)) * HTB)
#define PG8_SB(b, h) ((4 + (b) * 2 + (h)) * HTB)
#define PG8_STAGE(bufoff, gbase, voff) do { _Pragma("unroll") for (int _i = 0; _i < 2; ++_i) \
        __builtin_amdgcn_global_load_lds((const unsigned*)((const char*)(gbase) + (voff)[_i]), (PG8_LAS unsigned*)(lds + (bufoff) + ldsw + _i * 8192), 16, 0, 0); } while (0)
#define PG8_LDA(dst, b, h) do { _Pragma("unroll") for (int m = 0; m < 4; ++m) { const v4i l_ = *(const PG8_LAS v4i*)(lds + PG8_SA(b, h) + aoff0 + m * 2048), h_ = *(const PG8_LAS v4i*)(lds + PG8_SA(b, h) + aoff1 + m * 2048); dst[m] = __builtin_shufflevector(l_, h_, 0, 1, 2, 3, 4, 5, 6, 7); } } while (0)
#define PG8_LDB(dst, b, h) do { _Pragma("unroll") for (int n = 0; n < 2; ++n) { const v4i l_ = *(const PG8_LAS v4i*)(lds + PG8_SB(b, h) + boff0 + n * 2048), h_ = *(const PG8_LAS v4i*)(lds + PG8_SB(b, h) + boff1 + n * 2048); dst[n] = __builtin_shufflevector(l_, h_, 0, 1, 2, 3, 4, 5, 6, 7); } } while (0)
#define PG8_LO(v) __builtin_bit_cast(bf16x8, __builtin_shufflevector(v, v, 0, 1, 2, 3))
#define PG8_HI(v) __builtin_bit_cast(bf16x8, __builtin_shufflevector(v, v, 4, 5, 6, 7))
#define PG8_MMA(ai, bj, At, Bt) do { __builtin_amdgcn_s_setprio(1); _Pragma("unroll") for (int m = 0; m < 4; ++m) _Pragma("unroll") for (int n = 0; n < 2; ++n) { \
        if constexpr (EB == 2) { acc[ai][bj][m][n] = __builtin_amdgcn_mfma_f32_16x16x32_bf16(PG8_LO(Bt[n]), PG8_LO(At[m]), acc[ai][bj][m][n], 0, 0, 0); \
                                 acc[ai][bj][m][n] = __builtin_amdgcn_mfma_f32_16x16x32_bf16(PG8_HI(Bt[n]), PG8_HI(At[m]), acc[ai][bj][m][n], 0, 0, 0); } \
        else asm volatile("v_mfma_f32_16x16x128_f8f6f4 %0, %1, %2, %0" : "+v"(acc[ai][bj][m][n]) : "v"(Bt[n]), "v"(At[m])); } __builtin_amdgcn_s_setprio(0); } while (0)
#define PG8_WAIT_V(n) asm volatile("s_waitcnt vmcnt(" #n ")" ::: "memory")
#define PG8_WAIT_L(n) asm volatile("s_waitcnt lgkmcnt(" #n ")" ::: "memory")
#define PG8_BAR __builtin_amdgcn_s_barrier()
#define PG8_SCHED __builtin_amdgcn_sched_barrier(0)
    Unit cur, nxt; int ui = 0;
    if (!S.next(0, cur)) return;
    f32x4 acc[2][2][4][2];
#pragma unroll
    for (int a = 0; a < 2; ++a)
#pragma unroll
        for (int b = 0; b < 2; ++b)
#pragma unroll
            for (int m = 0; m < 4; ++m)
#pragma unroll
                for (int n = 0; n < 2; ++n) acc[a][b][m][n] = (f32x4){0.f, 0.f, 0.f, 0.f};
    v8i At[4], B0[2], B1[2];
    const char* cA = (const char*)g.A + (size_t)cur.pm * tstepA + (size_t)(cur.pn >> GemmT::akshift) * akb; const char* cB = (const char*)g.Bt + (size_t)cur.pn * tstepB;
    PG8_STAGE(PG8_SB(0, 0), cB, voffB); PG8_STAGE(PG8_SB(0, 1), cB + hstepB, voffB); PG8_STAGE(PG8_SA(0, 0), cA, voffA); PG8_STAGE(PG8_SA(0, 1), cA + hstepA, voffA);
    if (wr == 1) PG8_BAR;
    PG8_WAIT_V(0); PG8_BAR;
    PG8_STAGE(PG8_SB(1, 0), cB + kstep, voffB); PG8_STAGE(PG8_SB(1, 1), cB + hstepB + kstep, voffB);
    PG8_BAR;
    for (;;) {
        const bool has_next = S.next(ui + 1, nxt);
        const char* nA = has_next ? (const char*)g.A + (size_t)nxt.pm * tstepA + (size_t)(nxt.pn >> GemmT::akshift) * akb : cA; const char* nB = has_next ? (const char*)g.Bt + (size_t)nxt.pn * tstepB : cB;
#pragma unroll 1
        for (int t = 0; t < nt; t += 2) {
            const bool last = (t == nt - 2);
            const char* a1 = cA + (size_t)(t + 1) * kstep;
            const char* a2 = last ? nA : cA + (size_t)(t + 2) * kstep; const char* b2 = last ? nB : cB + (size_t)(t + 2) * kstep;
            const char* b3 = b2 + kstep;
            PG8_LDB(B0, 0, 0); PG8_LDB(B1, 0, 1); PG8_SCHED; PG8_LDA(At, 0, 0); PG8_STAGE(PG8_SA(1, 0), a1, voffA); PG8_STAGE(PG8_SA(1, 1), a1 + hstepA, voffA);
            PG8_WAIT_V(8); PG8_WAIT_L(0); PG8_BAR; PG8_MMA(0, 0, At, B0); PG8_MMA(0, 1, At, B1); PG8_BAR; PG8_SCHED;
            PG8_LDA(At, 0, 1); PG8_STAGE(PG8_SB(0, 0), b2, voffB); PG8_STAGE(PG8_SB(0, 1), b2 + hstepB, voffB);
            PG8_WAIT_V(6); PG8_WAIT_L(0); PG8_BAR; PG8_MMA(1, 0, At, B0); PG8_MMA(1, 1, At, B1); PG8_BAR; PG8_SCHED;
            PG8_LDB(B0, 1, 0); PG8_LDB(B1, 1, 1); PG8_SCHED; PG8_LDA(At, 1, 0); PG8_STAGE(PG8_SA(0, 0), a2, voffA); PG8_STAGE(PG8_SA(0, 1), a2 + hstepA, voffA);
            PG8_WAIT_V(8); PG8_WAIT_L(0); PG8_BAR; PG8_MMA(0, 0, At, B0); PG8_MMA(0, 1, At, B1); PG8_BAR; PG8_SCHED;
            PG8_LDA(At, 1, 1); PG8_STAGE(PG8_SB(1, 0), b3, voffB); PG8_STAGE(PG8_SB(1, 1), b3 + hstepB, voffB);
            PG8_WAIT_V(6); PG8_WAIT_L(0); PG8_BAR; PG8_MMA(1, 0, At, B0); PG8_MMA(1, 1, At, B1); PG8_BAR; PG8_SCHED;
        }
        if (wr == 0) PG8_BAR;
        if constexpr (EB == 1) asm volatile("s_nop 15\n\ts_nop 15" ::: "memory");
        E(acc, cur, wr, wc, fr, fq);
        if (!has_next) break;
#pragma unroll
        for (int a = 0; a < 2; ++a)
#pragma unroll
            for (int b = 0; b < 2; ++b)
#pragma unroll
                for (int m = 0; m < 4; ++m)
#pragma unroll
                    for (int n = 0; n < 2; ++n) acc[a][b][m][n] = (f32x4){0.f, 0.f, 0.f, 0.f};
        cur = nxt; cA = nA; cB = nB; ++ui;
        if (wr == 1) PG8_BAR;
    }
    PG8_WAIT_V(0);
    PG8_BAR;
}
template <class GP, class GM, class Mid, class Epi, class Sched>
__device__ __forceinline__ void gemm_chain(PG8_LAS unsigned char* lds, const GP gp, const GM gm, const Sched& S, const Mid& M, const Epi& E) {
    static_assert(GP::EB == 2 && GM::EB == 1 && GP::lda * 2 == GM::lda, "chain: bf16 prefix, fp8 main, equal A row strides in bytes");
    int tid_ = threadIdx.x; asm volatile("" : "+v"(tid_));
    const int tid = tid_, wid = __builtin_amdgcn_readfirstlane(tid >> 6), lane = tid & 63, wr = wid >> 2, wc = wid & 3, fr = lane & 15, fq = lane >> 4;
    constexpr int ntp = GP::K * 2 / 128, ntm = GM::K / 128;
    static_assert(ntp == 4 && ntm % 2 == 0, "chain: prefix of two trips");
    typedef int v8i __attribute__((ext_vector_type(8))); typedef int v4i __attribute__((ext_vector_type(4)));
    unsigned voffA[2], voffBp[2], voffBm[2];
#pragma unroll
    for (int i = 0; i < 2; ++i) { int R, C; stage_rc(tid * 16 + i * 8192, R, C); const int Rb = (R & ~31) + perm32(R & 31);
        voffA[i] = (unsigned)(R * GM::lda + C * 2); voffBp[i] = (unsigned)(Rb * GP::ldb * 2 + C * 2); voffBm[i] = (unsigned)(Rb * GM::ldb + C * 2); }
    constexpr size_t kstep = (size_t)(BK * 2);
    constexpr size_t hstepA = (size_t)HALF * GM::lda, hstepBp = (size_t)HALF * GP::ldb * 2, hstepBm = (size_t)HALF * GM::ldb;
    constexpr size_t tstepA = 2 * hstepA, tstepBp = 2 * hstepBp, tstepBm = 2 * hstepBm;
    constexpr size_t akbp = (size_t)GP::akstep * 2;
    const unsigned ldsw = (unsigned)wid * 1024u;
#define PC_OFFS_P() int lq_ = tid; asm volatile("" : "+v"(lq_)); const int frq_ = lq_ & 15, fqq_ = (lq_ >> 4) & 3; \
    const int aoffP0 = lds_byte(wr * 64 + frq_, fqq_ * 8), boffP0 = lds_byte(wc * 32 + frq_, fqq_ * 8), aoffP1 = aoffP0 + 1024, boffP1 = boffP0 + 1024
#define PC_OFFS_M() int lm_ = tid; asm volatile("" : "+v"(lm_)); const int frm_ = lm_ & 15, fqm_ = (lm_ >> 4) & 3; \
    const int aoffM0 = lds_byte(wr * 64 + frm_, fqm_ * 16) + 16 * (fqm_ & 1), boffM0 = lds_byte(wc * 32 + frm_, fqm_ * 16) + 16 * (fqm_ & 1), aoffM1 = aoffM0 ^ 16, boffM1 = boffM0 ^ 16
#define PC_LDA(dst, b, h, o0, o1) do { _Pragma("unroll") for (int m = 0; m < 4; ++m) { const v4i l_ = *(const PG8_LAS v4i*)(lds + PG8_SA(b, h) + (o0) + m * 2048), h_ = *(const PG8_LAS v4i*)(lds + PG8_SA(b, h) + (o1) + m * 2048); dst[m] = __builtin_shufflevector(l_, h_, 0, 1, 2, 3, 4, 5, 6, 7); } } while (0)
#define PC_LDB(dst, b, h, o0, o1) do { _Pragma("unroll") for (int n = 0; n < 2; ++n) { const v4i l_ = *(const PG8_LAS v4i*)(lds + PG8_SB(b, h) + (o0) + n * 2048), h_ = *(const PG8_LAS v4i*)(lds + PG8_SB(b, h) + (o1) + n * 2048); dst[n] = __builtin_shufflevector(l_, h_, 0, 1, 2, 3, 4, 5, 6, 7); } } while (0)
#define PC_MMA(EBv, ai, bj, At, Bt) do { __builtin_amdgcn_s_setprio(1); _Pragma("unroll") for (int m = 0; m < 4; ++m) _Pragma("unroll") for (int n = 0; n < 2; ++n) { \
        if constexpr (EBv == 2) { acc[ai][bj][m][n] = __builtin_amdgcn_mfma_f32_16x16x32_bf16(PG8_LO(Bt[n]), PG8_LO(At[m]), acc[ai][bj][m][n], 0, 0, 0); \
                                  acc[ai][bj][m][n] = __builtin_amdgcn_mfma_f32_16x16x32_bf16(PG8_HI(Bt[n]), PG8_HI(At[m]), acc[ai][bj][m][n], 0, 0, 0); } \
        else asm volatile("v_mfma_f32_16x16x128_f8f6f4 %0, %1, %2, %0" : "+v"(acc[ai][bj][m][n]) : "v"(Bt[n]), "v"(At[m])); } __builtin_amdgcn_s_setprio(0); } while (0)
#define PC_TRIP(EBv, A0, A1, B0o, B1o, a1_, a2_, b2_, voffBn, hstepBn) do { const char* a3_ = (a2_) + kstep; const char* b3_ = (b2_) + kstep; \
        PC_LDB(B0, 0, 0, B0o, B1o); PC_LDB(B1, 0, 1, B0o, B1o); PG8_SCHED; PC_LDA(At, 0, 0, A0, A1); PG8_STAGE(PG8_SA(1, 1), (a1_) + hstepA, voffA); \
        PG8_WAIT_V(8); PG8_WAIT_L(0); PG8_BAR; PC_MMA(EBv, 0, 0, At, B0); PC_MMA(EBv, 0, 1, At, B1); PG8_BAR; PG8_SCHED; \
        PC_LDA(At, 0, 1, A0, A1); PG8_STAGE(PG8_SB(0, 0), (b2_), voffBn); PG8_STAGE(PG8_SB(0, 1), (b2_) + (hstepBn), voffBn); PG8_STAGE(PG8_SA(0, 0), (a2_), voffA); \
        PG8_WAIT_V(8); PG8_WAIT_L(0); PG8_BAR; PC_MMA(EBv, 1, 0, At, B0); PC_MMA(EBv, 1, 1, At, B1); PG8_BAR; PG8_SCHED; \
        PC_LDB(B0, 1, 0, B0o, B1o); PC_LDB(B1, 1, 1, B0o, B1o); PG8_SCHED; PC_LDA(At, 1, 0, A0, A1); PG8_STAGE(PG8_SA(0, 1), (a2_) + hstepA, voffA); \
        PG8_WAIT_V(8); PG8_WAIT_L(0); PG8_BAR; PC_MMA(EBv, 0, 0, At, B0); PC_MMA(EBv, 0, 1, At, B1); PG8_BAR; PG8_SCHED; \
        PC_LDA(At, 1, 1, A0, A1); PG8_STAGE(PG8_SB(1, 0), b3_, voffBn); PG8_STAGE(PG8_SB(1, 1), b3_ + (hstepBn), voffBn); PG8_STAGE(PG8_SA(1, 0), a3_, voffA); \
        PG8_WAIT_V(8); PG8_WAIT_L(0); PG8_BAR; PC_MMA(EBv, 1, 0, At, B0); PC_MMA(EBv, 1, 1, At, B1); PG8_BAR; PG8_SCHED; } while (0)
    Unit cur, nxt; int ui = 0;
    if (!S.next(0, cur)) return;
    f32x4 acc[2][2][4][2];
#pragma unroll
    for (int a = 0; a < 2; ++a)
#pragma unroll
        for (int b = 0; b < 2; ++b)
#pragma unroll
            for (int m = 0; m < 4; ++m)
#pragma unroll
                for (int n = 0; n < 2; ++n) acc[a][b][m][n] = (f32x4){0.f, 0.f, 0.f, 0.f};
    v8i At[4], B0[2], B1[2];
    const char* cAp = (const char*)gp.A + (size_t)cur.pm * tstepA + (size_t)(cur.pn >> GP::akshift) * akbp; const char* cBp = (const char*)gp.Bt + (size_t)cur.pn * tstepBp;
    PG8_STAGE(PG8_SB(0, 0), cBp, voffBp); PG8_STAGE(PG8_SB(0, 1), cBp + hstepBp, voffBp); PG8_STAGE(PG8_SA(0, 0), cAp, voffA); PG8_STAGE(PG8_SA(0, 1), cAp + hstepA, voffA);
    if (wr == 1) PG8_BAR;
    PG8_WAIT_V(2); PG8_BAR;
    PG8_STAGE(PG8_SB(1, 0), cBp + kstep, voffBp); PG8_STAGE(PG8_SA(1, 0), cAp + kstep, voffA); PG8_STAGE(PG8_SB(1, 1), cBp + hstepBp + kstep, voffBp);
    PG8_WAIT_V(6); PG8_BAR;
    for (;;) {
        const bool has_next = S.next(ui + 1, nxt);
        const char* nAp = has_next ? (const char*)gp.A + (size_t)nxt.pm * tstepA + (size_t)(nxt.pn >> GP::akshift) * akbp : cAp; const char* nBp = has_next ? (const char*)gp.Bt + (size_t)nxt.pn * tstepBp : cBp;
        const char* cAm = (const char*)gm.A + (size_t)cur.pm * tstepA; const char* cBm = (const char*)gm.Bt + (size_t)cur.pn * tstepBm;
        {   PC_OFFS_P();
#pragma unroll 1
            for (int t = 0; t < ntp; t += 2) {
                const bool last = (t == ntp - 2);
                unsigned voffBn[2]; voffBn[0] = last ? voffBm[0] : voffBp[0]; voffBn[1] = last ? voffBm[1] : voffBp[1];
                const size_t hstepBn = last ? hstepBm : hstepBp;
                const char* a2 = last ? cAm : cAp + (size_t)(t + 2) * kstep; const char* b2 = last ? cBm : cBp + (size_t)(t + 2) * kstep;
                PC_TRIP(2, aoffP0, aoffP1, boffP0, boffP1, cAp + (size_t)(t + 1) * kstep, a2, b2, voffBn, hstepBn);
            } }
        M(acc, cur, wr, wc, fr, fq);
        PC_OFFS_M();
#pragma unroll 1
        for (int t = 0; t < ntm; t += 2) {
            const bool last = (t == ntm - 2);
            unsigned voffBn[2]; voffBn[0] = last ? voffBp[0] : voffBm[0]; voffBn[1] = last ? voffBp[1] : voffBm[1];
            const size_t hstepBn = last ? hstepBp : hstepBm;
            const char* a2 = last ? nAp : cAm + (size_t)(t + 2) * kstep; const char* b2 = last ? nBp : cBm + (size_t)(t + 2) * kstep;
            PC_TRIP(1, aoffM0, aoffM1, boffM0, boffM1, cAm + (size_t)(t + 1) * kstep, a2, b2, voffBn, hstepBn);
        }
        if (wr == 0) PG8_BAR;
        asm volatile("s_nop 15\n\ts_nop 15" ::: "memory");
        {   Unit cue = cur; asm volatile("" : "+s"(cue.pm), "+s"(cue.pn));
            E(acc, cue, wr, wc, fr, fq); }
        if (!has_next) break;
#pragma unroll
        for (int a = 0; a < 2; ++a)
#pragma unroll
            for (int b = 0; b < 2; ++b)
#pragma unroll
                for (int m = 0; m < 4; ++m)
#pragma unroll
                    for (int n = 0; n < 2; ++n) acc[a][b][m][n] = (f32x4){0.f, 0.f, 0.f, 0.f};
        cur = nxt; cAp = nAp; cBp = nBp; ++ui;
        if (wr == 1) PG8_BAR;
    }
    PG8_WAIT_V(0);
    PG8_BAR;
#undef PC_LDA
#undef PC_LDB
#undef PC_MMA
#undef PC_TRIP
#undef PC_OFFS_P
#undef PC_OFFS_M
}
template <class GemmT, class Epi>
__device__ __forceinline__ void gemm_quarter(PG8_LAS unsigned char* lds, const GemmT g, int qm, int qn, const Epi& E) {
    int tid_ = threadIdx.x; asm volatile("" : "+v"(tid_));
    const int tid = tid_, wid = __builtin_amdgcn_readfirstlane(tid >> 6), lane = tid & 63, wr = wid >> 2, wc = wid & 3, fr = lane & 15, fq = lane >> 4;
    constexpr int K = GemmT::K, EB = GemmT::EB, nt = K * EB / 128;
    static_assert(nt % 4 == 0 && nt >= 4, "quarter unit: K-tiles in groups of four");
    typedef int v8i __attribute__((ext_vector_type(8))); typedef int v4i __attribute__((ext_vector_type(4)));
    unsigned voffA[2], voffB[2];
#pragma unroll
    for (int i = 0; i < 2; ++i) { int R, C; stage_rc(tid * 16 + i * 8192, R, C); const int Rb = Epi::PERM ? ((R & ~31) + perm32(R & 31)) : R;
        voffA[i] = (unsigned)(R * GemmT::lda * EB + C * 2); voffB[i] = (unsigned)(Rb * GemmT::ldb * EB + C * 2); }
    constexpr size_t kstep = (size_t)(BK * 2);
    constexpr size_t hstepA = (size_t)HALF * GemmT::lda * EB, hstepB = (size_t)HALF * GemmT::ldb * EB;
    const unsigned ldsw = (unsigned)wid * 1024u;
    const int aoff0 = lds_byte(wr * 64 + fr, EB == 2 ? fq * 8 : fq * 16) + (EB == 2 ? 0 : 16 * (fq & 1)), boff0 = lds_byte(wc * 32 + fr, EB == 2 ? fq * 8 : fq * 16) + (EB == 2 ? 0 : 16 * (fq & 1));
    const int aoff1 = EB == 2 ? aoff0 + 1024 : (aoff0 ^ 16), boff1 = EB == 2 ? boff0 + 1024 : (boff0 ^ 16);
    const char* cA = (const char*)g.A + (size_t)qm * hstepA + (size_t)((qn >> 1) >> GemmT::akshift) * GemmT::akstep * EB; const char* cB = (const char*)g.Bt + (size_t)qn * hstepB;
    f32x4 acc[1][1][4][2];
#pragma unroll
    for (int m = 0; m < 4; ++m)
#pragma unroll
        for (int n = 0; n < 2; ++n) acc[0][0][m][n] = (f32x4){0.f, 0.f, 0.f, 0.f};
    v8i At[4], B0[2];
#define PG8Q_LDA(dst, s) do { _Pragma("unroll") for (int m = 0; m < 4; ++m) { const v4i l_ = *(const PG8_LAS v4i*)(lds + (s) * HTB + aoff0 + m * 2048), h_ = *(const PG8_LAS v4i*)(lds + (s) * HTB + aoff1 + m * 2048); dst[m] = __builtin_shufflevector(l_, h_, 0, 1, 2, 3, 4, 5, 6, 7); } } while (0)
#define PG8Q_LDB(dst, s) do { _Pragma("unroll") for (int n = 0; n < 2; ++n) { const v4i l_ = *(const PG8_LAS v4i*)(lds + (4 + (s)) * HTB + boff0 + n * 2048), h_ = *(const PG8_LAS v4i*)(lds + (4 + (s)) * HTB + boff1 + n * 2048); dst[n] = __builtin_shufflevector(l_, h_, 0, 1, 2, 3, 4, 5, 6, 7); } } while (0)
#pragma unroll
    for (int s = 0; s < 3; ++s) { PG8_STAGE(s * HTB, cA + (size_t)s * kstep, voffA); PG8_STAGE((4 + s) * HTB, cB + (size_t)s * kstep, voffB); }
#pragma unroll 1
    for (int t = 0; t < nt; t += 4) {
#pragma unroll
        for (int s = 0; s < 4; ++s) {
            PG8_WAIT_V(8); PG8_BAR;
            const int nx = (t + s + 3 < nt) ? (t + s + 3) : (nt - 1);
            PG8_STAGE(((s + 3) & 3) * HTB, cA + (size_t)nx * kstep, voffA); PG8_STAGE((4 + ((s + 3) & 3)) * HTB, cB + (size_t)nx * kstep, voffB);
            PG8Q_LDB(B0, s); PG8Q_LDA(At, s);
            PG8_WAIT_L(0); PG8_SCHED; PG8_MMA(0, 0, At, B0); PG8_SCHED;
        }
    }
    if constexpr (EB == 1) asm volatile("s_nop 15\n\ts_nop 15" ::: "memory");
    E.quarter(acc, qm * HALF, qn * HALF, wr, wc, fr, fq);
    PG8_WAIT_V(0);
    PG8_BAR;
#undef PG8Q_LDA
#undef PG8Q_LDB
#undef PG8_SA
#undef PG8_SB
#undef PG8_STAGE
#undef PG8_LDA
#undef PG8_LDB
#undef PG8_MMA
#undef PG8_LO
#undef PG8_HI
#undef PG8_WAIT_V
#undef PG8_WAIT_L
#undef PG8_BAR
#undef PG8_SCHED
}
}

constexpr int DM = 2048, NB = 8, SEQ = 2048, CTXL = 256, NLAYER = 2;
constexpr int TL = NB * SEQ, TC = NB * CTXL, TT = TL + TC;
constexpr int INW = 8192, KVOFF = 2048, VOFF = 2560, POOLOFF = 3072, GAOFF = 4096, GBOFF = 6144;
constexpr int NEXP = 16384, NSEL = 128;
constexpr float EPS = 1e-6f;
constexpr int NWAVES = 8;

constexpr size_t MiB = 1u << 20;
constexpr size_t WS_CTL = 0, CTL_ZERO_BYTES = 1 * MiB;
constexpr size_t WS_MOD = 1 * MiB;
constexpr size_t WS_MODP = 2 * MiB;
constexpr size_t WS_ROPE = 9 * MiB;
constexpr size_t WS_WIN = 10 * MiB;
constexpr size_t WS_WOUT = 90 * MiB;
constexpr size_t WS_WQP = 106 * MiB;
constexpr size_t WS_WPOOL = 122 * MiB;
constexpr size_t WS_KEYS = 124 * MiB;
constexpr size_t WS_PU = 126 * MiB;
constexpr size_t WS_PV = 190 * MiB;
constexpr size_t WS_SCU = 254 * MiB;
constexpr size_t WS_SCV = 255 * MiB;
constexpr size_t WS_X = 382 * MiB;
constexpr size_t WS_H = 526 * MiB;
constexpr size_t WS_P = 598 * MiB;
constexpr size_t WS_AO = 886 * MiB;
constexpr size_t WS_H8 = 922 * MiB;
constexpr size_t WS_WIN8 = WS_PU + 16 * MiB;
constexpr size_t WS_WBR8 = WS_PV + 16 * MiB;
constexpr size_t WS_POOLED = 958 * MiB;
constexpr size_t WS_YB = 994 * MiB;
constexpr size_t WS_END = 1066 * MiB;
constexpr size_t P_QP = 0, P_IDX = 216 * MiB, P_GW = 225 * MiB;

constexpr int CW_TMO = 0;
constexpr int CW_BAR = 4096;

constexpr int RING_BYTES = 131072;
constexpr int LDSCTL_OFF = RING_BYTES, MISC_OFF = LDSCTL_OFF + 320;
constexpr int LDS_BYTES = 147456;

#define GAS __attribute__((address_space(1)))
#define LAS __attribute__((address_space(3)))
typedef unsigned short bf16;
typedef unsigned v4u __attribute__((ext_vector_type(4)));
typedef unsigned v2u __attribute__((ext_vector_type(2)));
typedef float f32x4 __attribute__((ext_vector_type(4)));
typedef short bf16x8 __attribute__((ext_vector_type(8)));
typedef GAS unsigned gu32;
#define RLX_AGENT __ATOMIC_RELAXED, __HIP_MEMORY_SCOPE_AGENT
#define LDS_WAIT() asm volatile("s_waitcnt lgkmcnt(0)" ::: "memory")
#define VM_WAIT() asm volatile("s_waitcnt vmcnt(0)" ::: "memory")
__device__ __forceinline__ unsigned f2bf(float f) { unsigned u = __builtin_bit_cast(unsigned, f); return (u + 0x7fffu + ((u >> 16) & 1u)) >> 16; }
__device__ __forceinline__ unsigned pk2(float lo, float hi) { unsigned r; asm("v_cvt_pk_bf16_f32 %0, %1, %2" : "=v"(r) : "v"(lo), "v"(hi)); return r; }
__device__ __forceinline__ float bflo(unsigned w) { return __builtin_bit_cast(float, w << 16); }
__device__ __forceinline__ float bfhi(unsigned w) { return __builtin_bit_cast(float, w & 0xffff0000u); }
__device__ __forceinline__ float sigmoidf_(float x) { return __builtin_amdgcn_rcpf(1.0f + __expf(-x)); }
__device__ __forceinline__ float wave_sum(float v) {
#pragma unroll
    for (int o = 1; o < 64; o <<= 1) v += __shfl_xor(v, o);
    return v;
}
__device__ __forceinline__ float wave_max(float v) {
#pragma unroll
    for (int o = 1; o < 64; o <<= 1) v = fmaxf(v, __shfl_xor(v, o));
    return v;
}

#define XB_TMO      128
#define XB_XCNT(j)  (256  + 64 * (j))
#define XB_XSUB(j)  (1280 + 64 * (j))
#define XB_XGEN(j)  (2304 + 64 * (j))
#define XB_TOP      3328
#define XB_TOPGEN   3392
#define XCD_BAR_WORDS 3456
#define XB_SPIN_CAP (1u << 18)
__device__ __forceinline__ unsigned xb_ld(unsigned* p)              { return __hip_atomic_load(p, __ATOMIC_RELAXED, __HIP_MEMORY_SCOPE_AGENT); }
__device__ __forceinline__ unsigned xb_add(unsigned* p, unsigned v) { return __hip_atomic_fetch_add(p, v, __ATOMIC_RELAXED, __HIP_MEMORY_SCOPE_AGENT); }
__device__ __forceinline__ unsigned xb_xcc_id() { return (unsigned)__builtin_amdgcn_s_getreg((3 << 11) | 20) & 0xFu; }
#define XB_SPIN(cond, bar) do { unsigned _sp = 0; while (cond) { __builtin_amdgcn_s_sleep(1); \
    if ((++_sp & 255u) == 0u) { if (xb_ld(&(bar)[XB_TMO])) break; if (_sp > XB_SPIN_CAP) { atomicAdd(&(bar)[XB_TMO], 1u); break; } } } } while (0)
struct XcdBarrier { unsigned* bar; unsigned x; volatile LAS unsigned* st; };
__device__ __forceinline__ XcdBarrier xcd_barrier_post(unsigned* bar, volatile LAS unsigned* st) {
    XcdBarrier b; b.bar = bar; b.x = xb_xcc_id(); b.st = st;
    if (threadIdx.x == 0) (void)xb_add(&bar[XB_XCNT(b.x)], 1u);
    return b;
}
__device__ __forceinline__ void xcd_barrier_complete(unsigned* bar, unsigned x, unsigned& nloc, unsigned& nx) {
    const unsigned G = gridDim.x * gridDim.y * gridDim.z;
    unsigned sum, cnt, mine, sp = 0u;
    for (;;) {
        sum = 0u; cnt = 0u; mine = 0u;
#pragma unroll 1
        for (unsigned j = 0; j < 16; ++j) { const unsigned c = xb_ld(&bar[XB_XCNT(j)]); sum += c; cnt += (c > 0u) ? 1u : 0u; mine = (j == x) ? c : mine; }
        if (sum == G) break;
        __builtin_amdgcn_s_sleep(1);
        if ((++sp & 255u) == 0u) { if (xb_ld(&bar[XB_TMO])) break; if (sp > XB_SPIN_CAP) { atomicAdd(&bar[XB_TMO], 1u); break; } }
    }
    nloc = mine > 0u ? mine : 1u; nx = cnt > 0u ? cnt : 1u;
}
__device__ __forceinline__ void xcd_barrier(const XcdBarrier& b) {
    asm volatile("s_waitcnt vmcnt(0)" ::: "memory");
    __syncthreads();
    if (threadIdx.x == 0) {
        unsigned* bar = b.bar;
        asm volatile("" : "+s"(bar));
        __builtin_amdgcn_s_waitcnt(0);
        unsigned nloc = b.st[0], nx = b.st[1];
        if (nloc == 0u) { xcd_barrier_complete(bar, b.x, nloc, nx); b.st[0] = nloc; b.st[1] = nx; }
        const unsigned old = xb_add(&bar[XB_XSUB(b.x)], 1u);
        const unsigned gen = old / nloc;
        if (old + 1u == (gen + 1u) * nloc) {
            __builtin_amdgcn_fence(__ATOMIC_RELEASE, "agent");
            asm volatile("s_waitcnt vmcnt(0)" ::: "memory");
            const unsigned og = xb_add(&bar[XB_TOP], 1u);
            const unsigned tg = og / nx;
            if (og + 1u == (tg + 1u) * nx) xb_add(&bar[XB_TOPGEN], 1u);
            else XB_SPIN(xb_ld(&bar[XB_TOPGEN]) == tg, bar);
            __builtin_amdgcn_fence(__ATOMIC_ACQUIRE, "agent");
            xb_add(&bar[XB_XGEN(b.x)], 1u);
            asm volatile("s_waitcnt vmcnt(0)" ::: "memory");
        } else {
            XB_SPIN(xb_ld(&bar[XB_XGEN(b.x)]) == gen, bar);
            __builtin_amdgcn_fence(__ATOMIC_ACQUIRE, "agent");
            asm volatile("s_waitcnt vmcnt(0)" ::: "memory");
        }
    }
    __syncthreads();
}

struct Frame {
    LAS unsigned char* lds;
    int tid, lane, wave, vcu, G, bx;
    unsigned char* ws;
};
__device__ __forceinline__ Frame mkframe(unsigned char* lds_generic, unsigned char* ws) {
    Frame F; int t = threadIdx.x; asm volatile("" : "+v"(t)); asm volatile("" : "+s"(ws));
    F.lds = (LAS unsigned char*)lds_generic; F.tid = t; F.lane = t & 63; F.wave = __builtin_amdgcn_readfirstlane(t >> 6);
    { int bx = blockIdx.x, G = gridDim.x; asm volatile("" : "+s"(bx), "+s"(G));
      F.bx = bx; F.G = G; F.vcu = (G % 8 == 0) ? (bx % 8) * (G / 8) + bx / 8 : bx; }
    F.ws = ws; return F;
}
enum { I_X = 0, I_C, I_CTX, I_CCTX, I_WADA, I_BADA, I_WIN, I_QG, I_KG, I_WBR, I_WPOOL, I_PSCALE, I_WOUT, I_WQP, I_KEYS, I_PU, I_PV, I_FG, I_OUT };
template <int I> __device__ __forceinline__ const float* inp() {
    const float* p;
    asm volatile("s_load_dwordx2 %0, %1, %2\n\ts_waitcnt lgkmcnt(0)" : "=s"(p) : "s"(__builtin_amdgcn_kernarg_segment_ptr()), "i"(8 * I) : "memory");
    return p;
}
__device__ __forceinline__ const float* mod_ptr(const Frame& F, int layer, int row) {
    const int mr = row < TL ? (row >> 11) : 8;
    return (const float*)(F.ws + WS_MOD) + ((size_t)layer * 9 + mr) * (6 * DM);
}

__device__ __forceinline__ float clamp_fp8(float v) { return __builtin_amdgcn_fmed3f(v, -448.0f, 448.0f); }
__device__ __forceinline__ unsigned pk4_fp8(float a, float b, float c, float d) { int p = __builtin_amdgcn_cvt_pk_fp8_f32(clamp_fp8(a), clamp_fp8(b), 0, false); p = __builtin_amdgcn_cvt_pk_fp8_f32(clamp_fp8(c), clamp_fp8(d), p, true); return (unsigned)p; }
constexpr float W8_SCALE = 64.0f;
__device__ __forceinline__ void p0_transpose_item(const float* W, int K, int N, bf16* WT, unsigned char* WT8, int row_off, LAS float* scr, int item, int lane) {
    const int nblk = N / 64, kb = item / nblk, nb = item % nblk, k0 = 64 * kb, n0 = 64 * nb;
    const int n4 = (lane & 15) * 4, kr = lane >> 4;
#pragma unroll
    for (int i = 0; i < 16; ++i) { const int kk = kr + 4 * i;
        const f32x4 v = *(const GAS f32x4*)(W + (size_t)(k0 + kk) * N + n0 + n4);
        *(LAS f32x4*)(scr + kk * 64 + (n4 ^ ((kk >> 3) << 3))) = v; }
    LDS_WAIT(); asm volatile("" ::: "memory");
    const int c = lane & 7, nn = lane >> 3;
#pragma unroll
    for (int j = 0; j < 8; ++j) { const int n = nn + 8 * j; const LAS float* sp = scr + (8 * c) * 64 + (n ^ (c << 3));
        const float x0 = sp[0 * 64], x1 = sp[1 * 64], x2 = sp[2 * 64], x3 = sp[3 * 64], x4 = sp[4 * 64], x5 = sp[5 * 64], x6 = sp[6 * 64], x7 = sp[7 * 64];
        if (WT) { v4u o; o.x = pk2(x0, x1); o.y = pk2(x2, x3); o.z = pk2(x4, x5); o.w = pk2(x6, x7); *(GAS v4u*)(WT + (size_t)(row_off + n0 + n) * K + k0 + 8 * c) = o; }
        if (WT8) { v2u o; o.x = pk4_fp8(x0 * W8_SCALE, x1 * W8_SCALE, x2 * W8_SCALE, x3 * W8_SCALE); o.y = pk4_fp8(x4 * W8_SCALE, x5 * W8_SCALE, x6 * W8_SCALE, x7 * W8_SCALE);
            *(GAS v2u*)(WT8 + (size_t)(row_off + n0 + n) * K + k0 + 8 * c) = o; } }
    LDS_WAIT(); asm volatile("" ::: "memory");
}
__device__ __forceinline__ void cvt8(const float* src, bf16* dst) {
    const f32x4 a = *(const GAS f32x4*)src, b = *(const GAS f32x4*)(src + 4);
    v4u o; o.x = pk2(a.x, a.y); o.y = pk2(a.z, a.w); o.z = pk2(b.x, b.y); o.w = pk2(b.z, b.w);
    *(GAS v4u*)dst = o;
}
__device__ __forceinline__ void phase_prologue(Frame& F) {
    {
        LAS float* S = (LAS float*)F.lds;
        LAS float* red = (LAS float*)(F.lds + 16384);
        float* modp = (float*)(F.ws + WS_MODP);
        for (int u = F.bx; u < 96 * 8; u += F.G) {
            const int cb = u >> 3, kc = u & 7, layer = cb / 48, col0 = (cb % 48) * 256, kbase = kc * 256;
            for (int e = F.tid; e < 9 * 256; e += 512) { const int r = e >> 8, kk = e & 255;
                const float v = r < 8 ? inp<I_C>()[(size_t)r * DM + kbase + kk] : inp<I_CCTX>()[kbase + kk];
                S[e] = v / (1.0f + __expf(-v)); }
            __syncthreads();
            f32x4 acc[9];
#pragma unroll
            for (int r = 0; r < 9; ++r) acc[r] = (f32x4){0.f, 0.f, 0.f, 0.f};
            const float* wp = inp<I_WADA>() + ((size_t)layer * DM + kbase + F.wave * 32) * (6 * DM) + col0 + F.lane * 4;
#pragma unroll 8
            for (int kk = 0; kk < 32; ++kk) {
                const f32x4 w = *(const GAS f32x4*)(wp + (size_t)kk * (6 * DM));
#pragma unroll
                for (int r = 0; r < 9; ++r) { const float s = S[r * 256 + F.wave * 32 + kk]; acc[r] += w * s; }
            }
#pragma unroll
            for (int r = 0; r < 9; ++r) *(LAS f32x4*)(red + (F.wave * 9 + r) * 256 + F.lane * 4) = acc[r];
            __syncthreads();
            for (int e = F.tid; e < 9 * 256; e += 512) { const int r = e >> 8, cc = e & 255; float s = 0.f;
#pragma unroll
                for (int w = 0; w < 8; ++w) s += red[(w * 9 + r) * 256 + cc];
                modp[(((size_t)kc * 2 + layer) * 9 + r) * (6 * DM) + col0 + cc] = s; }
            __syncthreads();
        }
    }
    if (F.bx == F.G - 1) {
        float* rope = (float*)(F.ws + WS_ROPE);
        for (int e = F.tid; e < 64 * 32; e += 512) { const int pos = e >> 5, f = e & 31;
            const float inv = powf(10000.0f, -(float)f / 32.0f); const float ang = (float)pos * inv;
            rope[e] = cosf(ang); rope[2048 + e] = sinf(ang); }
    }
    LAS float* scr = (LAS float*)(F.lds + F.wave * 16384);
    const int gw = F.vcu * NWAVES + F.wave, NGW = F.G * NWAVES;
    constexpr int I_IN = (DM / 64) * (INW / 64), I_SQ = (DM / 64) * (DM / 64), I_PG = (256 / 64) * (512 / 64);
    constexpr int PER_LAYER = I_IN + 3 * I_SQ + 4 * I_PG;
    for (int it = gw; it < NLAYER * PER_LAYER; it += NGW) {
        const int layer = it / PER_LAYER; int r = it % PER_LAYER;
        if (r < I_IN) { const bool pool = (unsigned)(r % (INW / 64) - POOLOFF / 64) < 1024u / 64u;
            p0_transpose_item(inp<I_WIN>() + (size_t)layer * DM * INW, DM, INW, pool ? (bf16*)(F.ws + WS_WIN + (size_t)layer * 32 * MiB) : (bf16*)nullptr,
                              pool ? (unsigned char*)nullptr : F.ws + WS_WIN8 + (size_t)layer * 32 * MiB, 0, scr, r, F.lane); continue; } r -= I_IN;
        if (r < I_SQ) { p0_transpose_item(inp<I_WBR>() + (size_t)layer * DM * DM, DM, DM, nullptr, F.ws + WS_WBR8 + (size_t)layer * 32 * MiB, 0, scr, r, F.lane); continue; } r -= I_SQ;
        if (r < I_SQ) { p0_transpose_item(inp<I_WOUT>() + (size_t)layer * DM * DM, DM, DM, (bf16*)(F.ws + WS_WOUT + (size_t)layer * 8 * MiB), nullptr, 0, scr, r, F.lane); continue; } r -= I_SQ;
        if (r < I_SQ) { p0_transpose_item(inp<I_WQP>() + (size_t)layer * DM * DM, DM, DM, (bf16*)(F.ws + WS_WQP + (size_t)layer * 8 * MiB), nullptr, 0, scr, r, F.lane); continue; } r -= I_SQ;
        const int g = r / I_PG; r %= I_PG;
        p0_transpose_item(inp<I_WPOOL>() + ((size_t)layer * 4 + g) * 256 * 512, 256, 512, (bf16*)(F.ws + WS_WPOOL + (size_t)layer * 1 * MiB), nullptr, g * 512, scr, r, F.lane);
    }
    const size_t gt = (size_t)F.vcu * 512 + F.tid, NGT = (size_t)F.G * 512;
    for (size_t e = gt; e < (size_t)NLAYER * 2048 * 16; e += NGT) cvt8(inp<I_KEYS>() + e * 8, (bf16*)(F.ws + WS_KEYS) + e * 8);
    {
        typedef __bf16 bf32v __attribute__((ext_vector_type(32)));
        typedef unsigned v6u __attribute__((ext_vector_type(6)));
        const float* pu_ = inp<I_PU>(); const float* pv_ = inp<I_PV>();
        constexpr int NROWS = NLAYER * NEXP;
        for (int rr = gw; rr < 2 * NROWS; rr += NGW) {
            const bool isu = rr < NROWS; const int row = isu ? rr : rr - NROWS;
            const float* src = (isu ? pu_ : pv_) + (size_t)row * DM + F.lane * 4;
            f32x4 v[8];
#pragma unroll
            for (int j = 0; j < 8; ++j) v[j] = *(const GAS f32x4*)(src + 256 * j);
            float m = 0.f;
#pragma unroll
            for (int j = 0; j < 8; ++j) m = fmaxf(m, fmaxf(fmaxf(fabsf(v[j].x), fabsf(v[j].y)), fmaxf(fabsf(v[j].z), fabsf(v[j].w))));
            m = wave_max(m);
            float sc = 1.0f;
            if (m > 1e-30f) sc = fminf(6.0f / m, 1.0e30f);
            {
                unsigned pk[4];
#pragma unroll
                for (int d = 0; d < 4; ++d) { unsigned p = 0u;
                    p = __builtin_amdgcn_cvt_scalef32_pk_fp4_f32(p, v[2 * d].x * sc, v[2 * d].y * sc, 1.0f, 0); p = __builtin_amdgcn_cvt_scalef32_pk_fp4_f32(p, v[2 * d].z * sc, v[2 * d].w * sc, 1.0f, 1);
                    p = __builtin_amdgcn_cvt_scalef32_pk_fp4_f32(p, v[2 * d + 1].x * sc, v[2 * d + 1].y * sc, 1.0f, 2); p = __builtin_amdgcn_cvt_scalef32_pk_fp4_f32(p, v[2 * d + 1].z * sc, v[2 * d + 1].w * sc, 1.0f, 3);
                    pk[d] = p; }
                unsigned char* dst = F.ws + (isu ? WS_PU : WS_PV) + (size_t)(row / NEXP) * 32 * MiB + (size_t)(row % NEXP) * 1024 + F.lane * 16;
                *(GAS v4u*)dst = (v4u){pk[0], pk[1], pk[2], pk[3]};
            }
            if (F.lane == 0) ((float*)(F.ws + (isu ? WS_SCU : WS_SCV)))[row] = 1.0f / sc;
        }
    }
}
__device__ __forceinline__ void phase_mod_finalize(Frame& F) {
    const float* modp = (const float*)(F.ws + WS_MODP); float* mod = (float*)(F.ws + WS_MOD);
    constexpr int NMOD = NLAYER * 9 * 6 * DM;
    for (int e = F.vcu * 512 + F.tid; e < NMOD; e += F.G * 512) {
        const int layer = e / (9 * 6 * DM), col = e % (6 * DM);
        float s = inp<I_BADA>()[(size_t)layer * 6 * DM + col];
#pragma unroll
        for (int kc = 0; kc < 8; ++kc) s += modp[(size_t)kc * NMOD + e];
        mod[e] = s;
    }
}
__device__ __forceinline__ void phase_modulate(Frame& F, int layer, int which, int nrows, bool from_inputs, bool with_fp8) {
    const int gw = F.vcu * NWAVES + F.wave, NGW = F.G * NWAVES;
    bf16* H = (bf16*)(F.ws + WS_H);
    const float* x_ = inp<I_X>(); const float* ctx_ = inp<I_CTX>();
    for (int row = gw; row < nrows; row += NGW) {
        const float* mp = mod_ptr(F, layer, row) + (which ? 3 * DM : 0);
        f32x4 v[8]; float ss = 0.f;
        if (from_inputs) { const float* src = row < TL ? x_ + (size_t)row * DM : ctx_ + (size_t)(row - TL) * DM;
#pragma unroll
            for (int j = 0; j < 4; ++j) { v[2 * j] = *(const GAS f32x4*)(src + j * 512 + F.lane * 8); v[2 * j + 1] = *(const GAS f32x4*)(src + j * 512 + F.lane * 8 + 4); }
        } else { const bf16* src = (const bf16*)(F.ws + WS_X) + (size_t)row * DM; v4u r[4];
#pragma unroll
            for (int j = 0; j < 4; ++j) r[j] = *(const GAS v4u*)(src + j * 512 + F.lane * 8);
#pragma unroll
            for (int j = 0; j < 4; ++j) { v[2 * j] = (f32x4){bflo(r[j].x), bfhi(r[j].x), bflo(r[j].y), bfhi(r[j].y)}; v[2 * j + 1] = (f32x4){bflo(r[j].z), bfhi(r[j].z), bflo(r[j].w), bfhi(r[j].w)}; } }
#pragma unroll
        for (int j = 0; j < 8; ++j) ss += (v[j].x * v[j].x + v[j].y * v[j].y) + (v[j].z * v[j].z + v[j].w * v[j].w);
        const float rs = 1.0f / sqrtf(wave_sum(ss) * (1.0f / DM) + EPS);
#pragma unroll
        for (int j = 0; j < 4; ++j) { const int col = j * 512 + F.lane * 8;
            const f32x4 sh0 = *(const GAS f32x4*)(mp + col), sh1 = *(const GAS f32x4*)(mp + col + 4), sc0 = *(const GAS f32x4*)(mp + DM + col), sc1 = *(const GAS f32x4*)(mp + DM + col + 4);
            const f32x4 o0 = v[2 * j] * rs * (sc0 + 1.0f) + sh0, o1 = v[2 * j + 1] * rs * (sc1 + 1.0f) + sh1;
            v4u w; w.x = pk2(o0.x, o0.y); w.y = pk2(o0.z, o0.w); w.z = pk2(o1.x, o1.y); w.w = pk2(o1.z, o1.w);
            *(GAS v4u*)(H + (size_t)row * DM + col) = w;
            if (with_fp8) { v2u w8; w8.x = pk4_fp8(o0.x, o0.y, o0.z, o0.w); w8.y = pk4_fp8(o1.x, o1.y, o1.z, o1.w); *(GAS v2u*)(F.ws + WS_H8 + (size_t)row * DM + col) = w8; }
        }
    }
}

__device__ __forceinline__ v4u qk_item(const v4u raw, int row, int quad, int layer, int lane, const float* rope, const float* qg_, const float* kg_) {
    const int l16 = lane & 15, d0 = l16 * 8, head = quad * 4 + (lane >> 4);
    float v[8] = {bflo(raw.x), bfhi(raw.x), bflo(raw.y), bfhi(raw.y), bflo(raw.z), bfhi(raw.z), bflo(raw.w), bfhi(raw.w)};
    float ss = 0.f;
#pragma unroll
    for (int e = 0; e < 8; ++e) ss += v[e] * v[e];
    ss += __shfl_xor(ss, 1); ss += __shfl_xor(ss, 2); ss += __shfl_xor(ss, 4); ss += __shfl_xor(ss, 8);
    const float rs = 1.0f / sqrtf(ss * (1.0f / 128.0f) + EPS);
    const float* gain = (head < 16 ? qg_ : kg_) + (size_t)layer * 128 + d0;
    const f32x4 g0 = *(const GAS f32x4*)gain, g1 = *(const GAS f32x4*)(gain + 4);
    const float gg[8] = {g0.x, g0.y, g0.z, g0.w, g1.x, g1.y, g1.z, g1.w};
#pragma unroll
    for (int e = 0; e < 8; ++e) v[e] = v[e] * rs * gg[e];
    float part[8];
#pragma unroll
    for (int e = 0; e < 8; ++e) part[e] = __shfl_xor(v[e], 4);
    if (row < TL) {
        const int t = row & (SEQ - 1), pos = (d0 < 64) ? (t >> 6) : (t & 63), f0 = d0 & 31;
        const float* cs = rope + pos * 32 + f0; const float* sn = cs + 2048;
        const f32x4 c0 = *(const GAS f32x4*)cs, c1 = *(const GAS f32x4*)(cs + 4), s0 = *(const GAS f32x4*)sn, s1 = *(const GAS f32x4*)(sn + 4);
        const float cc[8] = {c0.x, c0.y, c0.z, c0.w, c1.x, c1.y, c1.z, c1.w}, sv[8] = {s0.x, s0.y, s0.z, s0.w, s1.x, s1.y, s1.z, s1.w};
        const float sgn = (l16 & 4) ? 1.0f : -1.0f;
#pragma unroll
        for (int e = 0; e < 8; ++e) v[e] = v[e] * cc[e] + sgn * part[e] * sv[e];
    }
    v4u o; o.x = pk2(v[0], v[1]); o.y = pk2(v[2], v[3]); o.z = pk2(v[4], v[5]); o.w = pk2(v[6], v[7]);
    return o;
}
__device__ __forceinline__ void phase_post(Frame& F, int layer) {
    const int gw = F.vcu * NWAVES + F.wave, NGW = F.G * NWAVES, lane = F.lane;
    bf16* P = (bf16*)(F.ws + WS_P);
    const float* rope = (const float*)(F.ws + WS_ROPE);
    const float* qg_ = inp<I_QG>(); const float* kg_ = inp<I_KG>();
    for (int it0 = gw; it0 < TT; it0 += 4 * NGW) {
        v4u raw[4]; bool ok[4];
#pragma unroll
        for (int q = 0; q < 4; ++q) { const int row = it0 + q * NGW; ok[q] = row < TT;
            if (ok[q]) raw[q] = *(const GAS v4u*)(P + (size_t)row * INW + 4 * 512 + lane * 8); }
#pragma unroll
        for (int q = 0; q < 4; ++q) if (ok[q]) { const int row = it0 + q * NGW;
            *(GAS v4u*)(P + (size_t)row * INW + 4 * 512 + lane * 8) = qk_item(raw[q], row, 4, layer, lane, rope, qg_, kg_); }
    }
    bf16* PO = (bf16*)(F.ws + WS_POOLED);
    const int prow = (layer == NLAYER - 1) ? TL : TT;
    for (int it = gw; it < prow * 2; it += NGW) {
        const int row = it >> 1, hsel = it & 1, c8 = hsel * 64 + lane, g = c8 >> 5, half = 1 << g;
        int base, t, L;
        if (row < TL) { base = row & ~(SEQ - 1); t = row & (SEQ - 1); L = SEQ; } else { const int j = row - TL; base = TL + (j & ~(CTXL - 1)); t = j & (CTXL - 1); L = CTXL; }
        const int lo = max(t - half, 0), hi = min(t + half, L);
        float acc[8] = {0.f, 0.f, 0.f, 0.f, 0.f, 0.f, 0.f, 0.f};
        const bf16* pp = P + (size_t)base * INW + POOLOFF + c8 * 8;
        const v4u selfraw = *(const GAS v4u*)(pp + (size_t)t * INW);
#define POOL_ACC(NW, H0) do { v4u rw_[NW]; \
            _Pragma("unroll") for (int d = 0; d < NW; ++d) { const int tt = min(max(t - (H0) + d, 0), L - 1); rw_[d] = *(const GAS v4u*)(pp + (size_t)tt * INW); } \
            _Pragma("unroll") for (int d = 0; d < NW; ++d) { const int tt = t - (H0) + d; const float wgt = (tt >= lo && tt < hi) ? 1.0f : 0.0f; \
                acc[0] += wgt * bflo(rw_[d].x); acc[1] += wgt * bfhi(rw_[d].x); acc[2] += wgt * bflo(rw_[d].y); acc[3] += wgt * bfhi(rw_[d].y); \
                acc[4] += wgt * bflo(rw_[d].z); acc[5] += wgt * bfhi(rw_[d].z); acc[6] += wgt * bflo(rw_[d].w); acc[7] += wgt * bfhi(rw_[d].w); } } while (0)
        if (hsel == 0) POOL_ACC(4, 2); else POOL_ACC(16, 8);
#undef POOL_ACC
        const float self[8] = {bflo(selfraw.x), bfhi(selfraw.x), bflo(selfraw.y), bfhi(selfraw.y), bflo(selfraw.z), bfhi(selfraw.z), bflo(selfraw.w), bfhi(selfraw.w)};
        const float inv = 1.0f / (float)(hi - lo);
        v4u o; o.x = pk2(acc[0] * inv - self[0], acc[1] * inv - self[1]); o.y = pk2(acc[2] * inv - self[2], acc[3] * inv - self[3]);
        o.z = pk2(acc[4] * inv - self[4], acc[5] * inv - self[5]); o.w = pk2(acc[6] * inv - self[6], acc[7] * inv - self[7]);
        *(GAS v4u*)(PO + (size_t)row * 1024 + c8 * 8) = o;
    }
}

namespace attn {
constexpr int D = 128, NW = 8, QBLK = 32, KVBLK = 64;
constexpr float SCALE = 0.088388347648318440f;
constexpr float THR = 8.f;
constexpr int LDQ = INW, LDK = INW, LDO = DM;
constexpr size_t SHM_V = KVBLK * D * 2, SHM_K = KVBLK * D * 2;
constexpr size_t OFF_WS = 2 * SHM_V + 2 * SHM_K, OFF_OST = OFF_WS + NW * 64 * 4, SHM_ATTN = OFF_OST + NW * 4096;
using s16x4  = __attribute__((ext_vector_type(4))) short;
using f32x16 = __attribute__((ext_vector_type(16))) float;
using u32x4  = __attribute__((ext_vector_type(4))) unsigned;
#define KSWZ(row, colB) ((row) * 256 + ((colB) ^ (((row) & 7) << 4)))
#define SBAR() __builtin_amdgcn_sched_barrier(0)
__device__ __forceinline__ int crow(int r, int hi) { return (r & 3) + 8 * (r >> 2) + 4 * hi; }
__device__ __forceinline__ unsigned cvtpk(float lo, float hi) { unsigned r; asm volatile("v_cvt_pk_bf16_f32 %0, %1, %2" : "=v"(r) : "v"(lo), "v"(hi)); return r; }
__device__ __forceinline__ void partialSM(f32x16& p0, f32x16& p1, float& m_reg, float& mn, float& alpha) {
  constexpr float C = SCALE * 1.4426950408889634f;
  float pmax = p0[0]; for (int r = 1; r < 16; ++r) pmax = fmaxf(pmax, p0[r]); for (int r = 0; r < 16; ++r) pmax = fmaxf(pmax, p1[r]);
  { auto rr = __builtin_amdgcn_permlane32_swap(__float_as_uint(pmax), __float_as_uint(pmax), false, false);
    pmax = fmaxf(__uint_as_float(rr[0]), __uint_as_float(rr[1])); }
  if (__builtin_expect(__all(pmax - m_reg <= THR / SCALE), 1)) { mn = m_reg; alpha = 1.f; }
  else { mn = fmaxf(m_reg, pmax); alpha = __builtin_amdgcn_exp2f((m_reg - mn) * C); m_reg = mn; }
  float mnC = -mn * C;
  for (int r = 0; r < 16; ++r) p0[r] = fmaf(p0[r], C, mnC); for (int r = 0; r < 16; ++r) p1[r] = fmaf(p1[r], C, mnC);
  for (int r = 0; r < 16; ++r) p0[r] = __builtin_amdgcn_exp2f(p0[r]);
}
__device__ __forceinline__ void finishSM(f32x16& p0, f32x16& p1, float alpha, float& l_reg, bf16x8& pa0, bf16x8& pa1, bf16x8& pa2, bf16x8& pa3) {
  for (int r = 0; r < 16; ++r) p1[r] = __builtin_amdgcn_exp2f(p1[r]);
  float ps = 0; for (int r = 0; r < 16; ++r) ps += p0[r]; for (int r = 0; r < 16; ++r) ps += p1[r];
  { auto rr = __builtin_amdgcn_permlane32_swap(__float_as_uint(ps), __float_as_uint(ps), false, false);
    ps = __uint_as_float(rr[0]) + __uint_as_float(rr[1]); }
  l_reg = l_reg * alpha + ps;
#define PK4(P, BASE, OUT) do { unsigned a0 = cvtpk(P[BASE + 0], P[BASE + 1]), a1 = cvtpk(P[BASE + 2], P[BASE + 3]);   \
    unsigned b0 = cvtpk(P[BASE + 4], P[BASE + 5]), b1 = cvtpk(P[BASE + 6], P[BASE + 7]);                              \
    auto r0 = __builtin_amdgcn_permlane32_swap(a0, b0, false, false); auto r1 = __builtin_amdgcn_permlane32_swap(a1, b1, false, false); \
    u32x4 w = {r0[0], r1[0], r0[1], r1[1]}; OUT = *reinterpret_cast<bf16x8*>(&w); } while (0)
  PK4(p0, 0, pa0); PK4(p0, 8, pa1); PK4(p1, 0, pa2); PK4(p1, 8, pa3);
#undef PK4
}
__device__ __forceinline__ void qkt(f32x16& p0, f32x16& p1, const bf16* Ks, const bf16x8* qr, int r32, int hi) {
  p0 = f32x16{}; p1 = f32x16{};
  for (int d0 = 0; d0 < 8; ++d0) { int cb = (d0 * 16 + hi * 8) * 2;
    bf16x8 b0 = *reinterpret_cast<const bf16x8*>((const char*)Ks + KSWZ(r32, cb));
    bf16x8 b1 = *reinterpret_cast<const bf16x8*>((const char*)Ks + KSWZ(32 + r32, cb));
    p0 = __builtin_amdgcn_mfma_f32_32x32x16_bf16(b0, qr[d0], p0, 0, 0, 0);
    p1 = __builtin_amdgcn_mfma_f32_32x32x16_bf16(b1, qr[d0], p1, 0, 0, 0); }
}
__device__ __forceinline__ int v_st(int k, int c) { const int kk = (k & ~0xC) | ((k & 4) << 1) | ((k & 8) >> 1); return ((kk >> 3) * 4 + (c >> 5)) * 512 + ((kk & 7) * 32 + (c & 31)) * 2; }
__device__ __forceinline__ int v_rd_base(int lane) { return ((lane & 3) << 3) | (((lane >> 2) & 3) << 6) | (((lane >> 4) & 1) << 5) | (((lane >> 5) & 1) << 8); }
constexpr int v_rd_off(int d0, int ks, int half) { return d0 * 512 + ks * 4096 + half * 2048; }
template <int OFF> __device__ __forceinline__ s16x4 tr_read(int vb) {
  s16x4 r; asm volatile("ds_read_b64_tr_b16 %0, %1 offset:%2" : "=&v"(r) : "v"(vb), "i"(OFF) : "memory"); return r;
}
template <int D0> __device__ __forceinline__ void pv_one(f32x16& od, int vb, bf16x8 pa0, bf16x8 pa1, bf16x8 pa2, bf16x8 pa3) {
  const s16x4 l0 = tr_read<v_rd_off(D0, 0, 0)>(vb), h0 = tr_read<v_rd_off(D0, 0, 1)>(vb), l1 = tr_read<v_rd_off(D0, 1, 0)>(vb), h1 = tr_read<v_rd_off(D0, 1, 1)>(vb);
  const s16x4 l2 = tr_read<v_rd_off(D0, 2, 0)>(vb), h2 = tr_read<v_rd_off(D0, 2, 1)>(vb), l3 = tr_read<v_rd_off(D0, 3, 0)>(vb), h3 = tr_read<v_rd_off(D0, 3, 1)>(vb);
  asm volatile("s_waitcnt lgkmcnt(0)" ::: "memory"); SBAR();
#define PK(L, H) (bf16x8){L[0], L[1], L[2], L[3], H[0], H[1], H[2], H[3]}
  od = __builtin_amdgcn_mfma_f32_32x32x16_bf16(pa0, PK(l0, h0), od, 0, 0, 0);
  od = __builtin_amdgcn_mfma_f32_32x32x16_bf16(pa1, PK(l1, h1), od, 0, 0, 0);
  od = __builtin_amdgcn_mfma_f32_32x32x16_bf16(pa2, PK(l2, h2), od, 0, 0, 0);
  od = __builtin_amdgcn_mfma_f32_32x32x16_bf16(pa3, PK(l3, h3), od, 0, 0, 0);
#undef PK
}
__device__ __forceinline__ void pv_d0(f32x16* o, int vb, bf16x8 pa0, bf16x8 pa1, bf16x8 pa2, bf16x8 pa3) {
  pv_one<0>(o[0], vb, pa0, pa1, pa2, pa3); pv_one<1>(o[1], vb, pa0, pa1, pa2, pa3); pv_one<2>(o[2], vb, pa0, pa1, pa2, pa3); pv_one<3>(o[3], vb, pa0, pa1, pa2, pa3);
}
__device__ __forceinline__ void attn_unit(const bf16* __restrict__ Qb, const bf16* __restrict__ K1, const bf16* __restrict__ K2,
                                          int len1, int seq, unsigned char* __restrict__ Ob, char* lds, const float* __restrict__ qgain, const float* __restrict__ rope, int tq0) {
  int tid_ = threadIdx.x; asm volatile("" : "+v"(tid_));
  const int tid = tid_, wid = tid >> 6, lane = tid & 63, r32 = lane & 31, hi = lane >> 5;
  bf16* V_lds = (bf16*)lds; bf16* K_lds = (bf16*)(lds + 2 * SHM_V);
  float* ws = (float*)(lds + OFF_WS) + wid * 64; float* li_l = ws; float* al_l = ws + 32;
  float m_reg = -1e30f, l_reg = 0; f32x16 o[4] = {}; bf16x8 qr[8];
  const bf16* Qw = Qb + (long)(wid * QBLK + r32) * LDQ + hi * 8;
#pragma unroll
  for (int d0 = 0; d0 < 8; ++d0) qr[d0] = *(const GAS bf16x8*)(Qw + d0 * 16);
  {
    float qf[8][8]; float ss = 0.f;
#pragma unroll
    for (int d0 = 0; d0 < 8; ++d0) { const u32x4 w = __builtin_bit_cast(u32x4, qr[d0]);
      qf[d0][0] = bflo(w[0]); qf[d0][1] = bfhi(w[0]); qf[d0][2] = bflo(w[1]); qf[d0][3] = bfhi(w[1]); qf[d0][4] = bflo(w[2]); qf[d0][5] = bfhi(w[2]); qf[d0][6] = bflo(w[3]); qf[d0][7] = bfhi(w[3]);
#pragma unroll
      for (int e = 0; e < 8; ++e) ss += qf[d0][e] * qf[d0][e]; }
    { auto rr = __builtin_amdgcn_permlane32_swap(__float_as_uint(ss), __float_as_uint(ss), false, false); ss = __uint_as_float(rr[0]) + __uint_as_float(rr[1]); }
    const float rs = 1.0f / sqrtf(ss * (1.0f / 128.0f) + EPS);
#pragma unroll
    for (int d0 = 0; d0 < 8; ++d0) { const float* gp = qgain + d0 * 16 + hi * 8; const f32x4 g0 = *(const GAS f32x4*)gp, g1 = *(const GAS f32x4*)(gp + 4);
      qf[d0][0] *= rs * g0.x; qf[d0][1] *= rs * g0.y; qf[d0][2] *= rs * g0.z; qf[d0][3] *= rs * g0.w; qf[d0][4] *= rs * g1.x; qf[d0][5] *= rs * g1.y; qf[d0][6] *= rs * g1.z; qf[d0][7] *= rs * g1.w; }
    if (tq0 >= 0) {
      const int t = tq0 + wid * QBLK + r32;
#pragma unroll
      for (int ch = 0; ch < 2; ++ch) { const int pos = ch == 0 ? (t >> 6) : (t & 63);
#pragma unroll
        for (int dd = 0; dd < 2; ++dd) { const int dA = ch * 4 + dd, dB = dA + 2; const float* cs = rope + pos * 32 + dd * 16 + hi * 8; const float* sn = cs + 2048;
          const f32x4 c0 = *(const GAS f32x4*)cs, c1 = *(const GAS f32x4*)(cs + 4), s0 = *(const GAS f32x4*)sn, s1 = *(const GAS f32x4*)(sn + 4);
          const float cc[8] = {c0.x, c0.y, c0.z, c0.w, c1.x, c1.y, c1.z, c1.w}, sv[8] = {s0.x, s0.y, s0.z, s0.w, s1.x, s1.y, s1.z, s1.w};
#pragma unroll
          for (int e = 0; e < 8; ++e) { const float x1 = qf[dA][e], x2 = qf[dB][e]; qf[dA][e] = x1 * cc[e] - x2 * sv[e]; qf[dB][e] = x2 * cc[e] + x1 * sv[e]; } } }
    }
#pragma unroll
    for (int d0 = 0; d0 < 8; ++d0) { u32x4 w; w[0] = cvtpk(qf[d0][0], qf[d0][1]); w[1] = cvtpk(qf[d0][2], qf[d0][3]); w[2] = cvtpk(qf[d0][4], qf[d0][5]); w[3] = cvtpk(qf[d0][6], qf[d0][7]); qr[d0] = __builtin_bit_cast(bf16x8, w); }
  }
  const int sr = tid >> 4, sc = (tid & 15) * 8, vst0 = v_st(sr, sc), vst1 = v_st(32 + sr, sc);
  const int vb0 = (int)(uintptr_t)V_lds + v_rd_base(lane);
  struct { bf16x8 vs0, vs1, ks0, ks1; } sr_[2];
  const unsigned lo0_ = (unsigned)(sr * LDK + sc) * 2u, lo1_ = lo0_ + 32u * LDK * 2u;
  constexpr int VKB = (VOFF - KVOFF) * 2;
#define SLOAD(i, k0) do { const int k0_ = (k0); const char* Kt_ = (const char*)((k0_ < len1) ? K1 + (long)k0_ * LDK : K2 + (long)(k0_ - len1) * LDK); \
    sr_[i].vs0 = *(const GAS bf16x8*)(Kt_ + lo0_ + VKB); sr_[i].vs1 = *(const GAS bf16x8*)(Kt_ + lo1_ + VKB); \
    sr_[i].ks0 = *(const GAS bf16x8*)(Kt_ + lo0_); sr_[i].ks1 = *(const GAS bf16x8*)(Kt_ + lo1_); } while (0)
#define SWRITE(b, i) do { *(bf16x8*)((char*)V_lds + (b) * SHM_V + vst0) = sr_[i].vs0;          \
    *(bf16x8*)((char*)V_lds + (b) * SHM_V + vst1) = sr_[i].vs1; int kc = sc * 2;               \
    *(bf16x8*)((char*)K_lds + (b) * SHM_K + KSWZ(sr, kc)) = sr_[i].ks0;                       \
    *(bf16x8*)((char*)K_lds + (b) * SHM_K + KSWZ(32 + sr, kc)) = sr_[i].ks1; } while (0)
#define SWAIT() asm volatile("s_waitcnt vmcnt(4)" ::: "memory")
#define RESC(a) do { if (__any((a) < 1.f)) { if (hi == 0) al_l[r32] = (a); asm volatile("s_waitcnt lgkmcnt(0)" ::: "memory"); \
    for (int d = 0; d < 4; ++d) for (int r = 0; r < 16; ++r) o[d][r] *= al_l[crow(r, hi)]; } } while (0)
  f32x16 pA0, pA1, pB0, pB1; float mnA, mnB, alA, alB; bf16x8 pa0, pa1, pa2, pa3; const int NT = seq / KVBLK;
  constexpr int SE = 0, SO = 1;
  SLOAD(SE, 0); asm volatile("s_waitcnt vmcnt(0)" ::: "memory"); SWRITE(0, SE); __syncthreads();
  qkt(pA0, pA1, K_lds, qr, r32, hi); partialSM(pA0, pA1, m_reg, mnA, alA);
  SLOAD(SO, KVBLK); if (2 < NT) SLOAD(SE, 2 * KVBLK);
  SWAIT(); SWRITE(1, SO); __syncthreads();
  for (int j = 1; j + 1 < NT; j += 2) {
    SBAR(); qkt(pB0, pB1, (bf16*)((char*)K_lds + SHM_K), qr, r32, hi);
    finishSM(pA0, pA1, alA, l_reg, pa0, pa1, pa2, pa3); SBAR();
    SLOAD(SO, (j + 2) * KVBLK); SBAR();
    pv_d0(o, vb0, pa0, pa1, pa2, pa3); partialSM(pB0, pB1, m_reg, mnB, alB);
    __syncthreads(); SWAIT(); SWRITE(0, SE);
    RESC(alB); __syncthreads();
    SBAR(); qkt(pA0, pA1, K_lds, qr, r32, hi);
    finishSM(pB0, pB1, alB, l_reg, pa0, pa1, pa2, pa3); SBAR();
    if (j + 3 < NT) SLOAD(SE, (j + 3) * KVBLK); SBAR();
    pv_d0(o, vb0 + (int)SHM_V, pa0, pa1, pa2, pa3); partialSM(pA0, pA1, m_reg, mnA, alA);
    __syncthreads(); SWAIT(); SWRITE(1, SO);
    RESC(alA); __syncthreads();
  }
  SBAR(); qkt(pB0, pB1, (bf16*)((char*)K_lds + SHM_K), qr, r32, hi);
  finishSM(pA0, pA1, alA, l_reg, pa0, pa1, pa2, pa3); SBAR();
  pv_d0(o, vb0, pa0, pa1, pa2, pa3); partialSM(pB0, pB1, m_reg, mnB, alB);
  __syncthreads(); RESC(alB);
  finishSM(pB0, pB1, alB, l_reg, pa0, pa1, pa2, pa3); SBAR();
  pv_d0(o, vb0 + (int)SHM_V, pa0, pa1, pa2, pa3);
  if (hi == 0) li_l[r32] = l_reg; asm volatile("s_waitcnt lgkmcnt(0)" ::: "memory");
  float rli[16];
#pragma unroll
  for (int r = 0; r < 16; ++r) rli[r] = __builtin_amdgcn_rcpf(li_l[crow(r, hi)]);
  unsigned char* Ow = (unsigned char*)Ob + (long)(wid * QBLK) * LDO;
  unsigned char* stg = (unsigned char*)(lds + OFF_OST) + wid * 4096;
#pragma unroll
  for (int r = 0; r < 16; ++r) { const int orow = crow(r, hi);
#pragma unroll
    for (int d0 = 0; d0 < 4; ++d0) { const float v = __builtin_amdgcn_fmed3f(o[d0][r] * rli[r] * 64.0f, -448.0f, 448.0f); stg[orow * 128 + d0 * 32 + r32] = (unsigned char)__builtin_amdgcn_cvt_pk_fp8_f32(v, v, 0, false); } }
  asm volatile("s_waitcnt lgkmcnt(0)" ::: "memory");
#pragma unroll
  for (int i = 0; i < 4; ++i) { const int row = i * 8 + (lane >> 3), ch = lane & 7; const u32x4 v = *(const u32x4*)(stg + row * 128 + ch * 16); *(GAS u32x4*)(Ow + (long)row * LDO + ch * 16) = v; }
  asm volatile("s_waitcnt lgkmcnt(0)" ::: "memory");
#undef SLOAD
#undef SWRITE
#undef SWAIT
#undef RESC
}
#undef KSWZ
#undef SBAR
}

__device__ __forceinline__ void phase_attention(Frame& F, int layer, char* lds) {
    const bf16* P = (const bf16*)(F.ws + WS_P); unsigned char* AO = F.ws + WS_AO;
    const float* qg_ = inp<I_QG>() + (size_t)layer * 128; const float* rope_ = (const float*)(F.ws + WS_ROPE);
    const int nunits = 1024 + (layer == NLAYER - 1 ? 0 : 128);
    for (int L = F.vcu; L < nunits; L += F.G) {
        const bool lat = L < 1024; const int cidx = L - 1024;
        const int combo = L >> 5, loc = L & 31, b = lat ? (combo >> 2) : (cidx >> 4), h = lat ? ((combo & 3) * 4 + (loc >> 3)) : (cidx & 15), kvh = h >> 2, qb = loc & 7;
        const size_t crow = (size_t)TL + b * CTXL, qrow = lat ? (size_t)b * SEQ + qb * 256 : crow, k1row = lat ? (size_t)b * SEQ : crow;
        attn::attn_unit(P + qrow * INW + h * 128, P + k1row * INW + KVOFF + kvh * 128, P + crow * INW + KVOFF + kvh * 128, lat ? SEQ : CTXL, lat ? SEQ + CTXL : CTXL, AO + qrow * DM + h * 128, lds, qg_, rope_, lat ? qb * 256 : -1);
    }
}

using pg8::f32x4;
struct FNone {};
struct FStoreBf16 { bf16* O; int ldc; float scale;
    typedef FNone Pre; typedef FNone Col;
    __device__ __forceinline__ Col col_load(int, int) const { return Col{}; }
    __device__ __forceinline__ Pre load(int, int) const { return Pre{}; }
    __device__ __forceinline__ void apply(int row, int col, f32x4 v0, f32x4 v1, Pre, Col) const {
        v0 = v0 * scale; v1 = v1 * scale;
        v4u w; w.x = pk2(v0[0], v0[1]); w.y = pk2(v0[2], v0[3]); w.z = pk2(v1[0], v1[1]); w.w = pk2(v1[2], v1[3]);
        *(GAS v4u*)(O + (size_t)row * ldc + col) = w; } };
__device__ __forceinline__ void unpack8(v4u raw, float* v) { v[0] = bflo(raw.x); v[1] = bfhi(raw.x); v[2] = bflo(raw.y); v[3] = bfhi(raw.y); v[4] = bflo(raw.z); v[5] = bfhi(raw.z); v[6] = bflo(raw.w); v[7] = bfhi(raw.w); }
struct FPool { bf16* YB; const bf16* P; const float* pscale;
    struct Pre { v4u g; }; struct Col { f32x4 s0, s1; };
    __device__ __forceinline__ Col col_load(int, int col) const { Col c; c.s0 = *(const GAS f32x4*)(pscale + col); c.s1 = *(const GAS f32x4*)(pscale + col + 4); return c; }
    __device__ __forceinline__ Pre load(int row, int col) const { Pre p; p.g = *(const GAS v4u*)(P + (size_t)row * INW + GBOFF + col); return p; }
    __device__ __forceinline__ void apply(int row, int col, f32x4 v0, f32x4 v1, Pre p, Col c) const {
        float gt[8]; unpack8(p.g, gt);
        float o[8];
#pragma unroll
        for (int e = 0; e < 4; ++e) { o[e] = v0[e] * c.s0[e] * sigmoidf_(gt[e]); o[4 + e] = v1[e] * c.s1[e] * sigmoidf_(gt[4 + e]); }
        v4u w; w.x = pk2(o[0], o[1]); w.y = pk2(o[2], o[3]); w.z = pk2(o[4], o[5]); w.w = pk2(o[6], o[7]);
        *(GAS v4u*)(YB + (size_t)row * DM + col) = w; } };
struct FMerge { bf16* MG; const bf16* P; const bf16* YB; float scale;
    struct Pre { v4u g, y; }; typedef FNone Col;
    __device__ __forceinline__ Col col_load(int, int) const { return Col{}; }
    __device__ __forceinline__ Pre load(int row, int col) const { Pre p; p.g = *(const GAS v4u*)(P + (size_t)row * INW + GAOFF + col); p.y = *(const GAS v4u*)(YB + (size_t)row * DM + col); return p; }
    __device__ __forceinline__ void apply(int row, int col, f32x4 v0, f32x4 v1, Pre p, Col) const {
        v0 = v0 * scale; v1 = v1 * scale;
        float gt[8], yb[8]; unpack8(p.g, gt); unpack8(p.y, yb);
        float o[8];
#pragma unroll
        for (int e = 0; e < 4; ++e) { o[e] = v0[e] * sigmoidf_(gt[e]) + yb[e]; o[4 + e] = v1[e] * sigmoidf_(gt[4 + e]) + yb[4 + e]; }
        v4u w; w.x = pk2(o[0], o[1]); w.y = pk2(o[2], o[3]); w.z = pk2(o[4], o[5]); w.w = pk2(o[6], o[7]);
        *(GAS v4u*)(MG + (size_t)row * DM + col) = w; } };
constexpr float SG_MIN = 1e-20f;
struct FMid { const bf16* P; const float* pscale; float inv_scale;
    struct Pre { v4u ga, gb; }; struct Col { f32x4 s0, s1; };
    __device__ __forceinline__ Col col_load(int, int col) const { Col c; c.s0 = *(const GAS f32x4*)(pscale + col); c.s1 = *(const GAS f32x4*)(pscale + col + 4); return c; }
    __device__ __forceinline__ Pre load(int row, int col) const { Pre p; p.ga = *(const GAS v4u*)(P + (size_t)row * INW + GAOFF + col); p.gb = *(const GAS v4u*)(P + (size_t)row * INW + GBOFF + col); return p; }
    __device__ __forceinline__ f32x4 factor(unsigned ga2a, unsigned ga2b, unsigned gb2a, unsigned gb2b, f32x4 ps) const {
        const float ga[4] = {bflo(ga2a), bfhi(ga2a), bflo(ga2b), bfhi(ga2b)}, gb[4] = {bflo(gb2a), bfhi(gb2a), bflo(gb2b), bfhi(gb2b)};
        f32x4 r;
#pragma unroll
        for (int e = 0; e < 4; ++e) r[e] = ps[e] * sigmoidf_(gb[e]) * (inv_scale * __builtin_amdgcn_rcpf(fmaxf(sigmoidf_(ga[e]), SG_MIN)));
        return r; }
    __device__ __forceinline__ void xform(f32x4& v0, f32x4& v1, Pre p, Col c) const {
        const f32x4 f0 = factor(p.ga.x, p.ga.y, p.gb.x, p.gb.y, c.s0); asm volatile("" ::: "memory"); const f32x4 f1 = factor(p.ga.z, p.ga.w, p.gb.z, p.gb.w, c.s1);
        v0 = v0 * f0; v1 = v1 * f1; } };
struct FMergeC { bf16* MG; const bf16* P; float scale;
    struct Pre { v4u g; }; typedef FNone Col;
    __device__ __forceinline__ Col col_load(int, int) const { return Col{}; }
    __device__ __forceinline__ Pre load(int row, int col) const { Pre p; p.g = *(const GAS v4u*)(P + (size_t)row * INW + GAOFF + col); return p; }
    __device__ __forceinline__ void apply(int row, int col, f32x4 v0, f32x4 v1, Pre p, Col) const {
        float gt[8]; unpack8(p.g, gt);
        float o[8];
#pragma unroll
        for (int e = 0; e < 4; ++e) { o[e] = v0[e] * (scale * fmaxf(sigmoidf_(gt[e]), SG_MIN)); o[4 + e] = v1[e] * (scale * fmaxf(sigmoidf_(gt[4 + e]), SG_MIN)); }
        v4u w; w.x = pk2(o[0], o[1]); w.y = pk2(o[2], o[3]); w.z = pk2(o[4], o[5]); w.w = pk2(o[6], o[7]);
        *(GAS v4u*)(MG + (size_t)row * DM + col) = w; } };
struct FResid { bf16* X; const float* xin; const float* cin; const float* mod; int from_inputs;
    struct Pre { f32x4 x0, x1; }; struct Col { f32x4 g0, g1; };
    __device__ __forceinline__ Col col_load(int row, int col) const {
        const int mr = row < TL ? (row >> 11) : 8;
        const float* g = mod + (size_t)mr * (6 * DM) + 2 * DM + col;
        Col c; c.g0 = *(const GAS f32x4*)g; c.g1 = *(const GAS f32x4*)(g + 4); return c; }
    __device__ __forceinline__ Pre load(int row, int col) const {
        Pre p;
        if (from_inputs) { const float* src = (row < TL ? xin : cin - (size_t)TL * DM) + (size_t)row * DM + col; p.x0 = *(const GAS f32x4*)src; p.x1 = *(const GAS f32x4*)(src + 4); }
        else { p.x0 = *(const GAS f32x4*)(X + (size_t)row * DM + col); p.x1 = p.x0; }
        return p; }
    __device__ __forceinline__ void apply(int row, int col, f32x4 v0, f32x4 v1, Pre p, Col c) const {
        f32x4 x0 = p.x0, x1 = p.x1;
        if (!from_inputs) { const v4u raw = __builtin_bit_cast(v4u, p.x0); x0 = (f32x4){bflo(raw.x), bfhi(raw.x), bflo(raw.y), bfhi(raw.y)}; x1 = (f32x4){bflo(raw.z), bfhi(raw.z), bflo(raw.w), bfhi(raw.w)}; }
        const f32x4 o0 = x0 + c.g0 * v0, o1 = x1 + c.g1 * v1;
        v4u w; w.x = pk2(o0[0], o0[1]); w.y = pk2(o0[2], o0[3]); w.z = pk2(o1[0], o1[1]); w.w = pk2(o1[2], o1[3]);
        *(GAS v4u*)(X + (size_t)row * DM + col) = w; } };

namespace pk {
using f32x16 = __attribute__((ext_vector_type(16))) float;
__device__ __forceinline__ float vmaxf(float a, float b) { float r; asm("v_max_f32 %0, %1, %2" : "=v"(r) : "v"(a), "v"(b)); return r; }
__device__ __forceinline__ float vminf(float a, float b) { float r; asm("v_min_f32 %0, %1, %2" : "=v"(r) : "v"(a), "v"(b)); return r; }
#define PK_CE(x, y) do { const float mx_ = vmaxf(x, y), mn_ = vminf(x, y); x = mx_; y = mn_; } while (0)
template <int OFF> __device__ __forceinline__ void sort16(float (&a)[64]) {
#pragma unroll
    for (int k = 2; k <= 16; k <<= 1)
#pragma unroll
        for (int j = k >> 1; j > 0; j >>= 1)
#pragma unroll
            for (int i = 0; i < 16; ++i) { const int l = i ^ j; if (l > i) { if ((i & k) == 0) PK_CE(a[OFF + i], a[OFF + l]); else PK_CE(a[OFF + l], a[OFF + i]); } }
}
template <int A, int B> __device__ __forceinline__ void merge16(float (&a)[64]) {
#pragma unroll
    for (int i = 0; i < 16; ++i) a[A + i] = vmaxf(a[A + i], a[B + 15 - i]);
#pragma unroll
    for (int j = 8; j > 0; j >>= 1)
#pragma unroll
        for (int i = 0; i < 16; ++i) { const int l = i ^ j; if (l > i) PK_CE(a[A + i], a[A + l]); }
}
__device__ __forceinline__ void top16_of_64(float (&a)[64]) {
    sort16<0>(a); sort16<16>(a); sort16<32>(a); sort16<48>(a);
    merge16<0, 16>(a); merge16<32, 48>(a); merge16<0, 32>(a);
}
struct Cand { int a[50], b[50]; };
constexpr Cand make_cand() { Cand c{}; int n = 0; for (int a = 0; a < 16; ++a) for (int b = 0; b < 16; ++b) if ((a + 1) * (b + 1) <= 16) { c.a[n] = a; c.b[n] = b; ++n; } return c; }
constexpr Cand CAND = make_cand();
constexpr int LDS_KEYS = 0, LDS_IDX = 65536;
}
__device__ __forceinline__ void phase_pk(Frame& F, int layer, int nrows) {
    using namespace pk;
    const int lane = F.lane, r32 = lane & 31, hi = lane >> 5, wave = F.wave;
    const bf16* QP = (const bf16*)(F.ws + WS_P + P_QP);
    int* IDX = (int*)(F.ws + WS_P + P_IDX); float* GW = (float*)(F.ws + WS_P + P_GW);
    const bf16* KB = (const bf16*)(F.ws + WS_KEYS) + (size_t)layer * 2048 * 128;
    const int nunits = (nrows / 256) * 8;
    int cur_hd = -1;
    for (int u = F.bx; u < nunits; u += F.G) {
        const int hd = u & 7, tb = u >> 3;
        if (hd != cur_hd) {
            __syncthreads();
#pragma unroll
            for (int i = 0; i < 8; ++i) { const int idx = F.tid + 512 * i, row = idx >> 4, c = idx & 15;
                const v4u v = *(const GAS v4u*)(KB + ((size_t)hd * 256 + row) * 128 + c * 8);
                *(LAS v4u*)(F.lds + LDS_KEYS + row * 256 + ((c ^ (row & 15)) << 4)) = v; }
            __syncthreads();
            cur_hd = hd;
        }
        const int t0 = tb * 256 + wave * 32;
        float v01[2][16];
#pragma unroll
        for (int p = 0; p < 2; ++p) {
            bf16x8 bq[8];
            const bf16* qrow = QP + (size_t)(t0 + r32) * DM + hd * 256 + p * 128 + hi * 8;
#pragma unroll
            for (int ks = 0; ks < 8; ++ks) bq[ks] = *(const GAS bf16x8*)(qrow + ks * 16);
            f32x16 acc[4];
#pragma unroll
            for (int nb = 0; nb < 4; ++nb) acc[nb] = f32x16{};
            const LAS unsigned char* kbase = F.lds + LDS_KEYS + (p * 128 + r32) * 256;
#pragma unroll
            for (int ks = 0; ks < 8; ++ks) { const int coff = ((2 * ks + hi) ^ (r32 & 15)) << 4;
#pragma unroll
                for (int nb = 0; nb < 4; ++nb) { const bf16x8 ak = *(const LAS bf16x8*)(kbase + nb * 32 * 256 + coff);
                    acc[nb] = __builtin_amdgcn_mfma_f32_32x32x16_bf16(ak, bq[ks], acc[nb], 0, 0, 0); } }
            float a[64]; const unsigned hib = (unsigned)hi << 2;
#pragma unroll
            for (int nb = 0; nb < 4; ++nb)
#pragma unroll
                for (int r = 0; r < 16; ++r) { const unsigned n0 = 32u * nb + (r & 3) + 8u * (r >> 2);
                    a[nb * 16 + r] = __uint_as_float(((__float_as_uint(acc[nb][r]) & ~127u) | n0) | hib); }
            top16_of_64(a);
            float m0[64];
#pragma unroll
            for (int i = 0; i < 16; ++i) { auto rr = __builtin_amdgcn_permlane32_swap(__float_as_uint(a[i]), __float_as_uint(a[i]), false, false);
                m0[i] = __uint_as_float(rr[0]); m0[16 + i] = __uint_as_float(rr[1]); }
            merge16<0, 16>(m0);
#pragma unroll
            for (int i = 0; i < 16; ++i) v01[p][i] = m0[i];
        }
        LAS unsigned* tab = (LAS unsigned*)(F.lds + LDS_IDX + wave * 8192);
#pragma unroll
        for (int i = 0; i < 16; ++i) { tab[i * 64 + lane] = __float_as_uint(v01[0][i]) & 127u; tab[(16 + i) * 64 + lane] = __float_as_uint(v01[1][i]) & 127u; }
        float c[64];
        float f0[16], f1[16];
#pragma unroll
        for (int i = 0; i < 16; ++i) { f0[i] = __uint_as_float(__float_as_uint(v01[0][i]) & ~127u); f1[i] = __uint_as_float(__float_as_uint(v01[1][i]) & ~127u); }
#pragma unroll
        for (int i = 0; i < 50; ++i) c[i] = __uint_as_float((__float_as_uint(f0[CAND.a[i]] + f1[CAND.b[i]]) & ~255u) | (unsigned)(CAND.a[i] * 16 + CAND.b[i]));
#pragma unroll
        for (int i = 50; i < 64; ++i) c[i] = -INFINITY;
        top16_of_64(c);
        float ev[16], sum = 0.f;
#pragma unroll
        for (int i = 0; i < 16; ++i) { ev[i] = __expf(__uint_as_float(__float_as_uint(c[i]) & ~255u) - __uint_as_float(__float_as_uint(c[0]) & ~255u)); sum += ev[i]; }
        const float rinv = 1.0f / sum;
        LDS_WAIT();
        int eid[8]; float gw[8];
#pragma unroll
        for (int j = 0; j < 8; ++j) { const float cj = hi ? c[8 + j] : c[j]; const unsigned bits = __float_as_uint(cj);
            const unsigned ia = tab[((bits >> 4) & 15u) * 64 + lane], ib = tab[(16u + (bits & 15u)) * 64 + lane];
            eid[j] = (int)(ia * 128u + ib); gw[j] = (hi ? ev[8 + j] : ev[j]) * rinv; }
        const size_t o = (size_t)(t0 + r32) * NSEL + hd * 16 + hi * 8;
        *(GAS v4u*)(IDX + o) = (v4u){(unsigned)eid[0], (unsigned)eid[1], (unsigned)eid[2], (unsigned)eid[3]}; *(GAS v4u*)(IDX + o + 4) = (v4u){(unsigned)eid[4], (unsigned)eid[5], (unsigned)eid[6], (unsigned)eid[7]};
        *(GAS f32x4*)(GW + o) = (f32x4){gw[0], gw[1], gw[2], gw[3]}; *(GAS f32x4*)(GW + o + 4) = (f32x4){gw[4], gw[5], gw[6], gw[7]};
        LDS_WAIT();
    }
}

typedef float f32x2 __attribute__((ext_vector_type(2)));
typedef __bf16 bf16x2_t __attribute__((ext_vector_type(2)));
struct RowV { v4u a, b; };
__device__ __forceinline__ void rowv_load(RowV& r, const unsigned char* tab, int idA, int idB, int hi, int j32) {
    const unsigned off = (unsigned)(hi ? idB : idA) * 1024u + (unsigned)j32;
    const unsigned char* p = tab + off;
    r.a = *(const GAS v4u*)p; r.b = *(const GAS v4u*)(p + 16);
}
#define DW_B(b) do { const f32x2 d_ = __builtin_amdgcn_cvt_scalef32_pk_f32_fp4(dw, 1.0f, b); asm("v_pk_fma_f32 %0, %1, %2, %0" : "+v"(o[b]) : "v"(d_), "v"(w2)); } while (0)
__device__ __forceinline__ void dw_axpy(unsigned dw, f32x2 w2, f32x2* o) { DW_B(0); DW_B(1); DW_B(2); DW_B(3);
    __builtin_amdgcn_sched_barrier(0); }
__device__ __forceinline__ void rowv_axpy(const RowV& r, float w, f32x2 (&o)[32]) {
    const f32x2 w2 = {w, w};
    dw_axpy(r.a.x, w2, o); dw_axpy(r.a.y, w2, o + 4); dw_axpy(r.a.z, w2, o + 8); dw_axpy(r.a.w, w2, o + 12);
    dw_axpy(r.b.x, w2, o + 16); dw_axpy(r.b.y, w2, o + 20); dw_axpy(r.b.z, w2, o + 24); dw_axpy(r.b.w, w2, o + 28);
}
#define DW_D(dw, b, hidx) acc = __builtin_amdgcn_fdot2_f32_bf16(__builtin_amdgcn_cvt_scalef32_pk_bf16_fp4(dw, 1.0f, b), __builtin_bit_cast(bf16x2_t, h[hidx]), acc, false)
__device__ __forceinline__ float rowv_dot(const RowV& r, const unsigned (&h)[32]) {
    float acc = 0.f;
    DW_D(r.a.x, 0, 0); DW_D(r.a.x, 1, 1); DW_D(r.a.x, 2, 2); DW_D(r.a.x, 3, 3);       DW_D(r.a.y, 0, 4); DW_D(r.a.y, 1, 5); DW_D(r.a.y, 2, 6); DW_D(r.a.y, 3, 7);
    DW_D(r.a.z, 0, 8); DW_D(r.a.z, 1, 9); DW_D(r.a.z, 2, 10); DW_D(r.a.z, 3, 11);    DW_D(r.a.w, 0, 12); DW_D(r.a.w, 1, 13); DW_D(r.a.w, 2, 14); DW_D(r.a.w, 3, 15);
    DW_D(r.b.x, 0, 16); DW_D(r.b.x, 1, 17); DW_D(r.b.x, 2, 18); DW_D(r.b.x, 3, 19);  DW_D(r.b.y, 0, 20); DW_D(r.b.y, 1, 21); DW_D(r.b.y, 2, 22); DW_D(r.b.y, 3, 23);
    DW_D(r.b.z, 0, 24); DW_D(r.b.z, 1, 25); DW_D(r.b.z, 2, 26); DW_D(r.b.z, 3, 27);  DW_D(r.b.w, 0, 28); DW_D(r.b.w, 1, 29); DW_D(r.b.w, 2, 30); DW_D(r.b.w, 3, 31);
    return acc;
}
template <int CTRL, int ROWMASK> __device__ __forceinline__ float dpp_add(float v) {
    return v + __uint_as_float((unsigned)__builtin_amdgcn_update_dpp(0, (int)__float_as_uint(v), CTRL, ROWMASK, 0xF, false)); }
__device__ __forceinline__ void reduce4x2(const float (&p)[4], float (&tot)[8]) {
    float r[4];
#pragma unroll
    for (int i = 0; i < 4; ++i) r[i] = dpp_add<0xB1, 0xF>(p[i]);
#pragma unroll
    for (int i = 0; i < 4; ++i) r[i] = dpp_add<0x4E, 0xF>(r[i]);
#pragma unroll
    for (int i = 0; i < 4; ++i) r[i] = dpp_add<0x141, 0xF>(r[i]);
#pragma unroll
    for (int i = 0; i < 4; ++i) r[i] = dpp_add<0x140, 0xF>(r[i]);
#pragma unroll
    for (int i = 0; i < 4; ++i) r[i] = dpp_add<0x142, 0xA>(r[i]);
#pragma unroll
    for (int i = 0; i < 4; ++i) { tot[2 * i] = __uint_as_float(__builtin_amdgcn_readlane(__float_as_uint(r[i]), 31)); tot[2 * i + 1] = __uint_as_float(__builtin_amdgcn_readlane(__float_as_uint(r[i]), 63)); }
}
__device__ __forceinline__ float gelu_erf(float s) { return 0.5f * s * (1.0f + erff(s * 0.70710678118654752f)); }
__device__ __forceinline__ float rdl(float v, int l) { return __uint_as_float(__builtin_amdgcn_readlane(__float_as_uint(v), l)); }
__device__ __forceinline__ void phase_peer(Frame& F, int layer, int nrows) {
    const int gw = F.vcu * NWAVES + F.wave, NGW = F.G * NWAVES, lane = F.lane, hi = lane >> 5;
    const int* IDX = (const int*)(F.ws + WS_P + P_IDX); const float* GW = (const float*)(F.ws + WS_P + P_GW);
    const unsigned char* PU = F.ws + WS_PU + (size_t)layer * 32 * MiB; const unsigned char* PV = F.ws + WS_PV + (size_t)layer * 32 * MiB;
    const float* SCU = (const float*)(F.ws + WS_SCU) + (size_t)layer * NEXP; const float* SCV = (const float*)(F.ws + WS_SCV) + (size_t)layer * NEXP;
    bf16* H = (bf16*)(F.ws + WS_H); bf16* X = (bf16*)(F.ws + WS_X);
    const float* fg_ = inp<I_FG>(); float* out_ = (float*)inp<I_OUT>();
    for (int t = gw; t < nrows; t += NGW) {
        const int id0 = *(const GAS int*)(IDX + (size_t)t * NSEL + lane), id1 = *(const GAS int*)(IDX + (size_t)t * NSEL + 64 + lane);
        const float g0 = *(const GAS float*)(GW + (size_t)t * NSEL + lane), g1 = *(const GAS float*)(GW + (size_t)t * NSEL + 64 + lane);
        const float su0 = *(const GAS float*)(SCU + id0), su1 = *(const GAS float*)(SCU + id1), sv0 = *(const GAS float*)(SCV + id0), sv1 = *(const GAS float*)(SCV + id1);
        unsigned hp[32];
        { const bf16* hrow = H + (size_t)t * DM + (lane & 31) * 8;
#pragma unroll
          for (int jj = 0; jj < 8; ++jj) { const v4u q = *(const GAS v4u*)(hrow + 256 * jj); hp[2 * jj] = q.x; hp[2 * jj + 1] = q.y; hp[16 + 2 * jj] = q.z; hp[16 + 2 * jj + 1] = q.w; } }
        float s0 = 0.f, s1 = 0.f;
        const int j32 = (lane & 31) * 32;
        RowV A[2], B[2];
#define LOAD2(buf, tab, idv, base) do { _Pragma("unroll") for (int q = 0; q < 2; ++q) rowv_load(buf[q], tab, __builtin_amdgcn_readlane(idv, (base) + 2 * q), __builtin_amdgcn_readlane(idv, (base) + 2 * q + 1), hi, j32); } while (0)
#define USTEP(sv_, base, tabn, idn, basen) do { float p_[4], tt_[8]; \
        _Pragma("unroll") for (int q = 0; q < 2; ++q) { p_[q] = rowv_dot(A[q], hp); __builtin_amdgcn_sched_barrier(0); } LOAD2(A, tabn, idn, basen); __builtin_amdgcn_sched_barrier(0); \
        _Pragma("unroll") for (int q = 0; q < 2; ++q) { p_[2 + q] = rowv_dot(B[q], hp); __builtin_amdgcn_sched_barrier(0); } LOAD2(B, tabn, idn, (basen) + 4); __builtin_amdgcn_sched_barrier(0); \
        reduce4x2(p_, tt_); _Pragma("unroll") for (int q = 0; q < 8; ++q) sv_ = (lane == (base) + q) ? tt_[q] : sv_; } while (0)
        LOAD2(A, PU, id0, 0); LOAD2(B, PU, id0, 4);
#pragma unroll 1
        for (int b = 0; b < 56; b += 8) USTEP(s0, b, PU, id0, b + 8);
        USTEP(s0, 56, PU, id1, 0);
#pragma unroll 1
        for (int b = 0; b < 56; b += 8) USTEP(s1, b, PU, id1, b + 8);
        USTEP(s1, 56, PV, id0, 0);
        const float w0 = g0 * gelu_erf(s0 * su0) * sv0, w1 = g1 * gelu_erf(s1 * su1) * sv1;
        f32x2 av[32];
#pragma unroll
        for (int i = 0; i < 32; ++i) av[i] = (f32x2){0.f, 0.f};
#define VSTEP(wv_, base, idn, basen) do { \
        _Pragma("unroll") for (int q = 0; q < 2; ++q) { const float we_ = rdl(wv_, (base) + 2 * q), wo_ = rdl(wv_, (base) + 2 * q + 1); rowv_axpy(A[q], hi ? wo_ : we_, av); } LOAD2(A, PV, idn, basen); \
        _Pragma("unroll") for (int q = 0; q < 2; ++q) { const float we_ = rdl(wv_, (base) + 4 + 2 * q), wo_ = rdl(wv_, (base) + 4 + 2 * q + 1); rowv_axpy(B[q], hi ? wo_ : we_, av); } LOAD2(B, PV, idn, (basen) + 4); } while (0)
#pragma unroll 1
        for (int b = 0; b < 56; b += 8) VSTEP(w0, b, id0, b + 8);
        VSTEP(w0, 56, id1, 0);
        const int col0 = (lane & 31) * 8 + hi * 4;
        const float* mp = mod_ptr(F, layer, t);
        v2u xr_[8]; f32x4 gf_[8];
#pragma unroll
        for (int j = 0; j < 8; ++j) { const int col = col0 + 256 * j; xr_[j] = *(const GAS v2u*)(X + (size_t)t * DM + col); gf_[j] = *(const GAS f32x4*)(mp + 5 * DM + col); }
#pragma unroll 1
        for (int b = 0; b < 56; b += 8) VSTEP(w1, b, id1, b + 8);
        VSTEP(w1, 56, id1, 56);
#undef LOAD2
#undef USTEP
#undef VSTEP
        float acc[32];
#pragma unroll
        for (int i = 0; i < 32; ++i) { auto rr = __builtin_amdgcn_permlane32_swap(__float_as_uint(av[i >> 1][i & 1]), __float_as_uint(av[16 + (i >> 1)][i & 1]), false, false);
            acc[i] = __uint_as_float(rr[0]) + __uint_as_float(rr[1]); }
        float xn[32]; float ss = 0.f;
#pragma unroll
        for (int j = 0; j < 8; ++j) {
            const v2u xr = xr_[j]; const f32x4 x0 = {bflo(xr.x), bfhi(xr.x), bflo(xr.y), bfhi(xr.y)}, gf = gf_[j];
            float* o = xn + 4 * j;
            o[0] = x0.x + gf.x * acc[4 * j]; o[1] = x0.y + gf.y * acc[4 * j + 1]; o[2] = x0.z + gf.z * acc[4 * j + 2]; o[3] = x0.w + gf.w * acc[4 * j + 3];
            ss += (o[0] * o[0] + o[1] * o[1]) + (o[2] * o[2] + o[3] * o[3]); }
        const float rs = 1.0f / sqrtf(wave_sum(ss) * (1.0f / DM) + EPS);
        if (layer == NLAYER - 1) {
#pragma unroll
            for (int j = 0; j < 8; ++j) { const int col = col0 + 256 * j; const float* o = xn + 4 * j;
                const f32x4 fg = *(const GAS f32x4*)(fg_ + col);
                *(GAS f32x4*)(out_ + (size_t)t * DM + col) = (f32x4){o[0] * rs * fg.x, o[1] * rs * fg.y, o[2] * rs * fg.z, o[3] * rs * fg.w}; }
        } else {
            const float* mn = mod_ptr(F, layer + 1, t);
#pragma unroll
            for (int j = 0; j < 8; ++j) { const int col = col0 + 256 * j; const float* o = xn + 4 * j;
                { v2u xw; xw.x = pk2(o[0], o[1]); xw.y = pk2(o[2], o[3]); *(GAS v2u*)(X + (size_t)t * DM + col) = xw; }
                const f32x4 sh = *(const GAS f32x4*)(mn + col), sc = *(const GAS f32x4*)(mn + DM + col);
                v2u w; w.x = pk2(o[0] * rs * (1.0f + sc.x) + sh.x, o[1] * rs * (1.0f + sc.y) + sh.y); w.y = pk2(o[2] * rs * (1.0f + sc.z) + sh.z, o[3] * rs * (1.0f + sc.w) + sh.w);
                *(GAS v2u*)(H + (size_t)t * DM + col) = w;
                *(GAS unsigned*)(F.ws + WS_H8 + (size_t)t * DM + col) = pk4_fp8(o[0] * rs * (1.0f + sc.x) + sh.x, o[1] * rs * (1.0f + sc.y) + sh.y, o[2] * rs * (1.0f + sc.z) + sh.z, o[3] * rs * (1.0f + sc.w) + sh.w); }
        }
    }
}

constexpr int PH_PER_LAYER = 10, PH_BASE = 3, N_PHASES = PH_BASE + NLAYER * PH_PER_LAYER;
struct Args { const float* in[18]; float* out; unsigned char* ws; int ph_lo, ph_hi; };
__global__ void __launch_bounds__(NWAVES * 64, 2) mk_fwd(Args args) {
    extern __shared__ __attribute__((aligned(16))) unsigned char lds[];
    unsigned char* const wsbase = args.ws;
    for (int u = threadIdx.x; u < (LDS_BYTES - LDSCTL_OFF) / 4; u += NWAVES * 64) ((LAS unsigned*)((LAS unsigned char*)lds + LDSCTL_OFF))[u] = 0u;
    __syncthreads();
    unsigned* ctl = (unsigned*)(args.ws + WS_CTL);
    XcdBarrier bar; bar.bar = ctl + CW_BAR; bar.x = 0; bar.st = nullptr;
#if !MK_PER_PHASE
    bar = xcd_barrier_post(ctl + CW_BAR, (volatile LAS unsigned*)((LAS unsigned char*)lds + MISC_OFF) + 8);
#endif
    const int lo = args.ph_lo, hi = args.ph_hi;
#ifndef PHM
#define PHM 0xFFFF
#endif
#define EN(b) ((PHM >> (b)) & 1)
#define IN(k) (lo <= (k) && (k) < hi)
#define SEAM(k) do { if (IN(k) && IN((k) + 1)) xcd_barrier(bar); } while (0)
    if (EN(0) && IN(0)) { Frame F = mkframe(lds, wsbase); phase_prologue(F); } SEAM(0);
    if (EN(1) && IN(1)) { Frame F = mkframe(lds, wsbase); phase_mod_finalize(F); } SEAM(1);
    if (EN(2) && IN(2)) { Frame F = mkframe(lds, wsbase); phase_modulate(F, 0, 0, TT, true, true); } SEAM(2);
#pragma unroll 1
    for (int layer = 0; layer < NLAYER; ++layer) {
        const int pb = PH_BASE + layer * PH_PER_LAYER;
        const bool lastl = (layer == NLAYER - 1);
        const int MR = lastl ? TL : TT;
        if (EN(3) && IN(pb + 0)) {
            Frame F = mkframe(lds, wsbase); bf16* P = (bf16*)(F.ws + WS_P); bf16* H = (bf16*)(F.ws + WS_H); (void)P; (void)H;
            {
                pg8::Gemm<DM, DM, DM, 0, 0, 2> g{H, F.ws + WS_WIN + (size_t)layer * 32 * MiB};
                pg8::SplitOrder S; S.S.init(MR, 4 * 256, F.G, F.bx); S.kind = 0; S.pm0 = 0; S.nMx = 0;
                pg8::EpiRow8<FStoreBf16> E{{P, INW, 1.0f}};
                pg8::gemm_phase(F.lds, g, S, E); }
            {
                pg8::Gemm<DM, DM, DM, 0, 0, 1> g{F.ws + WS_H8, F.ws + WS_WIN8 + (size_t)layer * 32 * MiB};
                pg8::SplitOrder S; S.S.init(MR, 28 * 256, F.G, F.G - 1 - F.bx); S.kind = 1; S.pm0 = TL / 256; S.nMx = 0;
                pg8::EpiRow8<FStoreBf16> E{{P, INW, 1.0f / W8_SCALE}};
                pg8::gemm_phase(F.lds, g, S, E);
                if (lastl)
                    for (int q = F.vcu; q < (TC / 128) * 8; q += F.G) pg8::gemm_quarter(F.lds, g, TL / 128 + (q >> 3), KVOFF / 128 + (q & 7), E); }
        }
        SEAM(pb + 0);
        if (EN(4) && IN(pb + 1)) { Frame F = mkframe(lds, wsbase); phase_post(F, layer); }
        SEAM(pb + 1);
        if (EN(5) && IN(pb + 2)) {
            Frame F = mkframe(lds, wsbase); bf16* P = (bf16*)(F.ws + WS_P); bf16* H = (bf16*)(F.ws + WS_H); (void)P; (void)H;
            if (!lastl) {
              pg8::Gemm<1024, 256, 256, 256, 1> g{(const bf16*)(F.ws + WS_POOLED), (const bf16*)(F.ws + WS_WPOOL + (size_t)layer * 1 * MiB)};
              pg8::EpiRow8<FPool> E{{(bf16*)(F.ws + WS_YB), P, inp<I_PSCALE>() + (size_t)layer * DM}};
              for (int q = F.vcu; q < (TC / 128) * (DM / 128); q += F.G) { const int grp = q >> 5, r = q & 31; pg8::gemm_quarter(F.lds, g, TL / 128 + (grp >> 1) * 4 + (r & 3), (grp & 1) * 8 + (r >> 2), E); } }
            phase_attention(F, layer, (char*)lds);
        }
        SEAM(pb + 2);
        if (EN(6) && IN(pb + 3)) {
            Frame F = mkframe(lds, wsbase); bf16* P = (bf16*)(F.ws + WS_P); bf16* H = (bf16*)(F.ws + WS_H); (void)P; (void)H;
            pg8::Gemm<DM, DM, DM, 0, 0, 1> g{F.ws + WS_AO, F.ws + WS_WBR8 + (size_t)layer * 32 * MiB};
            pg8::StaticOrder S; S.init(TL, DM, F.G, F.bx);
            pg8::EpiRow8<FMerge> E{{H, P, (const bf16*)(F.ws + WS_YB), 1.0f / (64.0f * W8_SCALE)}};
            {
                pg8::Gemm<1024, 256, 256, 256, 1> gp{(const bf16*)(F.ws + WS_POOLED), (const bf16*)(F.ws + WS_WPOOL + (size_t)layer * 1 * MiB)};
                pg8::MidRow8<FMid> Mx{{P, inp<I_PSCALE>() + (size_t)layer * DM, 64.0f * W8_SCALE}};
                pg8::EpiRow8<FMergeC> Ec{{H, P, 1.0f / (64.0f * W8_SCALE)}};
                pg8::gemm_chain(F.lds, gp, g, S, Mx, Ec); }
            if (!lastl)
                for (int q = F.vcu; q < (TC / 128) * (DM / 128); q += F.G) { const int grp = q >> 5, r = q & 31; pg8::gemm_quarter(F.lds, g, TL / 128 + (grp >> 1) * 4 + (r & 3), (grp & 1) * 8 + (r >> 2), E); }
        }
        SEAM(pb + 3);
        if (EN(7) && IN(pb + 4)) {
            Frame F = mkframe(lds, wsbase); bf16* P = (bf16*)(F.ws + WS_P); bf16* H = (bf16*)(F.ws + WS_H); (void)P; (void)H;
            pg8::Gemm<DM, DM, DM, 0, 0> g{H, (const bf16*)(F.ws + WS_WOUT + (size_t)layer * 8 * MiB)};
            pg8::StaticOrder S; S.init(TL, DM, F.G, F.bx);
            pg8::EpiRow8<FResid> E{{(bf16*)(F.ws + WS_X), inp<I_X>(), inp<I_CTX>(), (const float*)(F.ws + WS_MOD) + (size_t)layer * 9 * 6 * DM, layer == 0 ? 1 : 0}};
            pg8::gemm_phase(F.lds, g, S, E);
            if (!lastl)
                for (int q = F.vcu; q < (TC / 128) * (DM / 128); q += F.G) { const int grp = q >> 5, r = q & 31; pg8::gemm_quarter(F.lds, g, TL / 128 + (grp >> 1) * 4 + (r & 3), (grp & 1) * 8 + (r >> 2), E); }
        }
        SEAM(pb + 4);
        if (EN(8) && IN(pb + 5)) { Frame F = mkframe(lds, wsbase); phase_modulate(F, layer, 1, MR, false, false); }
        SEAM(pb + 5);
        if (EN(9) && IN(pb + 6)) {
            Frame F = mkframe(lds, wsbase); bf16* P = (bf16*)(F.ws + WS_P); bf16* H = (bf16*)(F.ws + WS_H); (void)P; (void)H;
            pg8::Gemm<DM, DM, DM, 0, 0> g{H, (const bf16*)(F.ws + WS_WQP + (size_t)layer * 8 * MiB)};
            pg8::StaticOrder S; S.init(TL, DM, F.G, F.bx);
            pg8::EpiRow8<FStoreBf16> E{{(bf16*)(F.ws + WS_P + P_QP), DM, 1.0f}};
            pg8::gemm_phase(F.lds, g, S, E);
            if (!lastl)
                for (int q = F.vcu; q < (TC / 128) * (DM / 128); q += F.G) { const int grp = q >> 5, r = q & 31; pg8::gemm_quarter(F.lds, g, TL / 128 + (grp >> 1) * 4 + (r & 3), (grp & 1) * 8 + (r >> 2), E); }
        }
        if (IN(pb + 6) && IN(pb + 8)) xcd_barrier(bar);
        if (EN(11) && IN(pb + 8)) { Frame F = mkframe(lds, wsbase); phase_pk(F, layer, MR); }
        SEAM(pb + 8);
        if (EN(12) && IN(pb + 9)) { Frame F = mkframe(lds, wsbase); phase_peer(F, layer, MR); }
        if (!lastl) SEAM(pb + 9);
    }
#undef IN
#undef SEAM
}

extern "C" void kernel_launch(void* const* d_in, const int* in_sizes, int n_in, void* d_out, int out_size, void* d_ws, size_t ws_size, hipStream_t stream) {
    static int grid = 0;
    if (grid == 0) {
        if (n_in != 18 || out_size != TL * DM || ws_size < WS_END) { fprintf(stderr, "kernel_launch: unexpected shapes (n_in %d out %d ws %zu need %zu)\n", n_in, out_size, ws_size, (size_t)WS_END); grid = -1; return; }
        int dev = 0, cus = 0, per_cu = 0;
        if (hipGetDevice(&dev) != hipSuccess || hipDeviceGetAttribute(&cus, hipDeviceAttributeMultiprocessorCount, dev) != hipSuccess) { grid = -1; return; }
        if (hipFuncSetAttribute((const void*)mk_fwd, hipFuncAttributeMaxDynamicSharedMemorySize, LDS_BYTES) != hipSuccess) { fprintf(stderr, "kernel_launch: hipFuncSetAttribute failed\n"); grid = -1; return; }
        if (hipOccupancyMaxActiveBlocksPerMultiprocessor(&per_cu, (const void*)mk_fwd, NWAVES * 64, LDS_BYTES) != hipSuccess || per_cu < 1)
            fprintf(stderr, "kernel_launch: occupancy query reports %d\n", per_cu);
        (void)hipGetLastError();
        grid = cus;
    }
    if (grid < 0) return;
    if (hipMemsetAsync((char*)d_ws + WS_CTL, 0, CTL_ZERO_BYTES, stream) != hipSuccess) return;
    Args a{};
    for (int i = 0; i < 18; ++i) a.in[i] = (const float*)d_in[i];
    a.out = (float*)d_out; a.ws = (unsigned char*)d_ws;
#if MK_PER_PHASE
    for (int p = 0; p < N_PHASES; ++p) { a.ph_lo = p; a.ph_hi = p + 1; hipLaunchKernelGGL(mk_fwd, dim3(grid), dim3(NWAVES * 64), LDS_BYTES, stream, a); }
#else
    a.ph_lo = 0; a.ph_hi = N_PHASES;
    hipLaunchKernelGGL(mk_fwd, dim3(grid), dim3(NWAVES * 64), LDS_BYTES, stream, a);
#endif
    const hipError_t le = hipPeekAtLastError();
    if (le != hipSuccess) fprintf(stderr, "kernel_launch: launch failed: %s\n", hipGetErrorName(le));
}
```

```cpp
#include <hip/hip_runtime.h>
#include <cstdio>
#include <cstdint>

#ifndef MK_PER_PHASE
#define MK_PER_PHASE 0
#endif

namespace pg8 {
#define PG8_LAS __attribute__((address_space(3)))
typedef unsigned short bf16_t;
typedef short bf16x8 __attribute__((ext_vector_type(8)));
typedef float f32x4 __attribute__((ext_vector_type(4)));
typedef unsigned u32x4 __attribute__((ext_vector_type(4)));
constexpr int BM = 256, BK = 64, HALF = 128, HTB = HALF * BK * 2, STAGE_BYTES = 8 * HTB, NXCD = 8, WGM = 8;

__host__ __device__ __forceinline__ int lds_byte(int r, int c) { const int st = (r >> 4) * 2 + (c >> 5), rr = r & 15, cc = c & 31, ob = rr * 64 + cc * 2; return st * 1024 + (ob ^ (((ob >> 9) & 1) << 5)); }
__host__ __device__ __forceinline__ void stage_rc(int b, int& R, int& C) { const int st = b / 1024, sb = b % 1024, swz = sb ^ (((sb >> 9) & 1) << 5); R = (st >> 1) * 16 + swz / 64; C = (st & 1) * 32 + (swz % 64) / 2; }
__host__ __device__ __forceinline__ int perm32(int rho) { const int n = rho >> 4, i = rho & 15; return 8 * (i >> 2) + 4 * n + (i & 3); }

struct Unit { int pm, pn; };
template <int LDA, int LDB, int KK, int AKSTEP, int AKSHIFT, int EB_ = 2> struct Gemm { const void* A; const void* Bt;
    static constexpr int lda = LDA, ldb = LDB, K = KK, akstep = AKSTEP, akshift = AKSHIFT, EB = EB_; };

struct StaticOrder {
    int nM, nN, nwg, G, c;
    __device__ void init(int M, int N, int G_, int c_) { nM = M / BM; nN = N / BM; nwg = nM * nN; G = G_; c = c_; }
    __device__ bool next(int i, Unit& u) const {
        const long L = (long)i * G + c; if (L >= nwg) return false;
        int wgid = (int)L; { const int q = nwg / NXCD, r = nwg % NXCD, xcd = wgid % NXCD, off = wgid / NXCD; wgid = (xcd < r ? xcd * (q + 1) : r * (q + 1) + (xcd - r) * q) + off; }
        const int nig = WGM * nN, gid = wgid / nig, fm = gid * WGM, gsz = (nM - fm) < WGM ? (nM - fm) : WGM;
        u.pm = fm + ((wgid % nig) % gsz); u.pn = (wgid % nig) / gsz; return true;
    }
};
struct SplitOrder {
    StaticOrder S; int kind, pm0, nMx;
    __device__ bool next(int i, Unit& u) const {
        const long L = (long)i * S.G + S.c;
        if (L < S.nwg) { S.next(i, u); u.pn = kind == 0 ? 12 + u.pn : (u.pn < 12 ? u.pn : u.pn + 4); return true; }
        const int j = (int)(L - S.nwg); if (j >= nMx * 4) return false;
        u.pm = pm0 + j / 4; u.pn = 8 + j % 4; return true;
    }
};

template <class F> struct EpiRow8 {
    static constexpr bool PERM = true;
    F f;
    __device__ __forceinline__ void operator()(const f32x4 (&acc)[2][2][4][2], const Unit& u, int wr, int wc, int fr, int fq) const {
        const int row0 = u.pm * BM + wr * 64 + fr, col0 = u.pn * BM + wc * 32 + 8 * fq;
        typename F::Col cp[2];
#pragma unroll
        for (int bj = 0; bj < 2; ++bj) cp[bj] = f.col_load(row0, col0 + bj * HALF);
#pragma unroll
        for (int ai = 0; ai < 2; ++ai) {
            typename F::Pre pre[4][2];
#pragma unroll
            for (int m = 0; m < 4; ++m)
#pragma unroll
                for (int bj = 0; bj < 2; ++bj) pre[m][bj] = f.load(row0 + ai * HALF + m * 16, col0 + bj * HALF);
#pragma unroll
            for (int m = 0; m < 4; ++m)
#pragma unroll
                for (int bj = 0; bj < 2; ++bj) f.apply(row0 + ai * HALF + m * 16, col0 + bj * HALF, acc[ai][bj][m][0], acc[ai][bj][m][1], pre[m][bj], cp[bj]);
            asm volatile("" ::: "memory");
        }
    }
    __device__ __forceinline__ void quarter(const f32x4 (&acc)[1][1][4][2], int rowo, int colo, int wr, int wc, int fr, int fq) const {
        const int row0 = rowo + wr * 64 + fr, col0 = colo + wc * 32 + 8 * fq;
        const typename F::Col cp = f.col_load(row0, col0);
        typename F::Pre pre[4];
#pragma unroll
        for (int m = 0; m < 4; ++m) pre[m] = f.load(row0 + m * 16, col0);
#pragma unroll
        for (int m = 0; m < 4; ++m) f.apply(row0 + m * 16, col0, acc[0][0][m][0], acc[0][0][m][1], pre[m], cp);
    }
};

template <class F> struct EpiPair {
    static constexpr bool PERM = true;
    F f;
    __device__ __forceinline__ void operator()(const f32x4 (&acc)[2][2][4][2], const Unit& u, int wr, int wc, int fr, int fq) const {
        const int row0 = u.pm * BM + wr * 64 + fr, col0 = u.pn * BM + wc * 32 + 8 * fq;
#pragma unroll
        for (int ai = 0; ai < 2; ++ai)
#pragma unroll
            for (int m = 0; m < 4; ++m) f.apply2(row0 + ai * HALF + m * 16, col0, acc[ai][0][m][0], acc[ai][0][m][1], acc[ai][1][m][0], acc[ai][1][m][1]);
    }
    __device__ __forceinline__ void quarter(const f32x4 (&acc)[1][1][4][2], int rowo, int colo, int wr, int wc, int fr, int fq) const {
        const int row0 = rowo + wr * 64 + fr, col0 = colo + wc * 32 + 8 * fq;
#pragma unroll
        for (int m = 0; m < 4; ++m) f.apply(row0 + m * 16, col0, acc[0][0][m][0], acc[0][0][m][1]);
    }
};
template <class F> struct MidRow8 {
    F f;
    __device__ __forceinline__ void operator()(f32x4 (&acc)[2][2][4][2], const Unit& u, int wr, int wc, int fr, int fq) const {
        const int row0 = u.pm * BM + wr * 64 + fr, col0 = u.pn * BM + wc * 32 + 8 * fq;
        typename F::Col cp[2];
#pragma unroll
        for (int bj = 0; bj < 2; ++bj) cp[bj] = f.col_load(row0, col0 + bj * HALF);
#pragma unroll
        for (int ai = 0; ai < 2; ++ai) {
            typename F::Pre pre[4][2];
#pragma unroll
            for (int m = 0; m < 4; ++m)
#pragma unroll
                for (int bj = 0; bj < 2; ++bj) pre[m][bj] = f.load(row0 + ai * HALF + m * 16, col0 + bj * HALF);
#pragma unroll
            for (int m = 0; m < 4; ++m)
#pragma unroll
                for (int bj = 0; bj < 2; ++bj) f.xform(acc[ai][bj][m][0], acc[ai][bj][m][1], pre[m][bj], cp[bj]);
            asm volatile("" ::: "memory");
        }
    }
};
struct BlockOrder {
    int pm0, nM, nN, G, c;
    __device__ bool next(int i, Unit& u) const { const long k = (long)i * G + c; if (k >= (long)nM * nN) return false; u.pm = pm0 + (int)(k / nN); u.pn = (int)(k % nN); return true; }
};

template <class GemmT, class Epi, class Sched>
__device__ __forceinline__ void gemm_phase(PG8_LAS unsigned char* lds, const GemmT g, const Sched& S, const Epi& E) {
    int tid_ = threadIdx.x; asm volatile("" : "+v"(tid_));
    const int tid = tid_, wid = __builtin_amdgcn_readfirstlane(tid >> 6), lane = tid & 63, wr = wid >> 2, wc = wid & 3, fr = lane & 15, fq = lane >> 4;
    constexpr int K = GemmT::K, EB = GemmT::EB, nt = K * EB / 128;
    typedef int v8i __attribute__((ext_vector_type(8))); typedef int v4i __attribute__((ext_vector_type(4)));
    unsigned voffA[2], voffB[2];
#pragma unroll
    for (int i = 0; i < 2; ++i) { int R, C; stage_rc(tid * 16 + i * 8192, R, C); const int Rb = Epi::PERM ? ((R & ~31) + perm32(R & 31)) : R;
        voffA[i] = (unsigned)(R * GemmT::lda * EB + C * 2); voffB[i] = (unsigned)(Rb * GemmT::ldb * EB + C * 2); }
    constexpr size_t kstep = (size_t)(BK * 2);
    constexpr size_t hstepA = (size_t)HALF * GemmT::lda * EB, hstepB = (size_t)HALF * GemmT::ldb * EB;
    constexpr size_t tstepA = 2 * hstepA, tstepB = 2 * hstepB;
    constexpr size_t akb = (size_t)GemmT::akstep * EB;
    const unsigned ldsw = (unsigned)wid * 1024u;
    const int aoff0 = lds_byte(wr * 64 + fr, EB == 2 ? fq * 8 : fq * 16) + (EB == 2 ? 0 : 16 * (fq & 1)), boff0 = lds_byte(wc * 32 + fr, EB == 2 ? fq * 8 : fq * 16) + (EB == 2 ? 0 : 16 * (fq & 1));
    const int aoff1 = EB == 2 ? aoff0 + 1024 : (aoff0 ^ 16), boff1 = EB == 2 ? boff0 + 1024 : (boff0 ^ 16);
#define PG8_SA(b, h) (((b) * 2 + (h)) * HTB)
#define PG8_SB(b, h) ((4 + (b) * 2 + (h)) * HTB)
#define PG8_STAGE(bufoff, gbase, voff) do { _Pragma("unroll") for (int _i = 0; _i < 2; ++_i) \
        __builtin_amdgcn_global_load_lds((const unsigned*)((const char*)(gbase) + (voff)[_i]), (PG8_LAS unsigned*)(lds + (bufoff) + ldsw + _i * 8192), 16, 0, 0); } while (0)
#define PG8_LDA(dst, b, h) do { _Pragma("unroll") for (int m = 0; m < 4; ++m) { const v4i l_ = *(const PG8_LAS v4i*)(lds + PG8_SA(b, h) + aoff0 + m * 2048), h_ = *(const PG8_LAS v4i*)(lds + PG8_SA(b, h) + aoff1 + m * 2048); dst[m] = __builtin_shufflevector(l_, h_, 0, 1, 2, 3, 4, 5, 6, 7); } } while (0)
#define PG8_LDB(dst, b, h) do { _Pragma("unroll") for (int n = 0; n < 2; ++n) { const v4i l_ = *(const PG8_LAS v4i*)(lds + PG8_SB(b, h) + boff0 + n * 2048), h_ = *(const PG8_LAS v4i*)(lds + PG8_SB(b, h) + boff1 + n * 2048); dst[n] = __builtin_shufflevector(l_, h_, 0, 1, 2, 3, 4, 5, 6, 7); } } while (0)
#define PG8_LO(v) __builtin_bit_cast(bf16x8, __builtin_shufflevector(v, v, 0, 1, 2, 3))
#define PG8_HI(v) __builtin_bit_cast(bf16x8, __builtin_shufflevector(v, v, 4, 5, 6, 7))
#define PG8_MMA(ai, bj, At, Bt) do { __builtin_amdgcn_s_setprio(1); _Pragma("unroll") for (int m = 0; m < 4; ++m) _Pragma("unroll") for (int n = 0; n < 2; ++n) { \
        if constexpr (EB == 2) { acc[ai][bj][m][n] = __builtin_amdgcn_mfma_f32_16x16x32_bf16(PG8_LO(Bt[n]), PG8_LO(At[m]), acc[ai][bj][m][n], 0, 0, 0); \
                                 acc[ai][bj][m][n] = __builtin_amdgcn_mfma_f32_16x16x32_bf16(PG8_HI(Bt[n]), PG8_HI(At[m]), acc[ai][bj][m][n], 0, 0, 0); } \
        else asm volatile("v_mfma_f32_16x16x128_f8f6f4 %0, %1, %2, %0" : "+v"(acc[ai][bj][m][n]) : "v"(Bt[n]), "v"(At[m])); } __builtin_amdgcn_s_setprio(0); } while (0)
#define PG8_WAIT_V(n) asm volatile("s_waitcnt vmcnt(" #n ")" ::: "memory")
#define PG8_WAIT_L(n) asm volatile("s_waitcnt lgkmcnt(" #n ")" ::: "memory")
#define PG8_BAR __builtin_amdgcn_s_barrier()
#define PG8_SCHED __builtin_amdgcn_sched_barrier(0)
    Unit cur, nxt; int ui = 0;
    if (!S.next(0, cur)) return;
    f32x4 acc[2][2][4][2];
#pragma unroll
    for (int a = 0; a < 2; ++a)
#pragma unroll
        for (int b = 0; b < 2; ++b)
#pragma unroll
            for (int m = 0; m < 4; ++m)
#pragma unroll
                for (int n = 0; n < 2; ++n) acc[a][b][m][n] = (f32x4){0.f, 0.f, 0.f, 0.f};
    v8i At[4], B0[2], B1[2];
    const char* cA = (const char*)g.A + (size_t)cur.pm * tstepA + (size_t)(cur.pn >> GemmT::akshift) * akb; const char* cB = (const char*)g.Bt + (size_t)cur.pn * tstepB;
    PG8_STAGE(PG8_SB(0, 0), cB, voffB); PG8_STAGE(PG8_SB(0, 1), cB + hstepB, voffB); PG8_STAGE(PG8_SA(0, 0), cA, voffA); PG8_STAGE(PG8_SA(0, 1), cA + hstepA, voffA);
    if (wr == 1) PG8_BAR;
    PG8_WAIT_V(2); PG8_BAR;
    PG8_STAGE(PG8_SB(1, 0), cB + kstep, voffB); PG8_STAGE(PG8_SA(1, 0), cA + kstep, voffA); PG8_STAGE(PG8_SB(1, 1), cB + hstepB + kstep, voffB);
    PG8_WAIT_V(6); PG8_BAR;
    for (;;) {
        const bool has_next = S.next(ui + 1, nxt);
        const char* nA = has_next ? (const char*)g.A + (size_t)nxt.pm * tstepA + (size_t)(nxt.pn >> GemmT::akshift) * akb : cA; const char* nB = has_next ? (const char*)g.Bt + (size_t)nxt.pn * tstepB : cB;
#pragma unroll 1
        for (int t = 0; t < nt; t += 2) {
            const bool last = (t == nt - 2);
            const char* a1 = cA + (size_t)(t + 1) * kstep;
            const char* a2 = last ? nA : cA + (size_t)(t + 2) * kstep; const char* b2 = last ? nB : cB + (size_t)(t + 2) * kstep;
            const char* a3 = a2 + kstep; const char* b3 = b2 + kstep;
            PG8_LDB(B0, 0, 0); PG8_LDB(B1, 0, 1); PG8_SCHED; PG8_LDA(At, 0, 0); PG8_STAGE(PG8_SA(1, 1), a1 + hstepA, voffA);
            PG8_WAIT_V(8); PG8_WAIT_L(0); PG8_BAR; PG8_MMA(0, 0, At, B0); PG8_MMA(0, 1, At, B1); PG8_BAR; PG8_SCHED;
            PG8_LDA(At, 0, 1); PG8_STAGE(PG8_SB(0, 0), b2, voffB); PG8_STAGE(PG8_SB(0, 1), b2 + hstepB, voffB); PG8_STAGE(PG8_SA(0, 0), a2, voffA);
            PG8_WAIT_V(8); PG8_WAIT_L(0); PG8_BAR; PG8_MMA(1, 0, At, B0); PG8_MMA(1, 1, At, B1); PG8_BAR; PG8_SCHED;
            PG8_LDB(B0, 1, 0); PG8_LDB(B1, 1, 1); PG8_SCHED; PG8_LDA(At, 1, 0); PG8_STAGE(PG8_SA(0, 1), a2 + hstepA, voffA);
            PG8_WAIT_V(8); PG8_WAIT_L(0); PG8_BAR; PG8_MMA(0, 0, At, B0); PG8_MMA(0, 1, At, B1); PG8_BAR; PG8_SCHED;
            PG8_LDA(At, 1, 1); PG8_STAGE(PG8_SB(1, 0), b3, voffB); PG8_STAGE(PG8_SB(1, 1), b3 + hstepB, voffB); PG8_STAGE(PG8_SA(1, 0), a3, voffA);
            PG8_WAIT_V(8); PG8_WAIT_L(0); PG8_BAR; PG8_MMA(1, 0, At, B0); PG8_MMA(1, 1, At, B1); PG8_BAR; PG8_SCHED;
        }
        if (wr == 0) PG8_BAR;
        if constexpr (EB == 1) asm volatile("s_nop 15\n\ts_nop 15" ::: "memory");
        E(acc, cur, wr, wc, fr, fq);
        if (!has_next) break;
#pragma unroll
        for (int a = 0; a < 2; ++a)
#pragma unroll
            for (int b = 0; b < 2; ++b)
#pragma unroll
                for (int m = 0; m < 4; ++m)
#pragma unroll
                    for (int n = 0; n < 2; ++n) acc[a][b][m][n] = (f32x4){0.f, 0.f, 0.f, 0.f};
        cur = nxt; cA = nA; cB = nB; ++ui;
        if (wr == 1) PG8_BAR;
    }
    PG8_WAIT_V(0);
    PG8_BAR;
}
template <class GP, class GM, class Mid, class Epi, class Sched>
__device__ __forceinline__ void gemm_chain(PG8_LAS unsigned char* lds, const GP gp, const GM gm, const Sched& S, const Mid& M, const Epi& E) {
    static_assert(GP::EB == 2 && GM::EB == 1 && GP::lda * 2 == GM::lda, "chain: bf16 prefix, fp8 main, equal A row strides in bytes");
    int tid_ = threadIdx.x; asm volatile("" : "+v"(tid_));
    const int tid = tid_, wid = __builtin_amdgcn_readfirstlane(tid >> 6), lane = tid & 63, wr = wid >> 2, wc = wid & 3, fr = lane & 15, fq = lane >> 4;
    constexpr int ntp = GP::K * 2 / 128, ntm = GM::K / 128;
    static_assert(ntp == 4 && ntm % 2 == 0, "chain: prefix of two trips");
    typedef int v8i __attribute__((ext_vector_type(8))); typedef int v4i __attribute__((ext_vector_type(4)));
    unsigned voffA[2], voffBp[2], voffBm[2];
#pragma unroll
    for (int i = 0; i < 2; ++i) { int R, C; stage_rc(tid * 16 + i * 8192, R, C); const int Rb = (R & ~31) + perm32(R & 31);
        voffA[i] = (unsigned)(R * GM::lda + C * 2); voffBp[i] = (unsigned)(Rb * GP::ldb * 2 + C * 2); voffBm[i] = (unsigned)(Rb * GM::ldb + C * 2); }
    constexpr size_t kstep = (size_t)(BK * 2);
    constexpr size_t hstepA = (size_t)HALF * GM::lda, hstepBp = (size_t)HALF * GP::ldb * 2, hstepBm = (size_t)HALF * GM::ldb;
    constexpr size_t tstepA = 2 * hstepA, tstepBp = 2 * hstepBp, tstepBm = 2 * hstepBm;
    constexpr size_t akbp = (size_t)GP::akstep * 2;
    const unsigned ldsw = (unsigned)wid * 1024u;
#define PC_OFFS_P() int lq_ = tid; asm volatile("" : "+v"(lq_)); const int frq_ = lq_ & 15, fqq_ = (lq_ >> 4) & 3; \
    const int aoffP0 = lds_byte(wr * 64 + frq_, fqq_ * 8), boffP0 = lds_byte(wc * 32 + frq_, fqq_ * 8), aoffP1 = aoffP0 + 1024, boffP1 = boffP0 + 1024
#define PC_OFFS_M() int lm_ = tid; asm volatile("" : "+v"(lm_)); const int frm_ = lm_ & 15, fqm_ = (lm_ >> 4) & 3; \
    const int aoffM0 = lds_byte(wr * 64 + frm_, fqm_ * 16) + 16 * (fqm_ & 1), boffM0 = lds_byte(wc * 32 + frm_, fqm_ * 16) + 16 * (fqm_ & 1), aoffM1 = aoffM0 ^ 16, boffM1 = boffM0 ^ 16
#define PC_LDA(dst, b, h, o0, o1) do { _Pragma("unroll") for (int m = 0; m < 4; ++m) { const v4i l_ = *(const PG8_LAS v4i*)(lds + PG8_SA(b, h) + (o0) + m * 2048), h_ = *(const PG8_LAS v4i*)(lds + PG8_SA(b, h) + (o1) + m * 2048); dst[m] = __builtin_shufflevector(l_, h_, 0, 1, 2, 3, 4, 5, 6, 7); } } while (0)
#define PC_LDB(dst, b, h, o0, o1) do { _Pragma("unroll") for (int n = 0; n < 2; ++n) { const v4i l_ = *(const PG8_LAS v4i*)(lds + PG8_SB(b, h) + (o0) + n * 2048), h_ = *(const PG8_LAS v4i*)(lds + PG8_SB(b, h) + (o1) + n * 2048); dst[n] = __builtin_shufflevector(l_, h_, 0, 1, 2, 3, 4, 5, 6, 7); } } while (0)
#define PC_MMA(EBv, ai, bj, At, Bt) do { __builtin_amdgcn_s_setprio(1); _Pragma("unroll") for (int m = 0; m < 4; ++m) _Pragma("unroll") for (int n = 0; n < 2; ++n) { \
        if constexpr (EBv == 2) { acc[ai][bj][m][n] = __builtin_amdgcn_mfma_f32_16x16x32_bf16(PG8_LO(Bt[n]), PG8_LO(At[m]), acc[ai][bj][m][n], 0, 0, 0); \
                                  acc[ai][bj][m][n] = __builtin_amdgcn_mfma_f32_16x16x32_bf16(PG8_HI(Bt[n]), PG8_HI(At[m]), acc[ai][bj][m][n], 0, 0, 0); } \
        else asm volatile("v_mfma_f32_16x16x128_f8f6f4 %0, %1, %2, %0" : "+v"(acc[ai][bj][m][n]) : "v"(Bt[n]), "v"(At[m])); } __builtin_amdgcn_s_setprio(0); } while (0)
#define PC_TRIP(EBv, A0, A1, B0o, B1o, a1_, a2_, b2_, voffBn, hstepBn) do { const char* a3_ = (a2_) + kstep; const char* b3_ = (b2_) + kstep; \
        PC_LDB(B0, 0, 0, B0o, B1o); PC_LDB(B1, 0, 1, B0o, B1o); PG8_SCHED; PC_LDA(At, 0, 0, A0, A1); PG8_STAGE(PG8_SA(1, 1), (a1_) + hstepA, voffA); \
        PG8_WAIT_V(8); PG8_WAIT_L(0); PG8_BAR; PC_MMA(EBv, 0, 0, At, B0); PC_MMA(EBv, 0, 1, At, B1); PG8_BAR; PG8_SCHED; \
        PC_LDA(At, 0, 1, A0, A1); PG8_STAGE(PG8_SB(0, 0), (b2_), voffBn); PG8_STAGE(PG8_SB(0, 1), (b2_) + (hstepBn), voffBn); PG8_STAGE(PG8_SA(0, 0), (a2_), voffA); \
        PG8_WAIT_V(8); PG8_WAIT_L(0); PG8_BAR; PC_MMA(EBv, 1, 0, At, B0); PC_MMA(EBv, 1, 1, At, B1); PG8_BAR; PG8_SCHED; \
        PC_LDB(B0, 1, 0, B0o, B1o); PC_LDB(B1, 1, 1, B0o, B1o); PG8_SCHED; PC_LDA(At, 1, 0, A0, A1); PG8_STAGE(PG8_SA(0, 1), (a2_) + hstepA, voffA); \
        PG8_WAIT_V(8); PG8_WAIT_L(0); PG8_BAR; PC_MMA(EBv, 0, 0, At, B0); PC_MMA(EBv, 0, 1, At, B1); PG8_BAR; PG8_SCHED; \
        PC_LDA(At, 1, 1, A0, A1); PG8_STAGE(PG8_SB(1, 0), b3_, voffBn); PG8_STAGE(PG8_SB(1, 1), b3_ + (hstepBn), voffBn); PG8_STAGE(PG8_SA(1, 0), a3_, voffA); \
        PG8_WAIT_V(8); PG8_WAIT_L(0); PG8_BAR; PC_MMA(EBv, 1, 0, At, B0); PC_MMA(EBv, 1, 1, At, B1); PG8_BAR; PG8_SCHED; } while (0)
    Unit cur, nxt; int ui = 0;
    if (!S.next(0, cur)) return;
    f32x4 acc[2][2][4][2];
#pragma unroll
    for (int a = 0; a < 2; ++a)
#pragma unroll
        for (int b = 0; b < 2; ++b)
#pragma unroll
            for (int m = 0; m < 4; ++m)
#pragma unroll
                for (int n = 0; n < 2; ++n) acc[a][b][m][n] = (f32x4){0.f, 0.f, 0.f, 0.f};
    v8i At[4], B0[2], B1[2];
    const char* cAp = (const char*)gp.A + (size_t)cur.pm * tstepA + (size_t)(cur.pn >> GP::akshift) * akbp; const char* cBp = (const char*)gp.Bt + (size_t)cur.pn * tstepBp;
    PG8_STAGE(PG8_SB(0, 0), cBp, voffBp); PG8_STAGE(PG8_SB(0, 1), cBp + hstepBp, voffBp); PG8_STAGE(PG8_SA(0, 0), cAp, voffA); PG8_STAGE(PG8_SA(0, 1), cAp + hstepA, voffA);
    if (wr == 1) PG8_BAR;
    PG8_WAIT_V(2); PG8_BAR;
    PG8_STAGE(PG8_SB(1, 0), cBp + kstep, voffBp); PG8_STAGE(PG8_SA(1, 0), cAp + kstep, voffA); PG8_STAGE(PG8_SB(1, 1), cBp + hstepBp + kstep, voffBp);
    PG8_WAIT_V(6); PG8_BAR;
    for (;;) {
        const bool has_next = S.next(ui + 1, nxt);
        const char* nAp = has_next ? (const char*)gp.A + (size_t)nxt.pm * tstepA + (size_t)(nxt.pn >> GP::akshift) * akbp : cAp; const char* nBp = has_next ? (const char*)gp.Bt + (size_t)nxt.pn * tstepBp : cBp;
        const char* cAm = (const char*)gm.A + (size_t)cur.pm * tstepA; const char* cBm = (const char*)gm.Bt + (size_t)cur.pn * tstepBm;
        {   PC_OFFS_P();
#pragma unroll 1
            for (int t = 0; t < ntp; t += 2) {
                const bool last = (t == ntp - 2);
                unsigned voffBn[2]; voffBn[0] = last ? voffBm[0] : voffBp[0]; voffBn[1] = last ? voffBm[1] : voffBp[1];
                const size_t hstepBn = last ? hstepBm : hstepBp;
                const char* a2 = last ? cAm : cAp + (size_t)(t + 2) * kstep; const char* b2 = last ? cBm : cBp + (size_t)(t + 2) * kstep;
                PC_TRIP(2, aoffP0, aoffP1, boffP0, boffP1, cAp + (size_t)(t + 1) * kstep, a2, b2, voffBn, hstepBn);
            } }
        M(acc, cur, wr, wc, fr, fq);
        PC_OFFS_M();
#pragma unroll 1
        for (int t = 0; t < ntm; t += 2) {
            const bool last = (t == ntm - 2);
            unsigned voffBn[2]; voffBn[0] = last ? voffBp[0] : voffBm[0]; voffBn[1] = last ? voffBp[1] : voffBm[1];
            const size_t hstepBn = last ? hstepBp : hstepBm;
            const char* a2 = last ? nAp : cAm + (size_t)(t + 2) * kstep; const char* b2 = last ? nBp : cBm + (size_t)(t + 2) * kstep;
            PC_TRIP(1, aoffM0, aoffM1, boffM0, boffM1, cAm + (size_t)(t + 1) * kstep, a2, b2, voffBn, hstepBn);
        }
        if (wr == 0) PG8_BAR;
        asm volatile("s_nop 15\n\ts_nop 15" ::: "memory");
        {   Unit cue = cur; asm volatile("" : "+s"(cue.pm), "+s"(cue.pn));
            E(acc, cue, wr, wc, fr, fq); }
        if (!has_next) break;
#pragma unroll
        for (int a = 0; a < 2; ++a)
#pragma unroll
            for (int b = 0; b < 2; ++b)
#pragma unroll
                for (int m = 0; m < 4; ++m)
#pragma unroll
                    for (int n = 0; n < 2; ++n) acc[a][b][m][n] = (f32x4){0.f, 0.f, 0.f, 0.f};
        cur = nxt; cAp = nAp; cBp = nBp; ++ui;
        if (wr == 1) PG8_BAR;
    }
    PG8_WAIT_V(0);
    PG8_BAR;
#undef PC_LDA
#undef PC_LDB
#undef PC_MMA
#undef PC_TRIP
#undef PC_OFFS_P
#undef PC_OFFS_M
}
template <class GemmT, class Epi>
__device__ __forceinline__ void gemm_quarter(PG8_LAS unsigned char* lds, const GemmT g, int qm, int qn, const Epi& E) {
    int tid_ = threadIdx.x; asm volatile("" : "+v"(tid_));
    const int tid = tid_, wid = __builtin_amdgcn_readfirstlane(tid >> 6), lane = tid & 63, wr = wid >> 2, wc = wid & 3, fr = lane & 15, fq = lane >> 4;
    constexpr int K = GemmT::K, EB = GemmT::EB, nt = K * EB / 128;
    static_assert(nt % 4 == 0 && nt >= 4, "quarter unit: K-tiles in groups of four");
    typedef int v8i __attribute__((ext_vector_type(8))); typedef int v4i __attribute__((ext_vector_type(4)));
    unsigned voffA[2], voffB[2];
#pragma unroll
    for (int i = 0; i < 2; ++i) { int R, C; stage_rc(tid * 16 + i * 8192, R, C); const int Rb = Epi::PERM ? ((R & ~31) + perm32(R & 31)) : R;
        voffA[i] = (unsigned)(R * GemmT::lda * EB + C * 2); voffB[i] = (unsigned)(Rb * GemmT::ldb * EB + C * 2); }
    constexpr size_t kstep = (size_t)(BK * 2);
    constexpr size_t hstepA = (size_t)HALF * GemmT::lda * EB, hstepB = (size_t)HALF * GemmT::ldb * EB;
    const unsigned ldsw = (unsigned)wid * 1024u;
    const int aoff0 = lds_byte(wr * 64 + fr, EB == 2 ? fq * 8 : fq * 16) + (EB == 2 ? 0 : 16 * (fq & 1)), boff0 = lds_byte(wc * 32 + fr, EB == 2 ? fq * 8 : fq * 16) + (EB == 2 ? 0 : 16 * (fq & 1));
    const int aoff1 = EB == 2 ? aoff0 + 1024 : (aoff0 ^ 16), boff1 = EB == 2 ? boff0 + 1024 : (boff0 ^ 16);
    const char* cA = (const char*)g.A + (size_t)qm * hstepA + (size_t)((qn >> 1) >> GemmT::akshift) * GemmT::akstep * EB; const char* cB = (const char*)g.Bt + (size_t)qn * hstepB;
    f32x4 acc[1][1][4][2];
#pragma unroll
    for (int m = 0; m < 4; ++m)
#pragma unroll
        for (int n = 0; n < 2; ++n) acc[0][0][m][n] = (f32x4){0.f, 0.f, 0.f, 0.f};
    v8i At[4], B0[2];
#define PG8Q_LDA(dst, s) do { _Pragma("unroll") for (int m = 0; m < 4; ++m) { const v4i l_ = *(const PG8_LAS v4i*)(lds + (s) * HTB + aoff0 + m * 2048), h_ = *(const PG8_LAS v4i*)(lds + (s) * HTB + aoff1 + m * 2048); dst[m] = __builtin_shufflevector(l_, h_, 0, 1, 2, 3, 4, 5, 6, 7); } } while (0)
#define PG8Q_LDB(dst, s) do { _Pragma("unroll") for (int n = 0; n < 2; ++n) { const v4i l_ = *(const PG8_LAS v4i*)(lds + (4 + (s)) * HTB + boff0 + n * 2048), h_ = *(const PG8_LAS v4i*)(lds + (4 + (s)) * HTB + boff1 + n * 2048); dst[n] = __builtin_shufflevector(l_, h_, 0, 1, 2, 3, 4, 5, 6, 7); } } while (0)
#pragma unroll
    for (int s = 0; s < 3; ++s) { PG8_STAGE(s * HTB, cA + (size_t)s * kstep, voffA); PG8_STAGE((4 + s) * HTB, cB + (size_t)s * kstep, voffB); }
#pragma unroll 1
    for (int t = 0; t < nt; t += 4) {
#pragma unroll
        for (int s = 0; s < 4; ++s) {
            PG8_WAIT_V(8); PG8_BAR;
            const int nx = (t + s + 3 < nt) ? (t + s + 3) : (nt - 1);
            PG8_STAGE(((s + 3) & 3) * HTB, cA + (size_t)nx * kstep, voffA); PG8_STAGE((4 + ((s + 3) & 3)) * HTB, cB + (size_t)nx * kstep, voffB);
            PG8Q_LDB(B0, s); PG8Q_LDA(At, s);
            PG8_WAIT_L(0); PG8_SCHED; PG8_MMA(0, 0, At, B0); PG8_SCHED;
        }
    }
    if constexpr (EB == 1) asm volatile("s_nop 15\n\ts_nop 15" ::: "memory");
    E.quarter(acc, qm * HALF, qn * HALF, wr, wc, fr, fq);
    PG8_WAIT_V(0);
    PG8_BAR;
#undef PG8Q_LDA
#undef PG8Q_LDB
#undef PG8_SA
#undef PG8_SB
#undef PG8_STAGE
#undef PG8_LDA
#undef PG8_LDB
#undef PG8_MMA
#undef PG8_LO
#undef PG8_HI
#undef PG8_WAIT_V
#undef PG8_WAIT_L
#undef PG8_BAR
#undef PG8_SCHED
}
}

constexpr int DM = 2048, NB = 8, SEQ = 2048, CTXL = 256, NLAYER = 2;
constexpr int TL = NB * SEQ, TC = NB * CTXL, TT = TL + TC;
constexpr int INW = 8192, KVOFF = 2048, VOFF = 2560, POOLOFF = 3072, GAOFF = 4096, GBOFF = 6144;
constexpr int NEXP = 16384, NSEL = 128;
constexpr float EPS = 1e-6f;
constexpr int NWAVES = 8;

constexpr size_t MiB = 1u << 20;
constexpr size_t WS_CTL = 0, CTL_ZERO_BYTES = 1 * MiB;
constexpr size_t WS_MOD = 1 * MiB;
constexpr size_t WS_MODP = 2 * MiB;
constexpr size_t WS_ROPE = 9 * MiB;
constexpr size_t WS_WIN = 10 * MiB;
constexpr size_t WS_WOUT = 90 * MiB;
constexpr size_t WS_WQP = 106 * MiB;
constexpr size_t WS_WPOOL = 122 * MiB;
constexpr size_t WS_KEYS = 124 * MiB;
constexpr size_t WS_PU = 126 * MiB;
constexpr size_t WS_PV = 190 * MiB;
constexpr size_t WS_SCU = 254 * MiB;
constexpr size_t WS_SCV = 255 * MiB;
constexpr size_t WS_X = 382 * MiB;
constexpr size_t WS_H = 526 * MiB;
constexpr size_t WS_P = 598 * MiB;
constexpr size_t WS_AO = 886 * MiB;
constexpr size_t WS_H8 = 922 * MiB;
constexpr size_t WS_WIN8 = WS_PU + 16 * MiB;
constexpr size_t WS_WBR8 = WS_PV + 16 * MiB;
constexpr size_t WS_POOLED = 958 * MiB;
constexpr size_t WS_YB = 994 * MiB;
constexpr size_t WS_END = 1066 * MiB;
constexpr size_t P_QP = 0, P_IDX = 216 * MiB, P_GW = 225 * MiB;

constexpr int CW_TMO = 0;
constexpr int CW_BAR = 4096;

constexpr int RING_BYTES = 131072;
constexpr int LDSCTL_OFF = RING_BYTES, MISC_OFF = LDSCTL_OFF + 320;
constexpr int LDS_BYTES = 147456;

#define GAS __attribute__((address_space(1)))
#define LAS __attribute__((address_space(3)))
typedef unsigned short bf16;
typedef unsigned v4u __attribute__((ext_vector_type(4)));
typedef unsigned v2u __attribute__((ext_vector_type(2)));
typedef float f32x4 __attribute__((ext_vector_type(4)));
typedef short bf16x8 __attribute__((ext_vector_type(8)));
typedef GAS unsigned gu32;
#define RLX_AGENT __ATOMIC_RELAXED, __HIP_MEMORY_SCOPE_AGENT
#define LDS_WAIT() asm volatile("s_waitcnt lgkmcnt(0)" ::: "memory")
#define VM_WAIT() asm volatile("s_waitcnt vmcnt(0)" ::: "memory")
__device__ __forceinline__ unsigned f2bf(float f) { unsigned u = __builtin_bit_cast(unsigned, f); return (u + 0x7fffu + ((u >> 16) & 1u)) >> 16; }
__device__ __forceinline__ unsigned pk2(float lo, float hi) { unsigned r; asm("v_cvt_pk_bf16_f32 %0, %1, %2" : "=v"(r) : "v"(lo), "v"(hi)); return r; }
__device__ __forceinline__ float bflo(unsigned w) { return __builtin_bit_cast(float, w << 16); }
__device__ __forceinline__ float bfhi(unsigned w) { return __builtin_bit_cast(float, w & 0xffff0000u); }
__device__ __forceinline__ float sigmoidf_(float x) { return __builtin_amdgcn_rcpf(1.0f + __expf(-x)); }
__device__ __forceinline__ float wave_sum(float v) {
#pragma unroll
    for (int o = 1; o < 64; o <<= 1) v += __shfl_xor(v, o);
    return v;
}
__device__ __forceinline__ float wave_max(float v) {
#pragma unroll
    for (int o = 1; o < 64; o <<= 1) v = fmaxf(v, __shfl_xor(v, o));
    return v;
}

#define XB_TMO      128
#define XB_XCNT(j)  (256  + 64 * (j))
#define XB_XSUB(j)  (1280 + 64 * (j))
#define XB_XGEN(j)  (2304 + 64 * (j))
#define XB_TOP      3328
#define XB_TOPGEN   3392
#define XCD_BAR_WORDS 3456
#define XB_SPIN_CAP (1u << 18)
__device__ __forceinline__ unsigned xb_ld(unsigned* p)              { return __hip_atomic_load(p, __ATOMIC_RELAXED, __HIP_MEMORY_SCOPE_AGENT); }
__device__ __forceinline__ unsigned xb_add(unsigned* p, unsigned v) { return __hip_atomic_fetch_add(p, v, __ATOMIC_RELAXED, __HIP_MEMORY_SCOPE_AGENT); }
__device__ __forceinline__ unsigned xb_xcc_id() { return (unsigned)__builtin_amdgcn_s_getreg((3 << 11) | 20) & 0xFu; }
#define XB_SPIN(cond, bar) do { unsigned _sp = 0; while (cond) { __builtin_amdgcn_s_sleep(1); \
    if ((++_sp & 255u) == 0u) { if (xb_ld(&(bar)[XB_TMO])) break; if (_sp > XB_SPIN_CAP) { atomicAdd(&(bar)[XB_TMO], 1u); break; } } } } while (0)
struct XcdBarrier { unsigned* bar; unsigned x; volatile LAS unsigned* st; };
__device__ __forceinline__ XcdBarrier xcd_barrier_post(unsigned* bar, volatile LAS unsigned* st) {
    XcdBarrier b; b.bar = bar; b.x = xb_xcc_id(); b.st = st;
    if (threadIdx.x == 0) (void)xb_add(&bar[XB_XCNT(b.x)], 1u);
    return b;
}
__device__ __forceinline__ void xcd_barrier_complete(unsigned* bar, unsigned x, unsigned& nloc, unsigned& nx) {
    const unsigned G = gridDim.x * gridDim.y * gridDim.z;
    unsigned sum, cnt, mine, sp = 0u;
    for (;;) {
        sum = 0u; cnt = 0u; mine = 0u;
#pragma unroll 1
        for (unsigned j = 0; j < 16; ++j) { const unsigned c = xb_ld(&bar[XB_XCNT(j)]); sum += c; cnt += (c > 0u) ? 1u : 0u; mine = (j == x) ? c : mine; }
        if (sum == G) break;
        __builtin_amdgcn_s_sleep(1);
        if ((++sp & 255u) == 0u) { if (xb_ld(&bar[XB_TMO])) break; if (sp > XB_SPIN_CAP) { atomicAdd(&bar[XB_TMO], 1u); break; } }
    }
    nloc = mine > 0u ? mine : 1u; nx = cnt > 0u ? cnt : 1u;
}
__device__ __forceinline__ void xcd_barrier(const XcdBarrier& b) {
    asm volatile("s_waitcnt vmcnt(0)" ::: "memory");
    __syncthreads();
    if (threadIdx.x == 0) {
        unsigned* bar = b.bar;
        asm volatile("" : "+s"(bar));
        __builtin_amdgcn_s_waitcnt(0);
        unsigned nloc = b.st[0], nx = b.st[1];
        if (nloc == 0u) { xcd_barrier_complete(bar, b.x, nloc, nx); b.st[0] = nloc; b.st[1] = nx; }
        const unsigned old = xb_add(&bar[XB_XSUB(b.x)], 1u);
        const unsigned gen = old / nloc;
        if (old + 1u == (gen + 1u) * nloc) {
            __builtin_amdgcn_fence(__ATOMIC_RELEASE, "agent");
            asm volatile("s_waitcnt vmcnt(0)" ::: "memory");
            const unsigned og = xb_add(&bar[XB_TOP], 1u);
            const unsigned tg = og / nx;
            if (og + 1u == (tg + 1u) * nx) xb_add(&bar[XB_TOPGEN], 1u);
            else XB_SPIN(xb_ld(&bar[XB_TOPGEN]) == tg, bar);
            __builtin_amdgcn_fence(__ATOMIC_ACQUIRE, "agent");
            xb_add(&bar[XB_XGEN(b.x)], 1u);
            asm volatile("s_waitcnt vmcnt(0)" ::: "memory");
        } else {
            XB_SPIN(xb_ld(&bar[XB_XGEN(b.x)]) == gen, bar);
            __builtin_amdgcn_fence(__ATOMIC_ACQUIRE, "agent");
            asm volatile("s_waitcnt vmcnt(0)" ::: "memory");
        }
    }
    __syncthreads();
}

struct Frame {
    LAS unsigned char* lds;
    int tid, lane, wave, vcu, G, bx;
    unsigned char* ws;
};
__device__ __forceinline__ Frame mkframe(unsigned char* lds_generic, unsigned char* ws) {
    Frame F; int t = threadIdx.x; asm volatile("" : "+v"(t)); asm volatile("" : "+s"(ws));
    F.lds = (LAS unsigned char*)lds_generic; F.tid = t; F.lane = t & 63; F.wave = __builtin_amdgcn_readfirstlane(t >> 6);
    { int bx = blockIdx.x, G = gridDim.x; asm volatile("" : "+s"(bx), "+s"(G));
      F.bx = bx; F.G = G; F.vcu = (G % 8 == 0) ? (bx % 8) * (G / 8) + bx / 8 : bx; }
    F.ws = ws; return F;
}
enum { I_X = 0, I_C, I_CTX, I_CCTX, I_WADA, I_BADA, I_WIN, I_QG, I_KG, I_WBR, I_WPOOL, I_PSCALE, I_WOUT, I_WQP, I_KEYS, I_PU, I_PV, I_FG, I_OUT };
template <int I> __device__ __forceinline__ const float* inp() {
    const float* p;
    asm volatile("s_load_dwordx2 %0, %1, %2\n\ts_waitcnt lgkmcnt(0)" : "=s"(p) : "s"(__builtin_amdgcn_kernarg_segment_ptr()), "i"(8 * I) : "memory");
    return p;
}
__device__ __forceinline__ const float* mod_ptr(const Frame& F, int layer, int row) {
    const int mr = row < TL ? (row >> 11) : 8;
    return (const float*)(F.ws + WS_MOD) + ((size_t)layer * 9 + mr) * (6 * DM);
}

__device__ __forceinline__ float clamp_fp8(float v) { return __builtin_amdgcn_fmed3f(v, -448.0f, 448.0f); }
__device__ __forceinline__ unsigned pk4_fp8(float a, float b, float c, float d) { int p = __builtin_amdgcn_cvt_pk_fp8_f32(clamp_fp8(a), clamp_fp8(b), 0, false); p = __builtin_amdgcn_cvt_pk_fp8_f32(clamp_fp8(c), clamp_fp8(d), p, true); return (unsigned)p; }
constexpr float W8_SCALE = 64.0f;
__device__ __forceinline__ void p0_transpose_item(const float* W, int K, int N, bf16* WT, unsigned char* WT8, int row_off, LAS float* scr, int item, int lane) {
    const int nblk = N / 64, kb = item / nblk, nb = item % nblk, k0 = 64 * kb, n0 = 64 * nb;
    const int n4 = (lane & 15) * 4, kr = lane >> 4;
#pragma unroll
    for (int i = 0; i < 16; ++i) { const int kk = kr + 4 * i;
        const f32x4 v = *(const GAS f32x4*)(W + (size_t)(k0 + kk) * N + n0 + n4);
        *(LAS f32x4*)(scr + kk * 64 + (n4 ^ ((kk >> 3) << 3))) = v; }
    LDS_WAIT(); asm volatile("" ::: "memory");
    const int c = lane & 7, nn = lane >> 3;
#pragma unroll
    for (int j = 0; j < 8; ++j) { const int n = nn + 8 * j; const LAS float* sp = scr + (8 * c) * 64 + (n ^ (c << 3));
        const float x0 = sp[0 * 64], x1 = sp[1 * 64], x2 = sp[2 * 64], x3 = sp[3 * 64], x4 = sp[4 * 64], x5 = sp[5 * 64], x6 = sp[6 * 64], x7 = sp[7 * 64];
        if (WT) { v4u o; o.x = pk2(x0, x1); o.y = pk2(x2, x3); o.z = pk2(x4, x5); o.w = pk2(x6, x7); *(GAS v4u*)(WT + (size_t)(row_off + n0 + n) * K + k0 + 8 * c) = o; }
        if (WT8) { v2u o; o.x = pk4_fp8(x0 * W8_SCALE, x1 * W8_SCALE, x2 * W8_SCALE, x3 * W8_SCALE); o.y = pk4_fp8(x4 * W8_SCALE, x5 * W8_SCALE, x6 * W8_SCALE, x7 * W8_SCALE);
            *(GAS v2u*)(WT8 + (size_t)(row_off + n0 + n) * K + k0 + 8 * c) = o; } }
    LDS_WAIT(); asm volatile("" ::: "memory");
}
__device__ __forceinline__ void cvt8(const float* src, bf16* dst) {
    const f32x4 a = *(const GAS f32x4*)src, b = *(const GAS f32x4*)(src + 4);
    v4u o; o.x = pk2(a.x, a.y); o.y = pk2(a.z, a.w); o.z = pk2(b.x, b.y); o.w = pk2(b.z, b.w);
    *(GAS v4u*)dst = o;
}
__device__ __forceinline__ void phase_prologue(Frame& F) {
    {
        LAS float* S = (LAS float*)F.lds;
        LAS float* red = (LAS float*)(F.lds + 16384);
        float* modp = (float*)(F.ws + WS_MODP);
        for (int u = F.bx; u < 96 * 8; u += F.G) {
            const int cb = u >> 3, kc = u & 7, layer = cb / 48, col0 = (cb % 48) * 256, kbase = kc * 256;
            for (int e = F.tid; e < 9 * 256; e += 512) { const int r = e >> 8, kk = e & 255;
                const float v = r < 8 ? inp<I_C>()[(size_t)r * DM + kbase + kk] : inp<I_CCTX>()[kbase + kk];
                S[e] = v / (1.0f + __expf(-v)); }
            __syncthreads();
            f32x4 acc[9];
#pragma unroll
            for (int r = 0; r < 9; ++r) acc[r] = (f32x4){0.f, 0.f, 0.f, 0.f};
            const float* wp = inp<I_WADA>() + ((size_t)layer * DM + kbase + F.wave * 32) * (6 * DM) + col0 + F.lane * 4;
#pragma unroll 8
            for (int kk = 0; kk < 32; ++kk) {
                const f32x4 w = *(const GAS f32x4*)(wp + (size_t)kk * (6 * DM));
#pragma unroll
                for (int r = 0; r < 9; ++r) { const float s = S[r * 256 + F.wave * 32 + kk]; acc[r] += w * s; }
            }
#pragma unroll
            for (int r = 0; r < 9; ++r) *(LAS f32x4*)(red + (F.wave * 9 + r) * 256 + F.lane * 4) = acc[r];
            __syncthreads();
            for (int e = F.tid; e < 9 * 256; e += 512) { const int r = e >> 8, cc = e & 255; float s = 0.f;
#pragma unroll
                for (int w = 0; w < 8; ++w) s += red[(w * 9 + r) * 256 + cc];
                modp[(((size_t)kc * 2 + layer) * 9 + r) * (6 * DM) + col0 + cc] = s; }
            __syncthreads();
        }
    }
    if (F.bx == F.G - 1) {
        float* rope = (float*)(F.ws + WS_ROPE);
        for (int e = F.tid; e < 64 * 32; e += 512) { const int pos = e >> 5, f = e & 31;
            const float inv = powf(10000.0f, -(float)f / 32.0f); const float ang = (float)pos * inv;
            rope[e] = cosf(ang); rope[2048 + e] = sinf(ang); }
    }
    LAS float* scr = (LAS float*)(F.lds + F.wave * 16384);
    const int gw = F.vcu * NWAVES + F.wave, NGW = F.G * NWAVES;
    constexpr int I_IN = (DM / 64) * (INW / 64), I_SQ = (DM / 64) * (DM / 64), I_PG = (256 / 64) * (512 / 64);
    constexpr int PER_LAYER = I_IN + 3 * I_SQ + 4 * I_PG;
    for (int it = gw; it < NLAYER * PER_LAYER; it += NGW) {
        const int layer = it / PER_LAYER; int r = it % PER_LAYER;
        if (r < I_IN) { const bool pool = (unsigned)(r % (INW / 64) - POOLOFF / 64) < 1024u / 64u;
            p0_transpose_item(inp<I_WIN>() + (size_t)layer * DM * INW, DM, INW, pool ? (bf16*)(F.ws + WS_WIN + (size_t)layer * 32 * MiB) : (bf16*)nullptr,
                              pool ? (unsigned char*)nullptr : F.ws + WS_WIN8 + (size_t)layer * 32 * MiB, 0, scr, r, F.lane); continue; } r -= I_IN;
        if (r < I_SQ) { p0_transpose_item(inp<I_WBR>() + (size_t)layer * DM * DM, DM, DM, nullptr, F.ws + WS_WBR8 + (size_t)layer * 32 * MiB, 0, scr, r, F.lane); continue; } r -= I_SQ;
        if (r < I_SQ) { p0_transpose_item(inp<I_WOUT>() + (size_t)layer * DM * DM, DM, DM, (bf16*)(F.ws + WS_WOUT + (size_t)layer * 8 * MiB), nullptr, 0, scr, r, F.lane); continue; } r -= I_SQ;
        if (r < I_SQ) { p0_transpose_item(inp<I_WQP>() + (size_t)layer * DM * DM, DM, DM, (bf16*)(F.ws + WS_WQP + (size_t)layer * 8 * MiB), nullptr, 0, scr, r, F.lane); continue; } r -= I_SQ;
        const int g = r / I_PG; r %= I_PG;
        p0_transpose_item(inp<I_WPOOL>() + ((size_t)layer * 4 + g) * 256 * 512, 256, 512, (bf16*)(F.ws + WS_WPOOL + (size_t)layer * 1 * MiB), nullptr, g * 512, scr, r, F.lane);
    }
    const size_t gt = (size_t)F.vcu * 512 + F.tid, NGT = (size_t)F.G * 512;
    for (size_t e = gt; e < (size_t)NLAYER * 2048 * 16; e += NGT) cvt8(inp<I_KEYS>() + e * 8, (bf16*)(F.ws + WS_KEYS) + e * 8);
    {
        typedef __bf16 bf32v __attribute__((ext_vector_type(32)));
        typedef unsigned v6u __attribute__((ext_vector_type(6)));
        const float* pu_ = inp<I_PU>(); const float* pv_ = inp<I_PV>();
        constexpr int NROWS = NLAYER * NEXP;
        for (int rr = gw; rr < 2 * NROWS; rr += NGW) {
            const bool isu = rr < NROWS; const int row = isu ? rr : rr - NROWS;
            const float* src = (isu ? pu_ : pv_) + (size_t)row * DM + F.lane * 4;
            f32x4 v[8];
#pragma unroll
            for (int j = 0; j < 8; ++j) v[j] = *(const GAS f32x4*)(src + 256 * j);
            float m = 0.f;
#pragma unroll
            for (int j = 0; j < 8; ++j) m = fmaxf(m, fmaxf(fmaxf(fabsf(v[j].x), fabsf(v[j].y)), fmaxf(fabsf(v[j].z), fabsf(v[j].w))));
            m = wave_max(m);
            float sc = 1.0f;
            if (m > 1e-30f) sc = fminf(6.0f / m, 1.0e30f);
            {
                unsigned pk[4];
#pragma unroll
                for (int d = 0; d < 4; ++d) { unsigned p = 0u;
                    p = __builtin_amdgcn_cvt_scalef32_pk_fp4_f32(p, v[2 * d].x * sc, v[2 * d].y * sc, 1.0f, 0); p = __builtin_amdgcn_cvt_scalef32_pk_fp4_f32(p, v[2 * d].z * sc, v[2 * d].w * sc, 1.0f, 1);
                    p = __builtin_amdgcn_cvt_scalef32_pk_fp4_f32(p, v[2 * d + 1].x * sc, v[2 * d + 1].y * sc, 1.0f, 2); p = __builtin_amdgcn_cvt_scalef32_pk_fp4_f32(p, v[2 * d + 1].z * sc, v[2 * d + 1].w * sc, 1.0f, 3);
                    pk[d] = p; }
                unsigned char* dst = F.ws + (isu ? WS_PU : WS_PV) + (size_t)(row / NEXP) * 32 * MiB + (size_t)(row % NEXP) * 1024 + F.lane * 16;
                *(GAS v4u*)dst = (v4u){pk[0], pk[1], pk[2], pk[3]};
            }
            if (F.lane == 0) ((float*)(F.ws + (isu ? WS_SCU : WS_SCV)))[row] = 1.0f / sc;
        }
    }
}
__device__ __forceinline__ void phase_mod_finalize(Frame& F) {
    const float* modp = (const float*)(F.ws + WS_MODP); float* mod = (float*)(F.ws + WS_MOD);
    constexpr int NMOD = NLAYER * 9 * 6 * DM;
    for (int e = F.vcu * 512 + F.tid; e < NMOD; e += F.G * 512) {
        const int layer = e / (9 * 6 * DM), col = e % (6 * DM);
        float s = inp<I_BADA>()[(size_t)layer * 6 * DM + col];
#pragma unroll
        for (int kc = 0; kc < 8; ++kc) s += modp[(size_t)kc * NMOD + e];
        mod[e] = s;
    }
}
__device__ __forceinline__ void phase_modulate(Frame& F, int layer, int which, int nrows, bool from_inputs, bool with_fp8) {
    const int gw = F.vcu * NWAVES + F.wave, NGW = F.G * NWAVES;
    bf16* H = (bf16*)(F.ws + WS_H);
    const float* x_ = inp<I_X>(); const float* ctx_ = inp<I_CTX>();
    for (int row = gw; row < nrows; row += NGW) {
        const float* mp = mod_ptr(F, layer, row) + (which ? 3 * DM : 0);
        f32x4 v[8]; float ss = 0.f;
        if (from_inputs) { const float* src = row < TL ? x_ + (size_t)row * DM : ctx_ + (size_t)(row - TL) * DM;
#pragma unroll
            for (int j = 0; j < 4; ++j) { v[2 * j] = *(const GAS f32x4*)(src + j * 512 + F.lane * 8); v[2 * j + 1] = *(const GAS f32x4*)(src + j * 512 + F.lane * 8 + 4); }
        } else { const bf16* src = (const bf16*)(F.ws + WS_X) + (size_t)row * DM; v4u r[4];
#pragma unroll
            for (int j = 0; j < 4; ++j) r[j] = *(const GAS v4u*)(src + j * 512 + F.lane * 8);
#pragma unroll
            for (int j = 0; j < 4; ++j) { v[2 * j] = (f32x4){bflo(r[j].x), bfhi(r[j].x), bflo(r[j].y), bfhi(r[j].y)}; v[2 * j + 1] = (f32x4){bflo(r[j].z), bfhi(r[j].z), bflo(r[j].w), bfhi(r[j].w)}; } }
#pragma unroll
        for (int j = 0; j < 8; ++j) ss += (v[j].x * v[j].x + v[j].y * v[j].y) + (v[j].z * v[j].z + v[j].w * v[j].w);
        const float rs = 1.0f / sqrtf(wave_sum(ss) * (1.0f / DM) + EPS);
#pragma unroll
        for (int j = 0; j < 4; ++j) { const int col = j * 512 + F.lane * 8;
            const f32x4 sh0 = *(const GAS f32x4*)(mp + col), sh1 = *(const GAS f32x4*)(mp + col + 4), sc0 = *(const GAS f32x4*)(mp + DM + col), sc1 = *(const GAS f32x4*)(mp + DM + col + 4);
            const f32x4 o0 = v[2 * j] * rs * (sc0 + 1.0f) + sh0, o1 = v[2 * j + 1] * rs * (sc1 + 1.0f) + sh1;
            v4u w; w.x = pk2(o0.x, o0.y); w.y = pk2(o0.z, o0.w); w.z = pk2(o1.x, o1.y); w.w = pk2(o1.z, o1.w);
            *(GAS v4u*)(H + (size_t)row * DM + col) = w;
            if (with_fp8) { v2u w8; w8.x = pk4_fp8(o0.x, o0.y, o0.z, o0.w); w8.y = pk4_fp8(o1.x, o1.y, o1.z, o1.w); *(GAS v2u*)(F.ws + WS_H8 + (size_t)row * DM + col) = w8; }
        }
    }
}

__device__ __forceinline__ v4u qk_item(const v4u raw, int row, int quad, int layer, int lane, const float* rope, const float* qg_, const float* kg_) {
    const int l16 = lane & 15, d0 = l16 * 8, head = quad * 4 + (lane >> 4);
    float v[8] = {bflo(raw.x), bfhi(raw.x), bflo(raw.y), bfhi(raw.y), bflo(raw.z), bfhi(raw.z), bflo(raw.w), bfhi(raw.w)};
    float ss = 0.f;
#pragma unroll
    for (int e = 0; e < 8; ++e) ss += v[e] * v[e];
    ss += __shfl_xor(ss, 1); ss += __shfl_xor(ss, 2); ss += __shfl_xor(ss, 4); ss += __shfl_xor(ss, 8);
    const float rs = 1.0f / sqrtf(ss * (1.0f / 128.0f) + EPS);
    const float* gain = (head < 16 ? qg_ : kg_) + (size_t)layer * 128 + d0;
    const f32x4 g0 = *(const GAS f32x4*)gain, g1 = *(const GAS f32x4*)(gain + 4);
    const float gg[8] = {g0.x, g0.y, g0.z, g0.w, g1.x, g1.y, g1.z, g1.w};
#pragma unroll
    for (int e = 0; e < 8; ++e) v[e] = v[e] * rs * gg[e];
    float part[8];
#pragma unroll
    for (int e = 0; e < 8; ++e) part[e] = __shfl_xor(v[e], 4);
    if (row < TL) {
        const int t = row & (SEQ - 1), pos = (d0 < 64) ? (t >> 6) : (t & 63), f0 = d0 & 31;
        const float* cs = rope + pos * 32 + f0; const float* sn = cs + 2048;
        const f32x4 c0 = *(const GAS f32x4*)cs, c1 = *(const GAS f32x4*)(cs + 4), s0 = *(const GAS f32x4*)sn, s1 = *(const GAS f32x4*)(sn + 4);
        const float cc[8] = {c0.x, c0.y, c0.z, c0.w, c1.x, c1.y, c1.z, c1.w}, sv[8] = {s0.x, s0.y, s0.z, s0.w, s1.x, s1.y, s1.z, s1.w};
        const float sgn = (l16 & 4) ? 1.0f : -1.0f;
#pragma unroll
        for (int e = 0; e < 8; ++e) v[e] = v[e] * cc[e] + sgn * part[e] * sv[e];
    }
    v4u o; o.x = pk2(v[0], v[1]); o.y = pk2(v[2], v[3]); o.z = pk2(v[4], v[5]); o.w = pk2(v[6], v[7]);
    return o;
}
__device__ __forceinline__ void phase_post(Frame& F, int layer) {
    const int gw = F.vcu * NWAVES + F.wave, NGW = F.G * NWAVES, lane = F.lane;
    bf16* P = (bf16*)(F.ws + WS_P);
    const float* rope = (const float*)(F.ws + WS_ROPE);
    const float* qg_ = inp<I_QG>(); const float* kg_ = inp<I_KG>();
    for (int it0 = gw; it0 < TT; it0 += 4 * NGW) {
        v4u raw[4]; bool ok[4];
#pragma unroll
        for (int q = 0; q < 4; ++q) { const int row = it0 + q * NGW; ok[q] = row < TT;
            if (ok[q]) raw[q] = *(const GAS v4u*)(P + (size_t)row * INW + 4 * 512 + lane * 8); }
#pragma unroll
        for (int q = 0; q < 4; ++q) if (ok[q]) { const int row = it0 + q * NGW;
            *(GAS v4u*)(P + (size_t)row * INW + 4 * 512 + lane * 8) = qk_item(raw[q], row, 4, layer, lane, rope, qg_, kg_); }
    }
    bf16* PO = (bf16*)(F.ws + WS_POOLED);
    const int prow = (layer == NLAYER - 1) ? TL : TT;
    for (int it = gw; it < prow * 2; it += NGW) {
        const int row = it >> 1, hsel = it & 1, c8 = hsel * 64 + lane, g = c8 >> 5, half = 1 << g;
        int base, t, L;
        if (row < TL) { base = row & ~(SEQ - 1); t = row & (SEQ - 1); L = SEQ; } else { const int j = row - TL; base = TL + (j & ~(CTXL - 1)); t = j & (CTXL - 1); L = CTXL; }
        const int lo = max(t - half, 0), hi = min(t + half, L);
        float acc[8] = {0.f, 0.f, 0.f, 0.f, 0.f, 0.f, 0.f, 0.f};
        const bf16* pp = P + (size_t)base * INW + POOLOFF + c8 * 8;
        const v4u selfraw = *(const GAS v4u*)(pp + (size_t)t * INW);
#define POOL_ACC(NW, H0) do { v4u rw_[NW]; \
            _Pragma("unroll") for (int d = 0; d < NW; ++d) { const int tt = min(max(t - (H0) + d, 0), L - 1); rw_[d] = *(const GAS v4u*)(pp + (size_t)tt * INW); } \
            _Pragma("unroll") for (int d = 0; d < NW; ++d) { const int tt = t - (H0) + d; const float wgt = (tt >= lo && tt < hi) ? 1.0f : 0.0f; \
                acc[0] += wgt * bflo(rw_[d].x); acc[1] += wgt * bfhi(rw_[d].x); acc[2] += wgt * bflo(rw_[d].y); acc[3] += wgt * bfhi(rw_[d].y); \
                acc[4] += wgt * bflo(rw_[d].z); acc[5] += wgt * bfhi(rw_[d].z); acc[6] += wgt * bflo(rw_[d].w); acc[7] += wgt * bfhi(rw_[d].w); } } while (0)
        if (hsel == 0) POOL_ACC(4, 2); else POOL_ACC(16, 8);
#undef POOL_ACC
        const float self[8] = {bflo(selfraw.x), bfhi(selfraw.x), bflo(selfraw.y), bfhi(selfraw.y), bflo(selfraw.z), bfhi(selfraw.z), bflo(selfraw.w), bfhi(selfraw.w)};
        const float inv = 1.0f / (float)(hi - lo);
        v4u o; o.x = pk2(acc[0] * inv - self[0], acc[1] * inv - self[1]); o.y = pk2(acc[2] * inv - self[2], acc[3] * inv - self[3]);
        o.z = pk2(acc[4] * inv - self[4], acc[5] * inv - self[5]); o.w = pk2(acc[6] * inv - self[6], acc[7] * inv - self[7]);
        *(GAS v4u*)(PO + (size_t)row * 1024 + c8 * 8) = o;
    }
}

namespace attn {
constexpr int D = 128, NW = 8, QBLK = 32, KVBLK = 64;
constexpr float SCALE = 0.088388347648318440f;
constexpr float THR = 8.f;
constexpr int LDQ = INW, LDK = INW, LDO = DM;
constexpr size_t SHM_V = KVBLK * D * 2, SHM_K = KVBLK * D * 2;
constexpr size_t OFF_WS = 2 * SHM_V + 2 * SHM_K, OFF_OST = OFF_WS + NW * 64 * 4, SHM_ATTN = OFF_OST + NW * 4096;
using s16x4  = __attribute__((ext_vector_type(4))) short;
using f32x16 = __attribute__((ext_vector_type(16))) float;
using u32x4  = __attribute__((ext_vector_type(4))) unsigned;
#define KSWZ(row, colB) ((row) * 256 + ((colB) ^ (((row) & 7) << 4)))
#define SBAR() __builtin_amdgcn_sched_barrier(0)
__device__ __forceinline__ int crow(int r, int hi) { return (r & 3) + 8 * (r >> 2) + 4 * hi; }
__device__ __forceinline__ unsigned cvtpk(float lo, float hi) { unsigned r; asm volatile("v_cvt_pk_bf16_f32 %0, %1, %2" : "=v"(r) : "v"(lo), "v"(hi)); return r; }
__device__ __forceinline__ void partialSM(f32x16& p0, f32x16& p1, float& m_reg, float& mn, float& alpha) {
  constexpr float C = SCALE * 1.4426950408889634f;
  float pmax = p0[0]; for (int r = 1; r < 16; ++r) pmax = fmaxf(pmax, p0[r]); for (int r = 0; r < 16; ++r) pmax = fmaxf(pmax, p1[r]);
  { auto rr = __builtin_amdgcn_permlane32_swap(__float_as_uint(pmax), __float_as_uint(pmax), false, false);
    pmax = fmaxf(__uint_as_float(rr[0]), __uint_as_float(rr[1])); }
  if (__builtin_expect(__all(pmax - m_reg <= THR / SCALE), 1)) { mn = m_reg; alpha = 1.f; }
  else { mn = fmaxf(m_reg, pmax); alpha = __builtin_amdgcn_exp2f((m_reg - mn) * C); m_reg = mn; }
  float mnC = -mn * C;
  for (int r = 0; r < 16; ++r) p0[r] = fmaf(p0[r], C, mnC); for (int r = 0; r < 16; ++r) p1[r] = fmaf(p1[r], C, mnC);
  for (int r = 0; r < 16; ++r) p0[r] = __builtin_amdgcn_exp2f(p0[r]);
}
__device__ __forceinline__ void finishSM(f32x16& p0, f32x16& p1, float alpha, float& l_reg, bf16x8& pa0, bf16x8& pa1, bf16x8& pa2, bf16x8& pa3) {
  for (int r = 0; r < 16; ++r) p1[r] = __builtin_amdgcn_exp2f(p1[r]);
  float ps = 0; for (int r = 0; r < 16; ++r) ps += p0[r]; for (int r = 0; r < 16; ++r) ps += p1[r];
  { auto rr = __builtin_amdgcn_permlane32_swap(__float_as_uint(ps), __float_as_uint(ps), false, false);
    ps = __uint_as_float(rr[0]) + __uint_as_float(rr[1]); }
  l_reg = l_reg * alpha + ps;
#define PK4(P, BASE, OUT) do { unsigned a0 = cvtpk(P[BASE + 0], P[BASE + 1]), a1 = cvtpk(P[BASE + 2], P[BASE + 3]);   \
    unsigned b0 = cvtpk(P[BASE + 4], P[BASE + 5]), b1 = cvtpk(P[BASE + 6], P[BASE + 7]);                              \
    auto r0 = __builtin_amdgcn_permlane32_swap(a0, b0, false, false); auto r1 = __builtin_amdgcn_permlane32_swap(a1, b1, false, false); \
    u32x4 w = {r0[0], r1[0], r0[1], r1[1]}; OUT = *reinterpret_cast<bf16x8*>(&w); } while (0)
  PK4(p0, 0, pa0); PK4(p0, 8, pa1); PK4(p1, 0, pa2); PK4(p1, 8, pa3);
#undef PK4
}
__device__ __forceinline__ void qkt(f32x16& p0, f32x16& p1, const bf16* Ks, const bf16x8* qr, int r32, int hi) {
  p0 = f32x16{}; p1 = f32x16{};
  for (int d0 = 0; d0 < 8; ++d0) { int cb = (d0 * 16 + hi * 8) * 2;
    bf16x8 b0 = *reinterpret_cast<const bf16x8*>((const char*)Ks + KSWZ(r32, cb));
    bf16x8 b1 = *reinterpret_cast<const bf16x8*>((const char*)Ks + KSWZ(32 + r32, cb));
    p0 = __builtin_amdgcn_mfma_f32_32x32x16_bf16(b0, qr[d0], p0, 0, 0, 0);
    p1 = __builtin_amdgcn_mfma_f32_32x32x16_bf16(b1, qr[d0], p1, 0, 0, 0); }
}
__device__ __forceinline__ int v_st(int k, int c) { const int kk = (k & ~0xC) | ((k & 4) << 1) | ((k & 8) >> 1); return ((kk >> 3) * 4 + (c >> 5)) * 512 + ((kk & 7) * 32 + (c & 31)) * 2; }
__device__ __forceinline__ int v_rd_base(int lane) { return ((lane & 3) << 3) | (((lane >> 2) & 3) << 6) | (((lane >> 4) & 1) << 5) | (((lane >> 5) & 1) << 8); }
constexpr int v_rd_off(int d0, int ks, int half) { return d0 * 512 + ks * 4096 + half * 2048; }
template <int OFF> __device__ __forceinline__ s16x4 tr_read(int vb) {
  s16x4 r; asm volatile("ds_read_b64_tr_b16 %0, %1 offset:%2" : "=&v"(r) : "v"(vb), "i"(OFF) : "memory"); return r;
}
template <int D0> __device__ __forceinline__ void pv_one(f32x16& od, int vb, bf16x8 pa0, bf16x8 pa1, bf16x8 pa2, bf16x8 pa3) {
  const s16x4 l0 = tr_read<v_rd_off(D0, 0, 0)>(vb), h0 = tr_read<v_rd_off(D0, 0, 1)>(vb), l1 = tr_read<v_rd_off(D0, 1, 0)>(vb), h1 = tr_read<v_rd_off(D0, 1, 1)>(vb);
  const s16x4 l2 = tr_read<v_rd_off(D0, 2, 0)>(vb), h2 = tr_read<v_rd_off(D0, 2, 1)>(vb), l3 = tr_read<v_rd_off(D0, 3, 0)>(vb), h3 = tr_read<v_rd_off(D0, 3, 1)>(vb);
  asm volatile("s_waitcnt lgkmcnt(0)" ::: "memory"); SBAR();
#define PK(L, H) (bf16x8){L[0], L[1], L[2], L[3], H[0], H[1], H[2], H[3]}
  od = __builtin_amdgcn_mfma_f32_32x32x16_bf16(pa0, PK(l0, h0), od, 0, 0, 0);
  od = __builtin_amdgcn_mfma_f32_32x32x16_bf16(pa1, PK(l1, h1), od, 0, 0, 0);
  od = __builtin_amdgcn_mfma_f32_32x32x16_bf16(pa2, PK(l2, h2), od, 0, 0, 0);
  od = __builtin_amdgcn_mfma_f32_32x32x16_bf16(pa3, PK(l3, h3), od, 0, 0, 0);
#undef PK
}
__device__ __forceinline__ void pv_d0(f32x16* o, int vb, bf16x8 pa0, bf16x8 pa1, bf16x8 pa2, bf16x8 pa3) {
  pv_one<0>(o[0], vb, pa0, pa1, pa2, pa3); pv_one<1>(o[1], vb, pa0, pa1, pa2, pa3); pv_one<2>(o[2], vb, pa0, pa1, pa2, pa3); pv_one<3>(o[3], vb, pa0, pa1, pa2, pa3);
}
__device__ __forceinline__ void attn_unit(const bf16* __restrict__ Qb, const bf16* __restrict__ K1, const bf16* __restrict__ K2,
                                          int len1, int seq, unsigned char* __restrict__ Ob, char* lds, const float* __restrict__ qgain, const float* __restrict__ rope, int tq0) {
  int tid_ = threadIdx.x; asm volatile("" : "+v"(tid_));
  const int tid = tid_, wid = tid >> 6, lane = tid & 63, r32 = lane & 31, hi = lane >> 5;
  bf16* V_lds = (bf16*)lds; bf16* K_lds = (bf16*)(lds + 2 * SHM_V);
  float* ws = (float*)(lds + OFF_WS) + wid * 64; float* li_l = ws; float* al_l = ws + 32;
  float m_reg = -1e30f, l_reg = 0; f32x16 o[4] = {}; bf16x8 qr[8];
  const bf16* Qw = Qb + (long)(wid * QBLK + r32) * LDQ + hi * 8;
#pragma unroll
  for (int d0 = 0; d0 < 8; ++d0) qr[d0] = *(const GAS bf16x8*)(Qw + d0 * 16);
  {
    float qf[8][8]; float ss = 0.f;
#pragma unroll
    for (int d0 = 0; d0 < 8; ++d0) { const u32x4 w = __builtin_bit_cast(u32x4, qr[d0]);
      qf[d0][0] = bflo(w[0]); qf[d0][1] = bfhi(w[0]); qf[d0][2] = bflo(w[1]); qf[d0][3] = bfhi(w[1]); qf[d0][4] = bflo(w[2]); qf[d0][5] = bfhi(w[2]); qf[d0][6] = bflo(w[3]); qf[d0][7] = bfhi(w[3]);
#pragma unroll
      for (int e = 0; e < 8; ++e) ss += qf[d0][e] * qf[d0][e]; }
    { auto rr = __builtin_amdgcn_permlane32_swap(__float_as_uint(ss), __float_as_uint(ss), false, false); ss = __uint_as_float(rr[0]) + __uint_as_float(rr[1]); }
    const float rs = 1.0f / sqrtf(ss * (1.0f / 128.0f) + EPS);
#pragma unroll
    for (int d0 = 0; d0 < 8; ++d0) { const float* gp = qgain + d0 * 16 + hi * 8; const f32x4 g0 = *(const GAS f32x4*)gp, g1 = *(const GAS f32x4*)(gp + 4);
      qf[d0][0] *= rs * g0.x; qf[d0][1] *= rs * g0.y; qf[d0][2] *= rs * g0.z; qf[d0][3] *= rs * g0.w; qf[d0][4] *= rs * g1.x; qf[d0][5] *= rs * g1.y; qf[d0][6] *= rs * g1.z; qf[d0][7] *= rs * g1.w; }
    if (tq0 >= 0) {
      const int t = tq0 + wid * QBLK + r32;
#pragma unroll
      for (int ch = 0; ch < 2; ++ch) { const int pos = ch == 0 ? (t >> 6) : (t & 63);
#pragma unroll
        for (int dd = 0; dd < 2; ++dd) { const int dA = ch * 4 + dd, dB = dA + 2; const float* cs = rope + pos * 32 + dd * 16 + hi * 8; const float* sn = cs + 2048;
          const f32x4 c0 = *(const GAS f32x4*)cs, c1 = *(const GAS f32x4*)(cs + 4), s0 = *(const GAS f32x4*)sn, s1 = *(const GAS f32x4*)(sn + 4);
          const float cc[8] = {c0.x, c0.y, c0.z, c0.w, c1.x, c1.y, c1.z, c1.w}, sv[8] = {s0.x, s0.y, s0.z, s0.w, s1.x, s1.y, s1.z, s1.w};
#pragma unroll
          for (int e = 0; e < 8; ++e) { const float x1 = qf[dA][e], x2 = qf[dB][e]; qf[dA][e] = x1 * cc[e] - x2 * sv[e]; qf[dB][e] = x2 * cc[e] + x1 * sv[e]; } } }
    }
#pragma unroll
    for (int d0 = 0; d0 < 8; ++d0) { u32x4 w; w[0] = cvtpk(qf[d0][0], qf[d0][1]); w[1] = cvtpk(qf[d0][2], qf[d0][3]); w[2] = cvtpk(qf[d0][4], qf[d0][5]); w[3] = cvtpk(qf[d0][6], qf[d0][7]); qr[d0] = __builtin_bit_cast(bf16x8, w); }
  }
  const int sr = tid >> 4, sc = (tid & 15) * 8, vst0 = v_st(sr, sc), vst1 = v_st(32 + sr, sc);
  const int vb0 = (int)(uintptr_t)V_lds + v_rd_base(lane);
  struct { bf16x8 vs0, vs1, ks0, ks1; } sr_[2];
  const unsigned lo0_ = (unsigned)(sr * LDK + sc) * 2u, lo1_ = lo0_ + 32u * LDK * 2u;
  constexpr int VKB = (VOFF - KVOFF) * 2;
#define SLOAD(i, k0) do { const int k0_ = (k0); const char* Kt_ = (const char*)((k0_ < len1) ? K1 + (long)k0_ * LDK : K2 + (long)(k0_ - len1) * LDK); \
    sr_[i].vs0 = *(const GAS bf16x8*)(Kt_ + lo0_ + VKB); sr_[i].vs1 = *(const GAS bf16x8*)(Kt_ + lo1_ + VKB); \
    sr_[i].ks0 = *(const GAS bf16x8*)(Kt_ + lo0_); sr_[i].ks1 = *(const GAS bf16x8*)(Kt_ + lo1_); } while (0)
#define SWRITE(b, i) do { *(bf16x8*)((char*)V_lds + (b) * SHM_V + vst0) = sr_[i].vs0;          \
    *(bf16x8*)((char*)V_lds + (b) * SHM_V + vst1) = sr_[i].vs1; int kc = sc * 2;               \
    *(bf16x8*)((char*)K_lds + (b) * SHM_K + KSWZ(sr, kc)) = sr_[i].ks0;                       \
    *(bf16x8*)((char*)K_lds + (b) * SHM_K + KSWZ(32 + sr, kc)) = sr_[i].ks1; } while (0)
#define SWAIT() asm volatile("s_waitcnt vmcnt(4)" ::: "memory")
#define RESC(a) do { if (__any((a) < 1.f)) { if (hi == 0) al_l[r32] = (a); asm volatile("s_waitcnt lgkmcnt(0)" ::: "memory"); \
    for (int d = 0; d < 4; ++d) for (int r = 0; r < 16; ++r) o[d][r] *= al_l[crow(r, hi)]; } } while (0)
  f32x16 pA0, pA1, pB0, pB1; float mnA, mnB, alA, alB; bf16x8 pa0, pa1, pa2, pa3; const int NT = seq / KVBLK;
  constexpr int SE = 0, SO = 1;
  SLOAD(SE, 0); asm volatile("s_waitcnt vmcnt(0)" ::: "memory"); SWRITE(0, SE); __syncthreads();
  qkt(pA0, pA1, K_lds, qr, r32, hi); partialSM(pA0, pA1, m_reg, mnA, alA);
  SLOAD(SO, KVBLK); if (2 < NT) SLOAD(SE, 2 * KVBLK);
  SWAIT(); SWRITE(1, SO); __syncthreads();
  for (int j = 1; j + 1 < NT; j += 2) {
    SBAR(); qkt(pB0, pB1, (bf16*)((char*)K_lds + SHM_K), qr, r32, hi);
    finishSM(pA0, pA1, alA, l_reg, pa0, pa1, pa2, pa3); SBAR();
    SLOAD(SO, (j + 2) * KVBLK); SBAR();
    pv_d0(o, vb0, pa0, pa1, pa2, pa3); partialSM(pB0, pB1, m_reg, mnB, alB);
    __syncthreads(); SWAIT(); SWRITE(0, SE);
    RESC(alB); __syncthreads();
    SBAR(); qkt(pA0, pA1, K_lds, qr, r32, hi);
    finishSM(pB0, pB1, alB, l_reg, pa0, pa1, pa2, pa3); SBAR();
    if (j + 3 < NT) SLOAD(SE, (j + 3) * KVBLK); SBAR();
    pv_d0(o, vb0 + (int)SHM_V, pa0, pa1, pa2, pa3); partialSM(pA0, pA1, m_reg, mnA, alA);
    __syncthreads(); SWAIT(); SWRITE(1, SO);
    RESC(alA); __syncthreads();
  }
  SBAR(); qkt(pB0, pB1, (bf16*)((char*)K_lds + SHM_K), qr, r32, hi);
  finishSM(pA0, pA1, alA, l_reg, pa0, pa1, pa2, pa3); SBAR();
  pv_d0(o, vb0, pa0, pa1, pa2, pa3); partialSM(pB0, pB1, m_reg, mnB, alB);
  __syncthreads(); RESC(alB);
  finishSM(pB0, pB1, alB, l_reg, pa0, pa1, pa2, pa3); SBAR();
  pv_d0(o, vb0 + (int)SHM_V, pa0, pa1, pa2, pa3);
  if (hi == 0) li_l[r32] = l_reg; asm volatile("s_waitcnt lgkmcnt(0)" ::: "memory");
  float rli[16];
#pragma unroll
  for (int r = 0; r < 16; ++r) rli[r] = __builtin_amdgcn_rcpf(li_l[crow(r, hi)]);
  unsigned char* Ow = (unsigned char*)Ob + (long)(wid * QBLK) * LDO;
  unsigned char* stg = (unsigned char*)(lds + OFF_OST) + wid * 4096;
#pragma unroll
  for (int r = 0; r < 16; ++r) { const int orow = crow(r, hi);
#pragma unroll
    for (int d0 = 0; d0 < 4; ++d0) { const float v = __builtin_amdgcn_fmed3f(o[d0][r] * rli[r] * 64.0f, -448.0f, 448.0f); stg[orow * 128 + d0 * 32 + r32] = (unsigned char)__builtin_amdgcn_cvt_pk_fp8_f32(v, v, 0, false); } }
  asm volatile("s_waitcnt lgkmcnt(0)" ::: "memory");
#pragma unroll
  for (int i = 0; i < 4; ++i) { const int row = i * 8 + (lane >> 3), ch = lane & 7; const u32x4 v = *(const u32x4*)(stg + row * 128 + ch * 16); *(GAS u32x4*)(Ow + (long)row * LDO + ch * 16) = v; }
  asm volatile("s_waitcnt lgkmcnt(0)" ::: "memory");
#undef SLOAD
#undef SWRITE
#undef SWAIT
#undef RESC
}
#undef KSWZ
#undef SBAR
}

__device__ __forceinline__ void phase_attention(Frame& F, int layer, char* lds) {
    const bf16* P = (const bf16*)(F.ws + WS_P); unsigned char* AO = F.ws + WS_AO;
    const float* qg_ = inp<I_QG>() + (size_t)layer * 128; const float* rope_ = (const float*)(F.ws + WS_ROPE);
    const int nunits = 1024 + (layer == NLAYER - 1 ? 0 : 128);
    for (int L = F.vcu; L < nunits; L += F.G) {
        const bool lat = L < 1024; const int cidx = L - 1024;
        const int combo = L >> 5, loc = L & 31, b = lat ? (combo >> 2) : (cidx >> 4), h = lat ? ((combo & 3) * 4 + (loc >> 3)) : (cidx & 15), kvh = h >> 2, qb = loc & 7;
        const size_t crow = (size_t)TL + b * CTXL, qrow = lat ? (size_t)b * SEQ + qb * 256 : crow, k1row = lat ? (size_t)b * SEQ : crow;
        attn::attn_unit(P + qrow * INW + h * 128, P + k1row * INW + KVOFF + kvh * 128, P + crow * INW + KVOFF + kvh * 128, lat ? SEQ : CTXL, lat ? SEQ + CTXL : CTXL, AO + qrow * DM + h * 128, lds, qg_, rope_, lat ? qb * 256 : -1);
    }
}

using pg8::f32x4;
struct FNone {};
struct FStoreBf16 { bf16* O; int ldc; float scale;
    typedef FNone Pre; typedef FNone Col;
    __device__ __forceinline__ Col col_load(int, int) const { return Col{}; }
    __device__ __forceinline__ Pre load(int, int) const { return Pre{}; }
    __device__ __forceinline__ void apply(int row, int col, f32x4 v0, f32x4 v1, Pre, Col) const {
        v0 = v0 * scale; v1 = v1 * scale;
        v4u w; w.x = pk2(v0[0], v0[1]); w.y = pk2(v0[2], v0[3]); w.z = pk2(v1[0], v1[1]); w.w = pk2(v1[2], v1[3]);
        *(GAS v4u*)(O + (size_t)row * ldc + col) = w; } };
constexpr float GATE_SCALE = 8.0f;
__device__ __forceinline__ size_t gate8_off(int row, int gc) {
    return (size_t)row * (INW * 2) + (INW) + (size_t)((gc & ~255) + ((gc & 127) << 1) + ((gc >> 7) & 1) * 8); }
__device__ __forceinline__ void unpack8_fp8(v2u raw, float* v) {
    const auto a = __builtin_amdgcn_cvt_pk_f32_fp8((int)raw.x, false), b = __builtin_amdgcn_cvt_pk_f32_fp8((int)raw.x, true), c = __builtin_amdgcn_cvt_pk_f32_fp8((int)raw.y, false), d = __builtin_amdgcn_cvt_pk_f32_fp8((int)raw.y, true);
    constexpr float inv = 1.0f / GATE_SCALE;
    v[0] = a[0] * inv; v[1] = a[1] * inv; v[2] = b[0] * inv; v[3] = b[1] * inv; v[4] = c[0] * inv; v[5] = c[1] * inv; v[6] = d[0] * inv; v[7] = d[1] * inv; }
struct FStoreG1 { bf16* O; float scale;
    typedef FNone Pre; typedef FNone Col;
    __device__ __forceinline__ void apply(int row, int col, f32x4 v0, f32x4 v1) const {
        v0 = v0 * scale; v1 = v1 * scale;
        v4u w; w.x = pk2(v0[0], v0[1]); w.y = pk2(v0[2], v0[3]); w.z = pk2(v1[0], v1[1]); w.w = pk2(v1[2], v1[3]);
        *(GAS v4u*)(O + (size_t)row * INW + col) = w; }
    __device__ __forceinline__ void apply2(int row, int col0, f32x4 a0, f32x4 a1, f32x4 b0, f32x4 b1) const {
        if (col0 < GAOFF) { apply(row, col0, a0, a1); apply(row, col0 + pg8::HALF, b0, b1); }
        else { const float g = scale * GATE_SCALE; a0 = a0 * g; a1 = a1 * g; b0 = b0 * g; b1 = b1 * g;
            v4u w; w.x = pk4_fp8(a0[0], a0[1], a0[2], a0[3]); w.y = pk4_fp8(a1[0], a1[1], a1[2], a1[3]); w.z = pk4_fp8(b0[0], b0[1], b0[2], b0[3]); w.w = pk4_fp8(b1[0], b1[1], b1[2], b1[3]);
            *(GAS v4u*)((unsigned char*)O + gate8_off(row, col0 - GAOFF)) = w; } } };
__device__ __forceinline__ void unpack8(v4u raw, float* v) { v[0] = bflo(raw.x); v[1] = bfhi(raw.x); v[2] = bflo(raw.y); v[3] = bfhi(raw.y); v[4] = bflo(raw.z); v[5] = bfhi(raw.z); v[6] = bflo(raw.w); v[7] = bfhi(raw.w); }
struct FPool { bf16* YB; const bf16* P; const float* pscale;
    struct Pre { v2u g; }; struct Col { f32x4 s0, s1; };
    __device__ __forceinline__ Col col_load(int, int col) const { Col c; c.s0 = *(const GAS f32x4*)(pscale + col); c.s1 = *(const GAS f32x4*)(pscale + col + 4); return c; }
    __device__ __forceinline__ Pre load(int row, int col) const { Pre p; p.g = *(const GAS v2u*)((const unsigned char*)P + gate8_off(row, DM + col)); return p; }
    __device__ __forceinline__ void apply(int row, int col, f32x4 v0, f32x4 v1, Pre p, Col c) const {
        float gt[8]; unpack8_fp8(p.g, gt);
        float o[8];
#pragma unroll
        for (int e = 0; e < 4; ++e) { o[e] = v0[e] * c.s0[e] * sigmoidf_(gt[e]); o[4 + e] = v1[e] * c.s1[e] * sigmoidf_(gt[4 + e]); }
        v4u w; w.x = pk2(o[0], o[1]); w.y = pk2(o[2], o[3]); w.z = pk2(o[4], o[5]); w.w = pk2(o[6], o[7]);
        *(GAS v4u*)(YB + (size_t)row * DM + col) = w; } };
struct FMerge { bf16* MG; const bf16* P; const bf16* YB; float scale;
    struct Pre { v2u g; v4u y; }; typedef FNone Col;
    __device__ __forceinline__ Col col_load(int, int) const { return Col{}; }
    __device__ __forceinline__ Pre load(int row, int col) const { Pre p; p.g = *(const GAS v2u*)((const unsigned char*)P + gate8_off(row, col)); p.y = *(const GAS v4u*)(YB + (size_t)row * DM + col); return p; }
    __device__ __forceinline__ void apply(int row, int col, f32x4 v0, f32x4 v1, Pre p, Col) const {
        v0 = v0 * scale; v1 = v1 * scale;
        float gt[8], yb[8]; unpack8_fp8(p.g, gt); unpack8(p.y, yb);
        float o[8];
#pragma unroll
        for (int e = 0; e < 4; ++e) { o[e] = v0[e] * sigmoidf_(gt[e]) + yb[e]; o[4 + e] = v1[e] * sigmoidf_(gt[4 + e]) + yb[4 + e]; }
        v4u w; w.x = pk2(o[0], o[1]); w.y = pk2(o[2], o[3]); w.z = pk2(o[4], o[5]); w.w = pk2(o[6], o[7]);
        *(GAS v4u*)(MG + (size_t)row * DM + col) = w; } };
constexpr float SG_MIN = 1e-20f;
struct FMid { const bf16* P; const float* pscale; float inv_scale;
    struct Pre { v2u ga, gb; }; struct Col { f32x4 s0, s1; };
    __device__ __forceinline__ Col col_load(int, int col) const { Col c; c.s0 = *(const GAS f32x4*)(pscale + col); c.s1 = *(const GAS f32x4*)(pscale + col + 4); return c; }
    __device__ __forceinline__ Pre load(int row, int col) const { Pre p; p.ga = *(const GAS v2u*)((const unsigned char*)P + gate8_off(row, col)); p.gb = *(const GAS v2u*)((const unsigned char*)P + gate8_off(row, DM + col)); return p; }
    __device__ __forceinline__ void xform(f32x4& v0, f32x4& v1, Pre p, Col c) const {
        float ga[8], gb[8]; unpack8_fp8(p.ga, ga); unpack8_fp8(p.gb, gb);
#pragma unroll
        for (int e = 0; e < 4; ++e) {
            v0[e] = v0[e] * (c.s0[e] * sigmoidf_(gb[e]) * (inv_scale * __builtin_amdgcn_rcpf(fmaxf(sigmoidf_(ga[e]), SG_MIN))));
            v1[e] = v1[e] * (c.s1[e] * sigmoidf_(gb[4 + e]) * (inv_scale * __builtin_amdgcn_rcpf(fmaxf(sigmoidf_(ga[4 + e]), SG_MIN)))); } } };
struct FMergeC { bf16* MG; const bf16* P; float scale;
    struct Pre { v2u g; }; typedef FNone Col;
    __device__ __forceinline__ Col col_load(int, int) const { return Col{}; }
    __device__ __forceinline__ Pre load(int row, int col) const { Pre p; p.g = *(const GAS v2u*)((const unsigned char*)P + gate8_off(row, col)); return p; }
    __device__ __forceinline__ void apply(int row, int col, f32x4 v0, f32x4 v1, Pre p, Col) const {
        float gt[8]; unpack8_fp8(p.g, gt);
        float o[8];
#pragma unroll
        for (int e = 0; e < 4; ++e) { o[e] = v0[e] * (scale * fmaxf(sigmoidf_(gt[e]), SG_MIN)); o[4 + e] = v1[e] * (scale * fmaxf(sigmoidf_(gt[4 + e]), SG_MIN)); }
        v4u w; w.x = pk2(o[0], o[1]); w.y = pk2(o[2], o[3]); w.z = pk2(o[4], o[5]); w.w = pk2(o[6], o[7]);
        *(GAS v4u*)(MG + (size_t)row * DM + col) = w; } };
struct FResid { bf16* X; const float* xin; const float* cin; const float* mod; int from_inputs;
    struct Pre { f32x4 x0, x1; }; struct Col { f32x4 g0, g1; };
    __device__ __forceinline__ Col col_load(int row, int col) const {
        const int mr = row < TL ? (row >> 11) : 8;
        const float* g = mod + (size_t)mr * (6 * DM) + 2 * DM + col;
        Col c; c.g0 = *(const GAS f32x4*)g; c.g1 = *(const GAS f32x4*)(g + 4); return c; }
    __device__ __forceinline__ Pre load(int row, int col) const {
        Pre p;
        if (from_inputs) { const float* src = (row < TL ? xin : cin - (size_t)TL * DM) + (size_t)row * DM + col; p.x0 = *(const GAS f32x4*)src; p.x1 = *(const GAS f32x4*)(src + 4); }
        else { p.x0 = *(const GAS f32x4*)(X + (size_t)row * DM + col); p.x1 = p.x0; }
        return p; }
    __device__ __forceinline__ void apply(int row, int col, f32x4 v0, f32x4 v1, Pre p, Col c) const {
        f32x4 x0 = p.x0, x1 = p.x1;
        if (!from_inputs) { const v4u raw = __builtin_bit_cast(v4u, p.x0); x0 = (f32x4){bflo(raw.x), bfhi(raw.x), bflo(raw.y), bfhi(raw.y)}; x1 = (f32x4){bflo(raw.z), bfhi(raw.z), bflo(raw.w), bfhi(raw.w)}; }
        const f32x4 o0 = x0 + c.g0 * v0, o1 = x1 + c.g1 * v1;
        v4u w; w.x = pk2(o0[0], o0[1]); w.y = pk2(o0[2], o0[3]); w.z = pk2(o1[0], o1[1]); w.w = pk2(o1[2], o1[3]);
        *(GAS v4u*)(X + (size_t)row * DM + col) = w; } };

namespace pk {
using f32x16 = __attribute__((ext_vector_type(16))) float;
__device__ __forceinline__ float vmaxf(float a, float b) { float r; asm("v_max_f32 %0, %1, %2" : "=v"(r) : "v"(a), "v"(b)); return r; }
__device__ __forceinline__ float vminf(float a, float b) { float r; asm("v_min_f32 %0, %1, %2" : "=v"(r) : "v"(a), "v"(b)); return r; }
#define PK_CE(x, y) do { const float mx_ = vmaxf(x, y), mn_ = vminf(x, y); x = mx_; y = mn_; } while (0)
template <int OFF> __device__ __forceinline__ void sort16(float (&a)[64]) {
#pragma unroll
    for (int k = 2; k <= 16; k <<= 1)
#pragma unroll
        for (int j = k >> 1; j > 0; j >>= 1)
#pragma unroll
            for (int i = 0; i < 16; ++i) { const int l = i ^ j; if (l > i) { if ((i & k) == 0) PK_CE(a[OFF + i], a[OFF + l]); else PK_CE(a[OFF + l], a[OFF + i]); } }
}
template <int A, int B> __device__ __forceinline__ void merge16(float (&a)[64]) {
#pragma unroll
    for (int i = 0; i < 16; ++i) a[A + i] = vmaxf(a[A + i], a[B + 15 - i]);
#pragma unroll
    for (int j = 8; j > 0; j >>= 1)
#pragma unroll
        for (int i = 0; i < 16; ++i) { const int l = i ^ j; if (l > i) PK_CE(a[A + i], a[A + l]); }
}
__device__ __forceinline__ void top16_of_64(float (&a)[64]) {
    sort16<0>(a); sort16<16>(a); sort16<32>(a); sort16<48>(a);
    merge16<0, 16>(a); merge16<32, 48>(a); merge16<0, 32>(a);
}
struct Cand { int a[50], b[50]; };
constexpr Cand make_cand() { Cand c{}; int n = 0; for (int a = 0; a < 16; ++a) for (int b = 0; b < 16; ++b) if ((a + 1) * (b + 1) <= 16) { c.a[n] = a; c.b[n] = b; ++n; } return c; }
constexpr Cand CAND = make_cand();
constexpr int LDS_KEYS = 0, LDS_IDX = 65536;
}
__device__ __forceinline__ void phase_pk(Frame& F, int layer, int nrows) {
    using namespace pk;
    const int lane = F.lane, r32 = lane & 31, hi = lane >> 5, wave = F.wave;
    const bf16* QP = (const bf16*)(F.ws + WS_P + P_QP);
    int* IDX = (int*)(F.ws + WS_P + P_IDX); float* GW = (float*)(F.ws + WS_P + P_GW);
    const bf16* KB = (const bf16*)(F.ws + WS_KEYS) + (size_t)layer * 2048 * 128;
    const int nunits = (nrows / 256) * 8;
    int cur_hd = -1;
    for (int u = F.bx; u < nunits; u += F.G) {
        const int hd = u & 7, tb = u >> 3;
        if (hd != cur_hd) {
            __syncthreads();
#pragma unroll
            for (int i = 0; i < 8; ++i) { const int idx = F.tid + 512 * i, row = idx >> 4, c = idx & 15;
                const v4u v = *(const GAS v4u*)(KB + ((size_t)hd * 256 + row) * 128 + c * 8);
                *(LAS v4u*)(F.lds + LDS_KEYS + row * 256 + ((c ^ (row & 15)) << 4)) = v; }
            __syncthreads();
            cur_hd = hd;
        }
        const int t0 = tb * 256 + wave * 32;
        float v01[2][16];
#pragma unroll
        for (int p = 0; p < 2; ++p) {
            bf16x8 bq[8];
            const bf16* qrow = QP + (size_t)(t0 + r32) * DM + hd * 256 + p * 128 + hi * 8;
#pragma unroll
            for (int ks = 0; ks < 8; ++ks) bq[ks] = *(const GAS bf16x8*)(qrow + ks * 16);
            f32x16 acc[4];
#pragma unroll
            for (int nb = 0; nb < 4; ++nb) acc[nb] = f32x16{};
            const LAS unsigned char* kbase = F.lds + LDS_KEYS + (p * 128 + r32) * 256;
#pragma unroll
            for (int ks = 0; ks < 8; ++ks) { const int coff = ((2 * ks + hi) ^ (r32 & 15)) << 4;
#pragma unroll
                for (int nb = 0; nb < 4; ++nb) { const bf16x8 ak = *(const LAS bf16x8*)(kbase + nb * 32 * 256 + coff);
                    acc[nb] = __builtin_amdgcn_mfma_f32_32x32x16_bf16(ak, bq[ks], acc[nb], 0, 0, 0); } }
            float a[64]; const unsigned hib = (unsigned)hi << 2;
#pragma unroll
            for (int nb = 0; nb < 4; ++nb)
#pragma unroll
                for (int r = 0; r < 16; ++r) { const unsigned n0 = 32u * nb + (r & 3) + 8u * (r >> 2);
                    a[nb * 16 + r] = __uint_as_float(((__float_as_uint(acc[nb][r]) & ~127u) | n0) | hib); }
            top16_of_64(a);
            float m0[64];
#pragma unroll
            for (int i = 0; i < 16; ++i) { auto rr = __builtin_amdgcn_permlane32_swap(__float_as_uint(a[i]), __float_as_uint(a[i]), false, false);
                m0[i] = __uint_as_float(rr[0]); m0[16 + i] = __uint_as_float(rr[1]); }
            merge16<0, 16>(m0);
#pragma unroll
            for (int i = 0; i < 16; ++i) v01[p][i] = m0[i];
        }
        LAS unsigned* tab = (LAS unsigned*)(F.lds + LDS_IDX + wave * 8192);
#pragma unroll
        for (int i = 0; i < 16; ++i) { tab[i * 64 + lane] = __float_as_uint(v01[0][i]) & 127u; tab[(16 + i) * 64 + lane] = __float_as_uint(v01[1][i]) & 127u; }
        float c[64];
        float f0[16], f1[16];
#pragma unroll
        for (int i = 0; i < 16; ++i) { f0[i] = __uint_as_float(__float_as_uint(v01[0][i]) & ~127u); f1[i] = __uint_as_float(__float_as_uint(v01[1][i]) & ~127u); }
#pragma unroll
        for (int i = 0; i < 50; ++i) c[i] = __uint_as_float((__float_as_uint(f0[CAND.a[i]] + f1[CAND.b[i]]) & ~255u) | (unsigned)(CAND.a[i] * 16 + CAND.b[i]));
#pragma unroll
        for (int i = 50; i < 64; ++i) c[i] = -INFINITY;
        top16_of_64(c);
        float ev[16], sum = 0.f;
#pragma unroll
        for (int i = 0; i < 16; ++i) { ev[i] = __expf(__uint_as_float(__float_as_uint(c[i]) & ~255u) - __uint_as_float(__float_as_uint(c[0]) & ~255u)); sum += ev[i]; }
        const float rinv = 1.0f / sum;
        LDS_WAIT();
        int eid[8]; float gw[8];
#pragma unroll
        for (int j = 0; j < 8; ++j) { const float cj = hi ? c[8 + j] : c[j]; const unsigned bits = __float_as_uint(cj);
            const unsigned ia = tab[((bits >> 4) & 15u) * 64 + lane], ib = tab[(16u + (bits & 15u)) * 64 + lane];
            eid[j] = (int)(ia * 128u + ib); gw[j] = (hi ? ev[8 + j] : ev[j]) * rinv; }
        const size_t o = (size_t)(t0 + r32) * NSEL + hd * 16 + hi * 8;
        *(GAS v4u*)(IDX + o) = (v4u){(unsigned)eid[0], (unsigned)eid[1], (unsigned)eid[2], (unsigned)eid[3]}; *(GAS v4u*)(IDX + o + 4) = (v4u){(unsigned)eid[4], (unsigned)eid[5], (unsigned)eid[6], (unsigned)eid[7]};
        *(GAS f32x4*)(GW + o) = (f32x4){gw[0], gw[1], gw[2], gw[3]}; *(GAS f32x4*)(GW + o + 4) = (f32x4){gw[4], gw[5], gw[6], gw[7]};
        LDS_WAIT();
    }
}

typedef float f32x2 __attribute__((ext_vector_type(2)));
typedef __bf16 bf16x2_t __attribute__((ext_vector_type(2)));
struct RowV { v4u a, b; };
__device__ __forceinline__ void rowv_load(RowV& r, const unsigned char* tab, int idA, int idB, int hi, int j32) {
    const unsigned off = (unsigned)(hi ? idB : idA) * 1024u + (unsigned)j32;
    const unsigned char* p = tab + off;
    r.a = *(const GAS v4u*)p; r.b = *(const GAS v4u*)(p + 16);
}
#define DW_B(b) do { const f32x2 d_ = __builtin_amdgcn_cvt_scalef32_pk_f32_fp4(dw, 1.0f, b); asm("v_pk_fma_f32 %0, %1, %2, %0" : "+v"(o[b]) : "v"(d_), "v"(w2)); } while (0)
__device__ __forceinline__ void dw_axpy(unsigned dw, f32x2 w2, f32x2* o) { DW_B(0); DW_B(1); DW_B(2); DW_B(3);
    __builtin_amdgcn_sched_barrier(0); }
__device__ __forceinline__ void rowv_axpy(const RowV& r, float w, f32x2 (&o)[32]) {
    const f32x2 w2 = {w, w};
    dw_axpy(r.a.x, w2, o); dw_axpy(r.a.y, w2, o + 4); dw_axpy(r.a.z, w2, o + 8); dw_axpy(r.a.w, w2, o + 12);
    dw_axpy(r.b.x, w2, o + 16); dw_axpy(r.b.y, w2, o + 20); dw_axpy(r.b.z, w2, o + 24); dw_axpy(r.b.w, w2, o + 28);
}
#define DW_D(dw, b, hidx) acc = __builtin_amdgcn_fdot2_f32_bf16(__builtin_amdgcn_cvt_scalef32_pk_bf16_fp4(dw, 1.0f, b), __builtin_bit_cast(bf16x2_t, h[hidx]), acc, false)
__device__ __forceinline__ float rowv_dot(const RowV& r, const unsigned (&h)[32]) {
    float acc = 0.f;
    DW_D(r.a.x, 0, 0); DW_D(r.a.x, 1, 1); DW_D(r.a.x, 2, 2); DW_D(r.a.x, 3, 3);       DW_D(r.a.y, 0, 4); DW_D(r.a.y, 1, 5); DW_D(r.a.y, 2, 6); DW_D(r.a.y, 3, 7);
    DW_D(r.a.z, 0, 8); DW_D(r.a.z, 1, 9); DW_D(r.a.z, 2, 10); DW_D(r.a.z, 3, 11);    DW_D(r.a.w, 0, 12); DW_D(r.a.w, 1, 13); DW_D(r.a.w, 2, 14); DW_D(r.a.w, 3, 15);
    DW_D(r.b.x, 0, 16); DW_D(r.b.x, 1, 17); DW_D(r.b.x, 2, 18); DW_D(r.b.x, 3, 19);  DW_D(r.b.y, 0, 20); DW_D(r.b.y, 1, 21); DW_D(r.b.y, 2, 22); DW_D(r.b.y, 3, 23);
    DW_D(r.b.z, 0, 24); DW_D(r.b.z, 1, 25); DW_D(r.b.z, 2, 26); DW_D(r.b.z, 3, 27);  DW_D(r.b.w, 0, 28); DW_D(r.b.w, 1, 29); DW_D(r.b.w, 2, 30); DW_D(r.b.w, 3, 31);
    return acc;
}
template <int CTRL, int ROWMASK> __device__ __forceinline__ float dpp_add(float v) {
    return v + __uint_as_float((unsigned)__builtin_amdgcn_update_dpp(0, (int)__float_as_uint(v), CTRL, ROWMASK, 0xF, false)); }
__device__ __forceinline__ void reduce4x2(const float (&p)[4], float (&tot)[8]) {
    float r[4];
#pragma unroll
    for (int i = 0; i < 4; ++i) r[i] = dpp_add<0xB1, 0xF>(p[i]);
#pragma unroll
    for (int i = 0; i < 4; ++i) r[i] = dpp_add<0x4E, 0xF>(r[i]);
#pragma unroll
    for (int i = 0; i < 4; ++i) r[i] = dpp_add<0x141, 0xF>(r[i]);
#pragma unroll
    for (int i = 0; i < 4; ++i) r[i] = dpp_add<0x140, 0xF>(r[i]);
#pragma unroll
    for (int i = 0; i < 4; ++i) r[i] = dpp_add<0x142, 0xA>(r[i]);
#pragma unroll
    for (int i = 0; i < 4; ++i) { tot[2 * i] = __uint_as_float(__builtin_amdgcn_readlane(__float_as_uint(r[i]), 31)); tot[2 * i + 1] = __uint_as_float(__builtin_amdgcn_readlane(__float_as_uint(r[i]), 63)); }
}
__device__ __forceinline__ float gelu_erf(float s) { return 0.5f * s * (1.0f + erff(s * 0.70710678118654752f)); }
__device__ __forceinline__ float rdl(float v, int l) { return __uint_as_float(__builtin_amdgcn_readlane(__float_as_uint(v), l)); }
__device__ __forceinline__ void phase_peer(Frame& F, int layer, int nrows) {
    const int gw = F.vcu * NWAVES + F.wave, NGW = F.G * NWAVES, lane = F.lane, hi = lane >> 5;
    const int* IDX = (const int*)(F.ws + WS_P + P_IDX); const float* GW = (const float*)(F.ws + WS_P + P_GW);
    const unsigned char* PU = F.ws + WS_PU + (size_t)layer * 32 * MiB; const unsigned char* PV = F.ws + WS_PV + (size_t)layer * 32 * MiB;
    const float* SCU = (const float*)(F.ws + WS_SCU) + (size_t)layer * NEXP; const float* SCV = (const float*)(F.ws + WS_SCV) + (size_t)layer * NEXP;
    bf16* H = (bf16*)(F.ws + WS_H); bf16* X = (bf16*)(F.ws + WS_X);
    const float* fg_ = inp<I_FG>(); float* out_ = (float*)inp<I_OUT>();
    for (int t = gw; t < nrows; t += NGW) {
        const int id0 = *(const GAS int*)(IDX + (size_t)t * NSEL + lane), id1 = *(const GAS int*)(IDX + (size_t)t * NSEL + 64 + lane);
        const float g0 = *(const GAS float*)(GW + (size_t)t * NSEL + lane), g1 = *(const GAS float*)(GW + (size_t)t * NSEL + 64 + lane);
        const float su0 = *(const GAS float*)(SCU + id0), su1 = *(const GAS float*)(SCU + id1), sv0 = *(const GAS float*)(SCV + id0), sv1 = *(const GAS float*)(SCV + id1);
        unsigned hp[32];
        { const bf16* hrow = H + (size_t)t * DM + (lane & 31) * 8;
#pragma unroll
          for (int jj = 0; jj < 8; ++jj) { const v4u q = *(const GAS v4u*)(hrow + 256 * jj); hp[2 * jj] = q.x; hp[2 * jj + 1] = q.y; hp[16 + 2 * jj] = q.z; hp[16 + 2 * jj + 1] = q.w; } }
        float s0 = 0.f, s1 = 0.f;
        const int j32 = (lane & 31) * 32;
        RowV A[2], B[2];
#define LOAD2(buf, tab, idv, base) do { _Pragma("unroll") for (int q = 0; q < 2; ++q) rowv_load(buf[q], tab, __builtin_amdgcn_readlane(idv, (base) + 2 * q), __builtin_amdgcn_readlane(idv, (base) + 2 * q + 1), hi, j32); } while (0)
#define USTEP(sv_, base, tabn, idn, basen) do { float p_[4], tt_[8]; \
        _Pragma("unroll") for (int q = 0; q < 2; ++q) { p_[q] = rowv_dot(A[q], hp); __builtin_amdgcn_sched_barrier(0); } LOAD2(A, tabn, idn, basen); __builtin_amdgcn_sched_barrier(0); \
        _Pragma("unroll") for (int q = 0; q < 2; ++q) { p_[2 + q] = rowv_dot(B[q], hp); __builtin_amdgcn_sched_barrier(0); } LOAD2(B, tabn, idn, (basen) + 4); __builtin_amdgcn_sched_barrier(0); \
        reduce4x2(p_, tt_); _Pragma("unroll") for (int q = 0; q < 8; ++q) sv_ = (lane == (base) + q) ? tt_[q] : sv_; } while (0)
        LOAD2(A, PU, id0, 0); LOAD2(B, PU, id0, 4);
#pragma unroll 1
        for (int b = 0; b < 56; b += 8) USTEP(s0, b, PU, id0, b + 8);
        USTEP(s0, 56, PU, id1, 0);
#pragma unroll 1
        for (int b = 0; b < 56; b += 8) USTEP(s1, b, PU, id1, b + 8);
        USTEP(s1, 56, PV, id0, 0);
        const float w0 = g0 * gelu_erf(s0 * su0) * sv0, w1 = g1 * gelu_erf(s1 * su1) * sv1;
        f32x2 av[32];
#pragma unroll
        for (int i = 0; i < 32; ++i) av[i] = (f32x2){0.f, 0.f};
#define VSTEP(wv_, base, idn, basen) do { \
        _Pragma("unroll") for (int q = 0; q < 2; ++q) { const float we_ = rdl(wv_, (base) + 2 * q), wo_ = rdl(wv_, (base) + 2 * q + 1); rowv_axpy(A[q], hi ? wo_ : we_, av); } LOAD2(A, PV, idn, basen); \
        _Pragma("unroll") for (int q = 0; q < 2; ++q) { const float we_ = rdl(wv_, (base) + 4 + 2 * q), wo_ = rdl(wv_, (base) + 4 + 2 * q + 1); rowv_axpy(B[q], hi ? wo_ : we_, av); } LOAD2(B, PV, idn, (basen) + 4); } while (0)
#pragma unroll 1
        for (int b = 0; b < 56; b += 8) VSTEP(w0, b, id0, b + 8);
        VSTEP(w0, 56, id1, 0);
        const int col0 = (lane & 31) * 8 + hi * 4;
        const float* mp = mod_ptr(F, layer, t);
        v2u xr_[8]; f32x4 gf_[8];
#pragma unroll
        for (int j = 0; j < 8; ++j) { const int col = col0 + 256 * j; xr_[j] = *(const GAS v2u*)(X + (size_t)t * DM + col); gf_[j] = *(const GAS f32x4*)(mp + 5 * DM + col); }
#pragma unroll 1
        for (int b = 0; b < 56; b += 8) VSTEP(w1, b, id1, b + 8);
        VSTEP(w1, 56, id1, 56);
#undef LOAD2
#undef USTEP
#undef VSTEP
        float acc[32];
#pragma unroll
        for (int i = 0; i < 32; ++i) { auto rr = __builtin_amdgcn_permlane32_swap(__float_as_uint(av[i >> 1][i & 1]), __float_as_uint(av[16 + (i >> 1)][i & 1]), false, false);
            acc[i] = __uint_as_float(rr[0]) + __uint_as_float(rr[1]); }
        float xn[32]; float ss = 0.f;
#pragma unroll
        for (int j = 0; j < 8; ++j) {
            const v2u xr = xr_[j]; const f32x4 x0 = {bflo(xr.x), bfhi(xr.x), bflo(xr.y), bfhi(xr.y)}, gf = gf_[j];
            float* o = xn + 4 * j;
            o[0] = x0.x + gf.x * acc[4 * j]; o[1] = x0.y + gf.y * acc[4 * j + 1]; o[2] = x0.z + gf.z * acc[4 * j + 2]; o[3] = x0.w + gf.w * acc[4 * j + 3];
            ss += (o[0] * o[0] + o[1] * o[1]) + (o[2] * o[2] + o[3] * o[3]); }
        const float rs = 1.0f / sqrtf(wave_sum(ss) * (1.0f / DM) + EPS);
        if (layer == NLAYER - 1) {
#pragma unroll
            for (int j = 0; j < 8; ++j) { const int col = col0 + 256 * j; const float* o = xn + 4 * j;
                const f32x4 fg = *(const GAS f32x4*)(fg_ + col);
                *(GAS f32x4*)(out_ + (size_t)t * DM + col) = (f32x4){o[0] * rs * fg.x, o[1] * rs * fg.y, o[2] * rs * fg.z, o[3] * rs * fg.w}; }
        } else {
            const float* mn = mod_ptr(F, layer + 1, t);
#pragma unroll
            for (int j = 0; j < 8; ++j) { const int col = col0 + 256 * j; const float* o = xn + 4 * j;
                { v2u xw; xw.x = pk2(o[0], o[1]); xw.y = pk2(o[2], o[3]); *(GAS v2u*)(X + (size_t)t * DM + col) = xw; }
                const f32x4 sh = *(const GAS f32x4*)(mn + col), sc = *(const GAS f32x4*)(mn + DM + col);
                v2u w; w.x = pk2(o[0] * rs * (1.0f + sc.x) + sh.x, o[1] * rs * (1.0f + sc.y) + sh.y); w.y = pk2(o[2] * rs * (1.0f + sc.z) + sh.z, o[3] * rs * (1.0f + sc.w) + sh.w);
                *(GAS v2u*)(H + (size_t)t * DM + col) = w;
                *(GAS unsigned*)(F.ws + WS_H8 + (size_t)t * DM + col) = pk4_fp8(o[0] * rs * (1.0f + sc.x) + sh.x, o[1] * rs * (1.0f + sc.y) + sh.y, o[2] * rs * (1.0f + sc.z) + sh.z, o[3] * rs * (1.0f + sc.w) + sh.w); }
        }
    }
}

constexpr int PH_PER_LAYER = 10, PH_BASE = 3, N_PHASES = PH_BASE + NLAYER * PH_PER_LAYER;
struct Args { const float* in[18]; float* out; unsigned char* ws; int ph_lo, ph_hi; };
__global__ void __launch_bounds__(NWAVES * 64, 2) mk_fwd(Args args) {
    extern __shared__ __attribute__((aligned(16))) unsigned char lds[];
    unsigned char* const wsbase = args.ws;
    for (int u = threadIdx.x; u < (LDS_BYTES - LDSCTL_OFF) / 4; u += NWAVES * 64) ((LAS unsigned*)((LAS unsigned char*)lds + LDSCTL_OFF))[u] = 0u;
    __syncthreads();
    unsigned* ctl = (unsigned*)(args.ws + WS_CTL);
    XcdBarrier bar; bar.bar = ctl + CW_BAR; bar.x = 0; bar.st = nullptr;
#if !MK_PER_PHASE
    bar = xcd_barrier_post(ctl + CW_BAR, (volatile LAS unsigned*)((LAS unsigned char*)lds + MISC_OFF) + 8);
#endif
    const int lo = args.ph_lo, hi = args.ph_hi;
#ifndef PHM
#define PHM 0xFFFF
#endif
#define EN(b) ((PHM >> (b)) & 1)
#define IN(k) (lo <= (k) && (k) < hi)
#define SEAM(k) do { if (IN(k) && IN((k) + 1)) xcd_barrier(bar); } while (0)
    if (EN(0) && IN(0)) { Frame F = mkframe(lds, wsbase); phase_prologue(F); } SEAM(0);
    if (EN(1) && IN(1)) { Frame F = mkframe(lds, wsbase); phase_mod_finalize(F); } SEAM(1);
    if (EN(2) && IN(2)) { Frame F = mkframe(lds, wsbase); phase_modulate(F, 0, 0, TT, true, true); } SEAM(2);
#pragma unroll 1
    for (int layer = 0; layer < NLAYER; ++layer) {
        const int pb = PH_BASE + layer * PH_PER_LAYER;
        const bool lastl = (layer == NLAYER - 1);
        const int MR = lastl ? TL : TT;
        if (EN(3) && IN(pb + 0)) {
            Frame F = mkframe(lds, wsbase); bf16* P = (bf16*)(F.ws + WS_P); bf16* H = (bf16*)(F.ws + WS_H); (void)P; (void)H;
            {
                pg8::Gemm<DM, DM, DM, 0, 0, 2> g{H, F.ws + WS_WIN + (size_t)layer * 32 * MiB};
                pg8::SplitOrder S; S.S.init(MR, 4 * 256, F.G, F.bx); S.kind = 0; S.pm0 = 0; S.nMx = 0;
                pg8::EpiRow8<FStoreBf16> E{{P, INW, 1.0f}};
                pg8::gemm_phase(F.lds, g, S, E); }
            {
                pg8::Gemm<DM, DM, DM, 0, 0, 1> g{F.ws + WS_H8, F.ws + WS_WIN8 + (size_t)layer * 32 * MiB};
                pg8::SplitOrder S; S.S.init(MR, 28 * 256, F.G, F.G - 1 - F.bx); S.kind = 1; S.pm0 = TL / 256; S.nMx = 0;
                pg8::EpiPair<FStoreG1> E{{P, 1.0f / W8_SCALE}};
                pg8::gemm_phase(F.lds, g, S, E);
                if (lastl)
                    for (int q = F.vcu; q < (TC / 128) * 8; q += F.G) pg8::gemm_quarter(F.lds, g, TL / 128 + (q >> 3), KVOFF / 128 + (q & 7), E); }
        }
        SEAM(pb + 0);
        if (EN(4) && IN(pb + 1)) { Frame F = mkframe(lds, wsbase); phase_post(F, layer); }
        SEAM(pb + 1);
        if (EN(5) && IN(pb + 2)) {
            Frame F = mkframe(lds, wsbase); bf16* P = (bf16*)(F.ws + WS_P); bf16* H = (bf16*)(F.ws + WS_H); (void)P; (void)H;
            if (!lastl) {
              pg8::Gemm<1024, 256, 256, 256, 1> g{(const bf16*)(F.ws + WS_POOLED), (const bf16*)(F.ws + WS_WPOOL + (size_t)layer * 1 * MiB)};
              pg8::EpiRow8<FPool> E{{(bf16*)(F.ws + WS_YB), P, inp<I_PSCALE>() + (size_t)layer * DM}};
              for (int q = F.vcu; q < (TC / 128) * (DM / 128); q += F.G) { const int grp = q >> 5, r = q & 31; pg8::gemm_quarter(F.lds, g, TL / 128 + (grp >> 1) * 4 + (r & 3), (grp & 1) * 8 + (r >> 2), E); } }
            phase_attention(F, layer, (char*)lds);
        }
        SEAM(pb + 2);
        if (EN(6) && IN(pb + 3)) {
            Frame F = mkframe(lds, wsbase); bf16* P = (bf16*)(F.ws + WS_P); bf16* H = (bf16*)(F.ws + WS_H); (void)P; (void)H;
            pg8::Gemm<DM, DM, DM, 0, 0, 1> g{F.ws + WS_AO, F.ws + WS_WBR8 + (size_t)layer * 32 * MiB};
            pg8::StaticOrder S; S.init(TL, DM, F.G, F.bx);
            pg8::EpiRow8<FMerge> E{{H, P, (const bf16*)(F.ws + WS_YB), 1.0f / (64.0f * W8_SCALE)}};
            {
                pg8::Gemm<1024, 256, 256, 256, 1> gp{(const bf16*)(F.ws + WS_POOLED), (const bf16*)(F.ws + WS_WPOOL + (size_t)layer * 1 * MiB)};
                pg8::MidRow8<FMid> Mx{{P, inp<I_PSCALE>() + (size_t)layer * DM, 64.0f * W8_SCALE}};
                pg8::EpiRow8<FMergeC> Ec{{H, P, 1.0f / (64.0f * W8_SCALE)}};
                pg8::gemm_chain(F.lds, gp, g, S, Mx, Ec); }
            if (!lastl)
                for (int q = F.vcu; q < (TC / 128) * (DM / 128); q += F.G) { const int grp = q >> 5, r = q & 31; pg8::gemm_quarter(F.lds, g, TL / 128 + (grp >> 1) * 4 + (r & 3), (grp & 1) * 8 + (r >> 2), E); }
        }
        SEAM(pb + 3);
        if (EN(7) && IN(pb + 4)) {
            Frame F = mkframe(lds, wsbase); bf16* P = (bf16*)(F.ws + WS_P); bf16* H = (bf16*)(F.ws + WS_H); (void)P; (void)H;
            pg8::Gemm<DM, DM, DM, 0, 0> g{H, (const bf16*)(F.ws + WS_WOUT + (size_t)layer * 8 * MiB)};
            pg8::StaticOrder S; S.init(TL, DM, F.G, F.bx);
            pg8::EpiRow8<FResid> E{{(bf16*)(F.ws + WS_X), inp<I_X>(), inp<I_CTX>(), (const float*)(F.ws + WS_MOD) + (size_t)layer * 9 * 6 * DM, layer == 0 ? 1 : 0}};
            pg8::gemm_phase(F.lds, g, S, E);
            if (!lastl)
                for (int q = F.vcu; q < (TC / 128) * (DM / 128); q += F.G) { const int grp = q >> 5, r = q & 31; pg8::gemm_quarter(F.lds, g, TL / 128 + (grp >> 1) * 4 + (r & 3), (grp & 1) * 8 + (r >> 2), E); }
        }
        SEAM(pb + 4);
        if (EN(8) && IN(pb + 5)) { Frame F = mkframe(lds, wsbase); phase_modulate(F, layer, 1, MR, false, false); }
        SEAM(pb + 5);
        if (EN(9) && IN(pb + 6)) {
            Frame F = mkframe(lds, wsbase); bf16* P = (bf16*)(F.ws + WS_P); bf16* H = (bf16*)(F.ws + WS_H); (void)P; (void)H;
            pg8::Gemm<DM, DM, DM, 0, 0> g{H, (const bf16*)(F.ws + WS_WQP + (size_t)layer * 8 * MiB)};
            pg8::StaticOrder S; S.init(TL, DM, F.G, F.bx);
            pg8::EpiRow8<FStoreBf16> E{{(bf16*)(F.ws + WS_P + P_QP), DM, 1.0f}};
            pg8::gemm_phase(F.lds, g, S, E);
            if (!lastl)
                for (int q = F.vcu; q < (TC / 128) * (DM / 128); q += F.G) { const int grp = q >> 5, r = q & 31; pg8::gemm_quarter(F.lds, g, TL / 128 + (grp >> 1) * 4 + (r & 3), (grp & 1) * 8 + (r >> 2), E); }
        }
        if (IN(pb + 6) && IN(pb + 8)) xcd_barrier(bar);
        if (EN(11) && IN(pb + 8)) { Frame F = mkframe(lds, wsbase); phase_pk(F, layer, MR); }
        SEAM(pb + 8);
        if (EN(12) && IN(pb + 9)) { Frame F = mkframe(lds, wsbase); phase_peer(F, layer, MR); }
        if (!lastl) SEAM(pb + 9);
    }
#undef IN
#undef SEAM
}

extern "C" void kernel_launch(void* const* d_in, const int* in_sizes, int n_in, void* d_out, int out_size, void* d_ws, size_t ws_size, hipStream_t stream) {
    static int grid = 0;
    if (grid == 0) {
        if (n_in != 18 || out_size != TL * DM || ws_size < WS_END) { fprintf(stderr, "kernel_launch: unexpected shapes (n_in %d out %d ws %zu need %zu)\n", n_in, out_size, ws_size, (size_t)WS_END); grid = -1; return; }
        int dev = 0, cus = 0, per_cu = 0;
        if (hipGetDevice(&dev) != hipSuccess || hipDeviceGetAttribute(&cus, hipDeviceAttributeMultiprocessorCount, dev) != hipSuccess) { grid = -1; return; }
        if (hipFuncSetAttribute((const void*)mk_fwd, hipFuncAttributeMaxDynamicSharedMemorySize, LDS_BYTES) != hipSuccess) { fprintf(stderr, "kernel_launch: hipFuncSetAttribute failed\n"); grid = -1; return; }
        if (hipOccupancyMaxActiveBlocksPerMultiprocessor(&per_cu, (const void*)mk_fwd, NWAVES * 64, LDS_BYTES) != hipSuccess || per_cu < 1)
            fprintf(stderr, "kernel_launch: occupancy query reports %d\n", per_cu);
        (void)hipGetLastError();
        grid = cus;
    }
    if (grid < 0) return;
    if (hipMemsetAsync((char*)d_ws + WS_CTL, 0, CTL_ZERO_BYTES, stream) != hipSuccess) return;
    Args a{};
    for (int i = 0; i < 18; ++i) a.in[i] = (const float*)d_in[i];
    a.out = (float*)d_out; a.ws = (unsigned char*)d_ws;
#if MK_PER_PHASE
    for (int p = 0; p < N_PHASES; ++p) { a.ph_lo = p; a.ph_hi = p + 1; hipLaunchKernelGGL(mk_fwd, dim3(grid), dim3(NWAVES * 64), LDS_BYTES, stream, a); }
#else
    a.ph_lo = 0; a.ph_hi = N_PHASES;
    hipLaunchKernelGGL(mk_fwd, dim3(grid), dim3(NWAVES * 64), LDS_BYTES, stream, a);
#endif
    const hipError_t le = hipPeekAtLastError();
    if (le != hipSuccess) fprintf(stderr, "kernel_launch: launch failed: %s\n", hipGetErrorName(le));
}
```

```cpp
#include <hip/hip_runtime.h>
#include <cstdio>
#include <cstdint>

#ifndef MK_PER_PHASE
#define MK_PER_PHASE 0
#endif

namespace pg8 {
#define PG8_LAS __attribute__((address_space(3)))
typedef unsigned short bf16_t;
typedef short bf16x8 __attribute__((ext_vector_type(8)));
typedef float f32x4 __attribute__((ext_vector_type(4)));
typedef unsigned u32x4 __attribute__((ext_vector_type(4)));
constexpr int BM = 256, BK = 64, HALF = 128, HTB = HALF * BK * 2, STAGE_BYTES = 8 * HTB, NXCD = 8, WGM = 8;

__host__ __device__ __forceinline__ int lds_byte(int r, int c) { const int st = (r >> 4) * 2 + (c >> 5), rr = r & 15, cc = c & 31, ob = rr * 64 + cc * 2; return st * 1024 + (ob ^ (((ob >> 9) & 1) << 5)); }
__host__ __device__ __forceinline__ void stage_rc(int b, int& R, int& C) { const int st = b / 1024, sb = b % 1024, swz = sb ^ (((sb >> 9) & 1) << 5); R = (st >> 1) * 16 + swz / 64; C = (st & 1) * 32 + (swz % 64) / 2; }
__host__ __device__ __forceinline__ int perm32(int rho) { const int n = rho >> 4, i = rho & 15; return 8 * (i >> 2) + 4 * n + (i & 3); }

struct Unit { int pm, pn; };
template <int LDA, int LDB, int KK, int AKSTEP, int AKSHIFT, int EB_ = 2> struct Gemm { const void* A; const void* Bt;
    static constexpr int lda = LDA, ldb = LDB, K = KK, akstep = AKSTEP, akshift = AKSHIFT, EB = EB_; };

struct StaticOrder {
    int nM, nN, nwg, G, c;
    __device__ void init(int M, int N, int G_, int c_) { nM = M / BM; nN = N / BM; nwg = nM * nN; G = G_; c = c_; }
    __device__ bool next(int i, Unit& u) const {
        const long L = (long)i * G + c; if (L >= nwg) return false;
        int wgid = (int)L; { const int q = nwg / NXCD, r = nwg % NXCD, xcd = wgid % NXCD, off = wgid / NXCD; wgid = (xcd < r ? xcd * (q + 1) : r * (q + 1) + (xcd - r) * q) + off; }
        const int nig = WGM * nN, gid = wgid / nig, fm = gid * WGM, gsz = (nM - fm) < WGM ? (nM - fm) : WGM;
        u.pm = fm + ((wgid % nig) % gsz); u.pn = (wgid % nig) / gsz; return true;
    }
};
struct SplitOrder {
    StaticOrder S; int kind, pm0, nMx;
    __device__ bool next(int i, Unit& u) const {
        const long L = (long)i * S.G + S.c;
        if (L < S.nwg) { S.next(i, u); u.pn = kind == 0 ? 12 + u.pn : (u.pn < 12 ? u.pn : u.pn + 4); return true; }
        const int j = (int)(L - S.nwg); if (j >= nMx * 4) return false;
        u.pm = pm0 + j / 4; u.pn = 8 + j % 4; return true;
    }
};

template <class F> struct EpiRow8 {
    static constexpr bool PERM = true;
    F f;
    __device__ __forceinline__ void operator()(const f32x4 (&acc)[2][2][4][2], const Unit& u, int wr, int wc, int fr, int fq) const {
        const int row0 = u.pm * BM + wr * 64 + fr, col0 = u.pn * BM + wc * 32 + 8 * fq;
        typename F::Col cp[2];
#pragma unroll
        for (int bj = 0; bj < 2; ++bj) cp[bj] = f.col_load(row0, col0 + bj * HALF);
#pragma unroll
        for (int ai = 0; ai < 2; ++ai) {
            typename F::Pre pre[4][2];
#pragma unroll
            for (int m = 0; m < 4; ++m)
#pragma unroll
                for (int bj = 0; bj < 2; ++bj) pre[m][bj] = f.load(row0 + ai * HALF + m * 16, col0 + bj * HALF);
#pragma unroll
            for (int m = 0; m < 4; ++m)
#pragma unroll
                for (int bj = 0; bj < 2; ++bj) f.apply(row0 + ai * HALF + m * 16, col0 + bj * HALF, acc[ai][bj][m][0], acc[ai][bj][m][1], pre[m][bj], cp[bj]);
            asm volatile("" ::: "memory");
        }
    }
    __device__ __forceinline__ void quarter(const f32x4 (&acc)[1][1][4][2], int rowo, int colo, int wr, int wc, int fr, int fq) const {
        const int row0 = rowo + wr * 64 + fr, col0 = colo + wc * 32 + 8 * fq;
        const typename F::Col cp = f.col_load(row0, col0);
        typename F::Pre pre[4];
#pragma unroll
        for (int m = 0; m < 4; ++m) pre[m] = f.load(row0 + m * 16, col0);
#pragma unroll
        for (int m = 0; m < 4; ++m) f.apply(row0 + m * 16, col0, acc[0][0][m][0], acc[0][0][m][1], pre[m], cp);
    }
};

template <class F> struct EpiPair {
    static constexpr bool PERM = true;
    F f;
    __device__ __forceinline__ void operator()(const f32x4 (&acc)[2][2][4][2], const Unit& u, int wr, int wc, int fr, int fq) const {
        const int row0 = u.pm * BM + wr * 64 + fr, col0 = u.pn * BM + wc * 32 + 8 * fq;
#pragma unroll
        for (int ai = 0; ai < 2; ++ai)
#pragma unroll
            for (int m = 0; m < 4; ++m) f.apply2(row0 + ai * HALF + m * 16, col0, acc[ai][0][m][0], acc[ai][0][m][1], acc[ai][1][m][0], acc[ai][1][m][1]);
    }
    __device__ __forceinline__ void quarter(const f32x4 (&acc)[1][1][4][2], int rowo, int colo, int wr, int wc, int fr, int fq) const {
        const int row0 = rowo + wr * 64 + fr, col0 = colo + wc * 32 + 8 * fq;
#pragma unroll
        for (int m = 0; m < 4; ++m) f.apply(row0 + m * 16, col0, acc[0][0][m][0], acc[0][0][m][1]);
    }
};
template <class F> struct MidRow8 {
    F f;
    __device__ __forceinline__ void operator()(f32x4 (&acc)[2][2][4][2], const Unit& u, int wr, int wc, int fr, int fq) const {
        const int row0 = u.pm * BM + wr * 64 + fr, col0 = u.pn * BM + wc * 32 + 8 * fq;
        typename F::Col cp[2];
#pragma unroll
        for (int bj = 0; bj < 2; ++bj) cp[bj] = f.col_load(row0, col0 + bj * HALF);
#pragma unroll
        for (int ai = 0; ai < 2; ++ai) {
            typename F::Pre pre[4][2];
#pragma unroll
            for (int m = 0; m < 4; ++m)
#pragma unroll
                for (int bj = 0; bj < 2; ++bj) pre[m][bj] = f.load(row0 + ai * HALF + m * 16, col0 + bj * HALF);
#pragma unroll
            for (int m = 0; m < 4; ++m)
#pragma unroll
                for (int bj = 0; bj < 2; ++bj) f.xform(acc[ai][bj][m][0], acc[ai][bj][m][1], pre[m][bj], cp[bj]);
            asm volatile("" ::: "memory");
        }
    }
};
struct BlockOrder {
    int pm0, nM, nN, G, c;
    __device__ bool next(int i, Unit& u) const { const long k = (long)i * G + c; if (k >= (long)nM * nN) return false; u.pm = pm0 + (int)(k / nN); u.pn = (int)(k % nN); return true; }
};

template <class GemmT, class Epi, class Sched>
__device__ __forceinline__ void gemm_phase(PG8_LAS unsigned char* lds, const GemmT g, const Sched& S, const Epi& E) {
    int tid_ = threadIdx.x; asm volatile("" : "+v"(tid_));
    const int tid = tid_, wid = __builtin_amdgcn_readfirstlane(tid >> 6), lane = tid & 63, wr = wid >> 2, wc = wid & 3, fr = lane & 15, fq = lane >> 4;
    constexpr int K = GemmT::K, EB = GemmT::EB, nt = K * EB / 128;
    typedef int v8i __attribute__((ext_vector_type(8))); typedef int v4i __attribute__((ext_vector_type(4)));
    unsigned voffA[2], voffB[2];
#pragma unroll
    for (int i = 0; i < 2; ++i) { int R, C; stage_rc(tid * 16 + i * 8192, R, C); const int Rb = Epi::PERM ? ((R & ~31) + perm32(R & 31)) : R;
        voffA[i] = (unsigned)(R * GemmT::lda * EB + C * 2); voffB[i] = (unsigned)(Rb * GemmT::ldb * EB + C * 2); }
    constexpr size_t kstep = (size_t)(BK * 2);
    constexpr size_t hstepA = (size_t)HALF * GemmT::lda * EB, hstepB = (size_t)HALF * GemmT::ldb * EB;
    constexpr size_t tstepA = 2 * hstepA, tstepB = 2 * hstepB;
    constexpr size_t akb = (size_t)GemmT::akstep * EB;
    const unsigned ldsw = (unsigned)wid * 1024u;
    const int aoff0 = lds_byte(wr * 64 + fr, EB == 2 ? fq * 8 : fq * 16) + (EB == 2 ? 0 : 16 * (fq & 1)), boff0 = lds_byte(wc * 32 + fr, EB == 2 ? fq * 8 : fq * 16) + (EB == 2 ? 0 : 16 * (fq & 1));
    const int aoff1 = EB == 2 ? aoff0 + 1024 : (aoff0 ^ 16), boff1 = EB == 2 ? boff0 + 1024 : (boff0 ^ 16);
#define PG8_SA(b, h) (((b) * 2 + (h)) * HTB)
#define PG8_SB(b, h) ((4 + (b) * 2 + (h)) * HTB)
#define PG8_STAGE(bufoff, gbase, voff) do { _Pragma("unroll") for (int _i = 0; _i < 2; ++_i) \
        __builtin_amdgcn_global_load_lds((const unsigned*)((const char*)(gbase) + (voff)[_i]), (PG8_LAS unsigned*)(lds + (bufoff) + ldsw + _i * 8192), 16, 0, 0); } while (0)
#define PG8_LDA(dst, b, h) do { _Pragma("unroll") for (int m = 0; m < 4; ++m) { const v4i l_ = *(const PG8_LAS v4i*)(lds + PG8_SA(b, h) + aoff0 + m * 2048), h_ = *(const PG8_LAS v4i*)(lds + PG8_SA(b, h) + aoff1 + m * 2048); dst[m] = __builtin_shufflevector(l_, h_, 0, 1, 2, 3, 4, 5, 6, 7); } } while (0)
#define PG8_LDB(dst, b, h) do { _Pragma("unroll") for (int n = 0; n < 2; ++n) { const v4i l_ = *(const PG8_LAS v4i*)(lds + PG8_SB(b, h) + boff0 + n * 2048), h_ = *(const PG8_LAS v4i*)(lds + PG8_SB(b, h) + boff1 + n * 2048); dst[n] = __builtin_shufflevector(l_, h_, 0, 1, 2, 3, 4, 5, 6, 7); } } while (0)
#define PG8_LO(v) __builtin_bit_cast(bf16x8, __builtin_shufflevector(v, v, 0, 1, 2, 3))
#define PG8_HI(v) __builtin_bit_cast(bf16x8, __builtin_shufflevector(v, v, 4, 5, 6, 7))
#define PG8_MMA(ai, bj, At, Bt) do { __builtin_amdgcn_s_setprio(1); _Pragma("unroll") for (int m = 0; m < 4; ++m) _Pragma("unroll") for (int n = 0; n < 2; ++n) { \
        if constexpr (EB == 2) { acc[ai][bj][m][n] = __builtin_amdgcn_mfma_f32_16x16x32_bf16(PG8_LO(Bt[n]), PG8_LO(At[m]), acc[ai][bj][m][n], 0, 0, 0); \
                                 acc[ai][bj][m][n] = __builtin_amdgcn_mfma_f32_16x16x32_bf16(PG8_HI(Bt[n]), PG8_HI(At[m]), acc[ai][bj][m][n], 0, 0, 0); } \
        else asm volatile("v_mfma_f32_16x16x128_f8f6f4 %0, %1, %2, %0" : "+v"(acc[ai][bj][m][n]) : "v"(Bt[n]), "v"(At[m])); } __builtin_amdgcn_s_setprio(0); } while (0)
#define PG8_WAIT_V(n) asm volatile("s_waitcnt vmcnt(" #n ")" ::: "memory")
#define PG8_WAIT_L(n) asm volatile("s_waitcnt lgkmcnt(" #n ")" ::: "memory")
#define PG8_BAR __builtin_amdgcn_s_barrier()
#define PG8_SCHED __builtin_amdgcn_sched_barrier(0)
    Unit cur, nxt; int ui = 0;
    if (!S.next(0, cur)) return;
    f32x4 acc[2][2][4][2];
#pragma unroll
    for (int a = 0; a < 2; ++a)
#pragma unroll
        for (int b = 0; b < 2; ++b)
#pragma unroll
            for (int m = 0; m < 4; ++m)
#pragma unroll
                for (int n = 0; n < 2; ++n) acc[a][b][m][n] = (f32x4){0.f, 0.f, 0.f, 0.f};
    v8i At[4], B0[2], B1[2];
    const char* cA = (const char*)g.A + (size_t)cur.pm * tstepA + (size_t)(cur.pn >> GemmT::akshift) * akb; const char* cB = (const char*)g.Bt + (size_t)cur.pn * tstepB;
    PG8_STAGE(PG8_SB(0, 0), cB, voffB); PG8_STAGE(PG8_SB(0, 1), cB + hstepB, voffB); PG8_STAGE(PG8_SA(0, 0), cA, voffA); PG8_STAGE(PG8_SA(0, 1), cA + hstepA, voffA);
    if (wr == 1) PG8_BAR;
    PG8_WAIT_V(2); PG8_BAR;
    PG8_STAGE(PG8_SB(1, 0), cB + kstep, voffB); PG8_STAGE(PG8_SA(1, 0), cA + kstep, voffA); PG8_STAGE(PG8_SB(1, 1), cB + hstepB + kstep, voffB);
    PG8_WAIT_V(6); PG8_BAR;
    for (;;) {
        const bool has_next = S.next(ui + 1, nxt);
        const char* nA = has_next ? (const char*)g.A + (size_t)nxt.pm * tstepA + (size_t)(nxt.pn >> GemmT::akshift) * akb : cA; const char* nB = has_next ? (const char*)g.Bt + (size_t)nxt.pn * tstepB : cB;
#pragma unroll 1
        for (int t = 0; t < nt; t += 2) {
            const bool last = (t == nt - 2);
            const char* a1 = cA + (size_t)(t + 1) * kstep;
            const char* a2 = last ? nA : cA + (size_t)(t + 2) * kstep; const char* b2 = last ? nB : cB + (size_t)(t + 2) * kstep;
            const char* a3 = a2 + kstep; const char* b3 = b2 + kstep;
            PG8_LDB(B0, 0, 0); PG8_LDB(B1, 0, 1); PG8_SCHED; PG8_LDA(At, 0, 0); PG8_STAGE(PG8_SA(1, 1), a1 + hstepA, voffA);
            PG8_WAIT_V(8); PG8_WAIT_L(0); PG8_BAR; PG8_MMA(0, 0, At, B0); PG8_MMA(0, 1, At, B1); PG8_BAR; PG8_SCHED;
            PG8_LDA(At, 0, 1); PG8_STAGE(PG8_SB(0, 0), b2, voffB); PG8_STAGE(PG8_SB(0, 1), b2 + hstepB, voffB); PG8_STAGE(PG8_SA(0, 0), a2, voffA);
            PG8_WAIT_V(8); PG8_WAIT_L(0); PG8_BAR; PG8_MMA(1, 0, At, B0); PG8_MMA(1, 1, At, B1); PG8_BAR; PG8_SCHED;
            PG8_LDB(B0, 1, 0); PG8_LDB(B1, 1, 1); PG8_SCHED; PG8_LDA(At, 1, 0); PG8_STAGE(PG8_SA(0, 1), a2 + hstepA, voffA);
            PG8_WAIT_V(8); PG8_WAIT_L(0); PG8_BAR; PG8_MMA(0, 0, At, B0); PG8_MMA(0, 1, At, B1); PG8_BAR; PG8_SCHED;
            PG8_LDA(At, 1, 1); PG8_STAGE(PG8_SB(1, 0), b3, voffB); PG8_STAGE(PG8_SB(1, 1), b3 + hstepB, voffB); PG8_STAGE(PG8_SA(1, 0), a3, voffA);
            PG8_WAIT_V(8); PG8_WAIT_L(0); PG8_BAR; PG8_MMA(1, 0, At, B0); PG8_MMA(1, 1, At, B1); PG8_BAR; PG8_SCHED;
        }
        if (wr == 0) PG8_BAR;
        if constexpr (EB == 1) asm volatile("s_nop 15\n\ts_nop 15" ::: "memory");
        E(acc, cur, wr, wc, fr, fq);
        if (!has_next) break;
#pragma unroll
        for (int a = 0; a < 2; ++a)
#pragma unroll
            for (int b = 0; b < 2; ++b)
#pragma unroll
                for (int m = 0; m < 4; ++m)
#pragma unroll
                    for (int n = 0; n < 2; ++n) acc[a][b][m][n] = (f32x4){0.f, 0.f, 0.f, 0.f};
        cur = nxt; cA = nA; cB = nB; ++ui;
        if (wr == 1) PG8_BAR;
    }
    PG8_WAIT_V(0);
    PG8_BAR;
}
template <class GP, class GM, class Mid, class Epi, class Sched>
__device__ __forceinline__ void gemm_chain(PG8_LAS unsigned char* lds, const GP gp, const GM gm, const Sched& S, const Mid& M, const Epi& E) {
    static_assert(GP::EB == 2 && GM::EB == 1 && GP::lda * 2 == GM::lda, "chain: bf16 prefix, fp8 main, equal A row strides in bytes");
    int tid_ = threadIdx.x; asm volatile("" : "+v"(tid_));
    const int tid = tid_, wid = __builtin_amdgcn_readfirstlane(tid >> 6), lane = tid & 63, wr = wid >> 2, wc = wid & 3, fr = lane & 15, fq = lane >> 4;
    constexpr int ntp = GP::K * 2 / 128, ntm = GM::K / 128;
    static_assert(ntp == 4 && ntm % 2 == 0, "chain: prefix of two trips");
    typedef int v8i __attribute__((ext_vector_type(8))); typedef int v4i __attribute__((ext_vector_type(4)));
    unsigned voffA[2], voffBp[2], voffBm[2];
#pragma unroll
    for (int i = 0; i < 2; ++i) { int R, C; stage_rc(tid * 16 + i * 8192, R, C); const int Rb = (R & ~31) + perm32(R & 31);
        voffA[i] = (unsigned)(R * GM::lda + C * 2); voffBp[i] = (unsigned)(Rb * GP::ldb * 2 + C * 2); voffBm[i] = (unsigned)(Rb * GM::ldb + C * 2); }
    constexpr size_t kstep = (size_t)(BK * 2);
    constexpr size_t hstepA = (size_t)HALF * GM::lda, hstepBp = (size_t)HALF * GP::ldb * 2, hstepBm = (size_t)HALF * GM::ldb;
    constexpr size_t tstepA = 2 * hstepA, tstepBp = 2 * hstepBp, tstepBm = 2 * hstepBm;
    constexpr size_t akbp = (size_t)GP::akstep * 2;
    const unsigned ldsw = (unsigned)wid * 1024u;
#define PC_OFFS_P() int lq_ = tid; asm volatile("" : "+v"(lq_)); const int frq_ = lq_ & 15, fqq_ = (lq_ >> 4) & 3; \
    const int aoffP0 = lds_byte(wr * 64 + frq_, fqq_ * 8), boffP0 = lds_byte(wc * 32 + frq_, fqq_ * 8), aoffP1 = aoffP0 + 1024, boffP1 = boffP0 + 1024
#define PC_OFFS_M() int lm_ = tid; asm volatile("" : "+v"(lm_)); const int frm_ = lm_ & 15, fqm_ = (lm_ >> 4) & 3; \
    const int aoffM0 = lds_byte(wr * 64 + frm_, fqm_ * 16) + 16 * (fqm_ & 1), boffM0 = lds_byte(wc * 32 + frm_, fqm_ * 16) + 16 * (fqm_ & 1), aoffM1 = aoffM0 ^ 16, boffM1 = boffM0 ^ 16
#define PC_LDA(dst, b, h, o0, o1) do { _Pragma("unroll") for (int m = 0; m < 4; ++m) { const v4i l_ = *(const PG8_LAS v4i*)(lds + PG8_SA(b, h) + (o0) + m * 2048), h_ = *(const PG8_LAS v4i*)(lds + PG8_SA(b, h) + (o1) + m * 2048); dst[m] = __builtin_shufflevector(l_, h_, 0, 1, 2, 3, 4, 5, 6, 7); } } while (0)
#define PC_LDB(dst, b, h, o0, o1) do { _Pragma("unroll") for (int n = 0; n < 2; ++n) { const v4i l_ = *(const PG8_LAS v4i*)(lds + PG8_SB(b, h) + (o0) + n * 2048), h_ = *(const PG8_LAS v4i*)(lds + PG8_SB(b, h) + (o1) + n * 2048); dst[n] = __builtin_shufflevector(l_, h_, 0, 1, 2, 3, 4, 5, 6, 7); } } while (0)
#define PC_MMA(EBv, ai, bj, At, Bt) do { __builtin_amdgcn_s_setprio(1); _Pragma("unroll") for (int m = 0; m < 4; ++m) _Pragma("unroll") for (int n = 0; n < 2; ++n) { \
        if constexpr (EBv == 2) { acc[ai][bj][m][n] = __builtin_amdgcn_mfma_f32_16x16x32_bf16(PG8_LO(Bt[n]), PG8_LO(At[m]), acc[ai][bj][m][n], 0, 0, 0); \
                                  acc[ai][bj][m][n] = __builtin_amdgcn_mfma_f32_16x16x32_bf16(PG8_HI(Bt[n]), PG8_HI(At[m]), acc[ai][bj][m][n], 0, 0, 0); } \
        else asm volatile("v_mfma_f32_16x16x128_f8f6f4 %0, %1, %2, %0" : "+v"(acc[ai][bj][m][n]) : "v"(Bt[n]), "v"(At[m])); } __builtin_amdgcn_s_setprio(0); } while (0)
#define PC_TRIP(EBv, A0, A1, B0o, B1o, a1_, a2_, b2_, voffBn, hstepBn) do { const char* a3_ = (a2_) + kstep; const char* b3_ = (b2_) + kstep; \
        PC_LDB(B0, 0, 0, B0o, B1o); PC_LDB(B1, 0, 1, B0o, B1o); PG8_SCHED; PC_LDA(At, 0, 0, A0, A1); PG8_STAGE(PG8_SA(1, 1), (a1_) + hstepA, voffA); \
        PG8_WAIT_V(8); PG8_WAIT_L(0); PG8_BAR; PC_MMA(EBv, 0, 0, At, B0); PC_MMA(EBv, 0, 1, At, B1); PG8_BAR; PG8_SCHED; \
        PC_LDA(At, 0, 1, A0, A1); PG8_STAGE(PG8_SB(0, 0), (b2_), voffBn); PG8_STAGE(PG8_SB(0, 1), (b2_) + (hstepBn), voffBn); PG8_STAGE(PG8_SA(0, 0), (a2_), voffA); \
        PG8_WAIT_V(8); PG8_WAIT_L(0); PG8_BAR; PC_MMA(EBv, 1, 0, At, B0); PC_MMA(EBv, 1, 1, At, B1); PG8_BAR; PG8_SCHED; \
        PC_LDB(B0, 1, 0, B0o, B1o); PC_LDB(B1, 1, 1, B0o, B1o); PG8_SCHED; PC_LDA(At, 1, 0, A0, A1); PG8_STAGE(PG8_SA(0, 1), (a2_) + hstepA, voffA); \
        PG8_WAIT_V(8); PG8_WAIT_L(0); PG8_BAR; PC_MMA(EBv, 0, 0, At, B0); PC_MMA(EBv, 0, 1, At, B1); PG8_BAR; PG8_SCHED; \
        PC_LDA(At, 1, 1, A0, A1); PG8_STAGE(PG8_SB(1, 0), b3_, voffBn); PG8_STAGE(PG8_SB(1, 1), b3_ + (hstepBn), voffBn); PG8_STAGE(PG8_SA(1, 0), a3_, voffA); \
        PG8_WAIT_V(8); PG8_WAIT_L(0); PG8_BAR; PC_MMA(EBv, 1, 0, At, B0); PC_MMA(EBv, 1, 1, At, B1); PG8_BAR; PG8_SCHED; } while (0)
    Unit cur, nxt; int ui = 0;
    if (!S.next(0, cur)) return;
    f32x4 acc[2][2][4][2];
#pragma unroll
    for (int a = 0; a < 2; ++a)
#pragma unroll
        for (int b = 0; b < 2; ++b)
#pragma unroll
            for (int m = 0; m < 4; ++m)
#pragma unroll
                for (int n = 0; n < 2; ++n) acc[a][b][m][n] = (f32x4){0.f, 0.f, 0.f, 0.f};
    v8i At[4], B0[2], B1[2];
    const char* cAp = (const char*)gp.A + (size_t)cur.pm * tstepA + (size_t)(cur.pn >> GP::akshift) * akbp; const char* cBp = (const char*)gp.Bt + (size_t)cur.pn * tstepBp;
    PG8_STAGE(PG8_SB(0, 0), cBp, voffBp); PG8_STAGE(PG8_SB(0, 1), cBp + hstepBp, voffBp); PG8_STAGE(PG8_SA(0, 0), cAp, voffA); PG8_STAGE(PG8_SA(0, 1), cAp + hstepA, voffA);
    if (wr == 1) PG8_BAR;
    PG8_WAIT_V(2); PG8_BAR;
    PG8_STAGE(PG8_SB(1, 0), cBp + kstep, voffBp); PG8_STAGE(PG8_SA(1, 0), cAp + kstep, voffA); PG8_STAGE(PG8_SB(1, 1), cBp + hstepBp + kstep, voffBp);
    PG8_WAIT_V(6); PG8_BAR;
    for (;;) {
        const bool has_next = S.next(ui + 1, nxt);
        const char* nAp = has_next ? (const char*)gp.A + (size_t)nxt.pm * tstepA + (size_t)(nxt.pn >> GP::akshift) * akbp : cAp; const char* nBp = has_next ? (const char*)gp.Bt + (size_t)nxt.pn * tstepBp : cBp;
        const char* cAm = (const char*)gm.A + (size_t)cur.pm * tstepA; const char* cBm = (const char*)gm.Bt + (size_t)cur.pn * tstepBm;
        {   PC_OFFS_P();
#pragma unroll 1
            for (int t = 0; t < ntp; t += 2) {
                const bool last = (t == ntp - 2);
                unsigned voffBn[2]; voffBn[0] = last ? voffBm[0] : voffBp[0]; voffBn[1] = last ? voffBm[1] : voffBp[1];
                const size_t hstepBn = last ? hstepBm : hstepBp;
                const char* a2 = last ? cAm : cAp + (size_t)(t + 2) * kstep; const char* b2 = last ? cBm : cBp + (size_t)(t + 2) * kstep;
                PC_TRIP(2, aoffP0, aoffP1, boffP0, boffP1, cAp + (size_t)(t + 1) * kstep, a2, b2, voffBn, hstepBn);
            } }
        M(acc, cur, wr, wc, fr, fq);
        PC_OFFS_M();
#pragma unroll 1
        for (int t = 0; t < ntm; t += 2) {
            const bool last = (t == ntm - 2);
            unsigned voffBn[2]; voffBn[0] = last ? voffBp[0] : voffBm[0]; voffBn[1] = last ? voffBp[1] : voffBm[1];
            const size_t hstepBn = last ? hstepBp : hstepBm;
            const char* a2 = last ? nAp : cAm + (size_t)(t + 2) * kstep; const char* b2 = last ? nBp : cBm + (size_t)(t + 2) * kstep;
            PC_TRIP(1, aoffM0, aoffM1, boffM0, boffM1, cAm + (size_t)(t + 1) * kstep, a2, b2, voffBn, hstepBn);
        }
        if (wr == 0) PG8_BAR;
        asm volatile("s_nop 15\n\ts_nop 15" ::: "memory");
        {   Unit cue = cur; asm volatile("" : "+s"(cue.pm), "+s"(cue.pn));
            E(acc, cue, wr, wc, fr, fq); }
        if (!has_next) break;
#pragma unroll
        for (int a = 0; a < 2; ++a)
#pragma unroll
            for (int b = 0; b < 2; ++b)
#pragma unroll
                for (int m = 0; m < 4; ++m)
#pragma unroll
                    for (int n = 0; n < 2; ++n) acc[a][b][m][n] = (f32x4){0.f, 0.f, 0.f, 0.f};
        cur = nxt; cAp = nAp; cBp = nBp; ++ui;
        if (wr == 1) PG8_BAR;
    }
    PG8_WAIT_V(0);
    PG8_BAR;
#undef PC_LDA
#undef PC_LDB
#undef PC_MMA
#undef PC_TRIP
#undef PC_OFFS_P
#undef PC_OFFS_M
}
template <class GemmT, class Epi>
__device__ __forceinline__ void gemm_quarter(PG8_LAS unsigned char* lds, const GemmT g, int qm, int qn, const Epi& E) {
    int tid_ = threadIdx.x; asm volatile("" : "+v"(tid_));
    const int tid = tid_, wid = __builtin_amdgcn_readfirstlane(tid >> 6), lane = tid & 63, wr = wid >> 2, wc = wid & 3, fr = lane & 15, fq = lane >> 4;
    constexpr int K = GemmT::K, EB = GemmT::EB, nt = K * EB / 128;
    static_assert(nt % 4 == 0 && nt >= 4, "quarter unit: K-tiles in groups of four");
    typedef int v8i __attribute__((ext_vector_type(8))); typedef int v4i __attribute__((ext_vector_type(4)));
    unsigned voffA[2], voffB[2];
#pragma unroll
    for (int i = 0; i < 2; ++i) { int R, C; stage_rc(tid * 16 + i * 8192, R, C); const int Rb = Epi::PERM ? ((R & ~31) + perm32(R & 31)) : R;
        voffA[i] = (unsigned)(R * GemmT::lda * EB + C * 2); voffB[i] = (unsigned)(Rb * GemmT::ldb * EB + C * 2); }
    constexpr size_t kstep = (size_t)(BK * 2);
    constexpr size_t hstepA = (size_t)HALF * GemmT::lda * EB, hstepB = (size_t)HALF * GemmT::ldb * EB;
    const unsigned ldsw = (unsigned)wid * 1024u;
    const int aoff0 = lds_byte(wr * 64 + fr, EB == 2 ? fq * 8 : fq * 16) + (EB == 2 ? 0 : 16 * (fq & 1)), boff0 = lds_byte(wc * 32 + fr, EB == 2 ? fq * 8 : fq * 16) + (EB == 2 ? 0 : 16 * (fq & 1));
    const int aoff1 = EB == 2 ? aoff0 + 1024 : (aoff0 ^ 16), boff1 = EB == 2 ? boff0 + 1024 : (boff0 ^ 16);
    const char* cA = (const char*)g.A + (size_t)qm * hstepA + (size_t)((qn >> 1) >> GemmT::akshift) * GemmT::akstep * EB; const char* cB = (const char*)g.Bt + (size_t)qn * hstepB;
    f32x4 acc[1][1][4][2];
#pragma unroll
    for (int m = 0; m < 4; ++m)
#pragma unroll
        for (int n = 0; n < 2; ++n) acc[0][0][m][n] = (f32x4){0.f, 0.f, 0.f, 0.f};
    v8i At[4], B0[2];
#define PG8Q_LDA(dst, s) do { _Pragma("unroll") for (int m = 0; m < 4; ++m) { const v4i l_ = *(const PG8_LAS v4i*)(lds + (s) * HTB + aoff0 + m * 2048), h_ = *(const PG8_LAS v4i*)(lds + (s) * HTB + aoff1 + m * 2048); dst[m] = __builtin_shufflevector(l_, h_, 0, 1, 2, 3, 4, 5, 6, 7); } } while (0)
#define PG8Q_LDB(dst, s) do { _Pragma("unroll") for (int n = 0; n < 2; ++n) { const v4i l_ = *(const PG8_LAS v4i*)(lds + (4 + (s)) * HTB + boff0 + n * 2048), h_ = *(const PG8_LAS v4i*)(lds + (4 + (s)) * HTB + boff1 + n * 2048); dst[n] = __builtin_shufflevector(l_, h_, 0, 1, 2, 3, 4, 5, 6, 7); } } while (0)
#pragma unroll
    for (int s = 0; s < 3; ++s) { PG8_STAGE(s * HTB, cA + (size_t)s * kstep, voffA); PG8_STAGE((4 + s) * HTB, cB + (size_t)s * kstep, voffB); }
#pragma unroll 1
    for (int t = 0; t < nt; t += 4) {
#pragma unroll
        for (int s = 0; s < 4; ++s) {
            PG8_WAIT_V(8); PG8_BAR;
            const int nx = (t + s + 3 < nt) ? (t + s + 3) : (nt - 1);
            PG8_STAGE(((s + 3) & 3) * HTB, cA + (size_t)nx * kstep, voffA); PG8_STAGE((4 + ((s + 3) & 3)) * HTB, cB + (size_t)nx * kstep, voffB);
            PG8Q_LDB(B0, s); PG8Q_LDA(At, s);
            PG8_WAIT_L(0); PG8_SCHED; PG8_MMA(0, 0, At, B0); PG8_SCHED;
        }
    }
    if constexpr (EB == 1) asm volatile("s_nop 15\n\ts_nop 15" ::: "memory");
    E.quarter(acc, qm * HALF, qn * HALF, wr, wc, fr, fq);
    PG8_WAIT_V(0);
    PG8_BAR;
#undef PG8Q_LDA
#undef PG8Q_LDB
#undef PG8_SA
#undef PG8_SB
#undef PG8_STAGE
#undef PG8_LDA
#undef PG8_LDB
#undef PG8_MMA
#undef PG8_LO
#undef PG8_HI
#undef PG8_WAIT_V
#undef PG8_WAIT_L
#undef PG8_BAR
#undef PG8_SCHED
}
}

constexpr int DM = 2048, NB = 8, SEQ = 2048, CTXL = 256, NLAYER = 2;
constexpr int TL = NB * SEQ, TC = NB * CTXL, TT = TL + TC;
constexpr int INW = 8192, KVOFF = 2048, VOFF = 2560, POOLOFF = 3072, GAOFF = 4096, GBOFF = 6144;
constexpr int NEXP = 16384, NSEL = 128;
constexpr float EPS = 1e-6f;
constexpr int NWAVES = 8;

constexpr size_t MiB = 1u << 20;
constexpr size_t WS_CTL = 0, CTL_ZERO_BYTES = 1 * MiB;
constexpr size_t WS_MOD = 1 * MiB;
constexpr size_t WS_MODP = 2 * MiB;
constexpr size_t WS_ROPE = 9 * MiB;
constexpr size_t WS_WIN = 10 * MiB;
constexpr size_t WS_WOUT = 90 * MiB;
constexpr size_t WS_WQP = 106 * MiB;
constexpr size_t WS_WPOOL = 122 * MiB;
constexpr size_t WS_KEYS = 124 * MiB;
constexpr size_t WS_PU = 126 * MiB;
constexpr size_t WS_PV = 190 * MiB;
constexpr size_t WS_SCU = 254 * MiB;
constexpr size_t WS_SCV = 255 * MiB;
constexpr size_t WS_X = 382 * MiB;
constexpr size_t WS_H = 526 * MiB;
constexpr size_t WS_P = 598 * MiB;
constexpr size_t WS_AO = 886 * MiB;
constexpr size_t WS_H8 = 922 * MiB;
constexpr size_t WS_WIN8 = WS_PU + 16 * MiB;
constexpr size_t WS_WBR8 = WS_PV + 16 * MiB;
constexpr size_t WS_POOLED = 958 * MiB;
constexpr size_t WS_YB = 994 * MiB;
constexpr size_t WS_END = 1066 * MiB;
constexpr size_t P_QP = 0, P_IDX = 216 * MiB, P_GW = 225 * MiB;

constexpr int CW_TMO = 0;
constexpr int CW_BAR = 4096;

constexpr int RING_BYTES = 131072;
constexpr int LDSCTL_OFF = RING_BYTES, MISC_OFF = LDSCTL_OFF + 320;
constexpr int LDS_BYTES = 147456;

#define GAS __attribute__((address_space(1)))
#define LAS __attribute__((address_space(3)))
typedef unsigned short bf16;
typedef unsigned v4u __attribute__((ext_vector_type(4)));
typedef unsigned v2u __attribute__((ext_vector_type(2)));
typedef float f32x4 __attribute__((ext_vector_type(4)));
typedef short bf16x8 __attribute__((ext_vector_type(8)));
typedef GAS unsigned gu32;
#define RLX_AGENT __ATOMIC_RELAXED, __HIP_MEMORY_SCOPE_AGENT
#define LDS_WAIT() asm volatile("s_waitcnt lgkmcnt(0)" ::: "memory")
#define VM_WAIT() asm volatile("s_waitcnt vmcnt(0)" ::: "memory")
__device__ __forceinline__ unsigned f2bf(float f) { unsigned u = __builtin_bit_cast(unsigned, f); return (u + 0x7fffu + ((u >> 16) & 1u)) >> 16; }
__device__ __forceinline__ unsigned pk2(float lo, float hi) { unsigned r; asm("v_cvt_pk_bf16_f32 %0, %1, %2" : "=v"(r) : "v"(lo), "v"(hi)); return r; }
__device__ __forceinline__ float bflo(unsigned w) { return __builtin_bit_cast(float, w << 16); }
__device__ __forceinline__ float bfhi(unsigned w) { return __builtin_bit_cast(float, w & 0xffff0000u); }
__device__ __forceinline__ float sigmoidf_(float x) { return __builtin_amdgcn_rcpf(1.0f + __expf(-x)); }
__device__ __forceinline__ float wave_sum(float v) {
#pragma unroll
    for (int o = 1; o < 64; o <<= 1) v += __shfl_xor(v, o);
    return v;
}
__device__ __forceinline__ float wave_max(float v) {
#pragma unroll
    for (int o = 1; o < 64; o <<= 1) v = fmaxf(v, __shfl_xor(v, o));
    return v;
}

#define XB_TMO      128
#define XB_XCNT(j)  (256  + 64 * (j))
#define XB_XSUB(j)  (1280 + 64 * (j))
#define XB_XGEN(j)  (2304 + 64 * (j))
#define XB_TOP      3328
#define XB_TOPGEN   3392
#define XCD_BAR_WORDS 3456
#define XB_SPIN_CAP (1u << 18)
__device__ __forceinline__ unsigned xb_ld(unsigned* p)              { return __hip_atomic_load(p, __ATOMIC_RELAXED, __HIP_MEMORY_SCOPE_AGENT); }
__device__ __forceinline__ unsigned xb_add(unsigned* p, unsigned v) { return __hip_atomic_fetch_add(p, v, __ATOMIC_RELAXED, __HIP_MEMORY_SCOPE_AGENT); }
__device__ __forceinline__ unsigned xb_xcc_id() { return (unsigned)__builtin_amdgcn_s_getreg((3 << 11) | 20) & 0xFu; }
#define XB_SPIN(cond, bar) do { unsigned _sp = 0; while (cond) { __builtin_amdgcn_s_sleep(1); \
    if ((++_sp & 255u) == 0u) { if (xb_ld(&(bar)[XB_TMO])) break; if (_sp > XB_SPIN_CAP) { atomicAdd(&(bar)[XB_TMO], 1u); break; } } } } while (0)
struct XcdBarrier { unsigned* bar; unsigned x; volatile LAS unsigned* st; };
__device__ __forceinline__ XcdBarrier xcd_barrier_post(unsigned* bar, volatile LAS unsigned* st) {
    XcdBarrier b; b.bar = bar; b.x = xb_xcc_id(); b.st = st;
    if (threadIdx.x == 0) (void)xb_add(&bar[XB_XCNT(b.x)], 1u);
    return b;
}
__device__ __forceinline__ void xcd_barrier_complete(unsigned* bar, unsigned x, unsigned& nloc, unsigned& nx) {
    const unsigned G = gridDim.x * gridDim.y * gridDim.z;
    unsigned sum, cnt, mine, sp = 0u;
    for (;;) {
        sum = 0u; cnt = 0u; mine = 0u;
#pragma unroll 1
        for (unsigned j = 0; j < 16; ++j) { const unsigned c = xb_ld(&bar[XB_XCNT(j)]); sum += c; cnt += (c > 0u) ? 1u : 0u; mine = (j == x) ? c : mine; }
        if (sum == G) break;
        __builtin_amdgcn_s_sleep(1);
        if ((++sp & 255u) == 0u) { if (xb_ld(&bar[XB_TMO])) break; if (sp > XB_SPIN_CAP) { atomicAdd(&bar[XB_TMO], 1u); break; } }
    }
    nloc = mine > 0u ? mine : 1u; nx = cnt > 0u ? cnt : 1u;
}
__device__ __forceinline__ void xcd_barrier(const XcdBarrier& b) {
    asm volatile("s_waitcnt vmcnt(0)" ::: "memory");
    __syncthreads();
    if (threadIdx.x == 0) {
        unsigned* bar = b.bar;
        asm volatile("" : "+s"(bar));
        __builtin_amdgcn_s_waitcnt(0);
        unsigned nloc = b.st[0], nx = b.st[1];
        if (nloc == 0u) { xcd_barrier_complete(bar, b.x, nloc, nx); b.st[0] = nloc; b.st[1] = nx; }
        const unsigned old = xb_add(&bar[XB_XSUB(b.x)], 1u);
        const unsigned gen = old / nloc;
        if (old + 1u == (gen + 1u) * nloc) {
            __builtin_amdgcn_fence(__ATOMIC_RELEASE, "agent");
            asm volatile("s_waitcnt vmcnt(0)" ::: "memory");
            const unsigned og = xb_add(&bar[XB_TOP], 1u);
            const unsigned tg = og / nx;
            if (og + 1u == (tg + 1u) * nx) xb_add(&bar[XB_TOPGEN], 1u);
            else XB_SPIN(xb_ld(&bar[XB_TOPGEN]) == tg, bar);
            __builtin_amdgcn_fence(__ATOMIC_ACQUIRE, "agent");
            xb_add(&bar[XB_XGEN(b.x)], 1u);
            asm volatile("s_waitcnt vmcnt(0)" ::: "memory");
        } else {
            XB_SPIN(xb_ld(&bar[XB_XGEN(b.x)]) == gen, bar);
            __builtin_amdgcn_fence(__ATOMIC_ACQUIRE, "agent");
            asm volatile("s_waitcnt vmcnt(0)" ::: "memory");
        }
    }
    __syncthreads();
}

struct Frame {
    LAS unsigned char* lds;
    int tid, lane, wave, vcu, G, bx;
    unsigned char* ws;
};
__device__ __forceinline__ Frame mkframe(unsigned char* lds_generic, unsigned char* ws) {
    Frame F; int t = threadIdx.x; asm volatile("" : "+v"(t)); asm volatile("" : "+s"(ws));
    F.lds = (LAS unsigned char*)lds_generic; F.tid = t; F.lane = t & 63; F.wave = __builtin_amdgcn_readfirstlane(t >> 6);
    { int bx = blockIdx.x, G = gridDim.x; asm volatile("" : "+s"(bx), "+s"(G));
      F.bx = bx; F.G = G; F.vcu = (G % 8 == 0) ? (bx % 8) * (G / 8) + bx / 8 : bx; }
    F.ws = ws; return F;
}
enum { I_X = 0, I_C, I_CTX, I_CCTX, I_WADA, I_BADA, I_WIN, I_QG, I_KG, I_WBR, I_WPOOL, I_PSCALE, I_WOUT, I_WQP, I_KEYS, I_PU, I_PV, I_FG, I_OUT };
template <int I> __device__ __forceinline__ const float* inp() {
    const float* p;
    asm volatile("s_load_dwordx2 %0, %1, %2\n\ts_waitcnt lgkmcnt(0)" : "=s"(p) : "s"(__builtin_amdgcn_kernarg_segment_ptr()), "i"(8 * I) : "memory");
    return p;
}
__device__ __forceinline__ const float* mod_ptr(const Frame& F, int layer, int row) {
    const int mr = row < TL ? (row >> 11) : 8;
    return (const float*)(F.ws + WS_MOD) + ((size_t)layer * 9 + mr) * (6 * DM);
}

__device__ __forceinline__ float clamp_fp8(float v) { return __builtin_amdgcn_fmed3f(v, -448.0f, 448.0f); }
__device__ __forceinline__ unsigned pk4_fp8(float a, float b, float c, float d) { int p = __builtin_amdgcn_cvt_pk_fp8_f32(clamp_fp8(a), clamp_fp8(b), 0, false); p = __builtin_amdgcn_cvt_pk_fp8_f32(clamp_fp8(c), clamp_fp8(d), p, true); return (unsigned)p; }
constexpr float W8_SCALE = 64.0f;
__device__ __forceinline__ void p0_transpose_item(const float* W, int K, int N, bf16* WT, unsigned char* WT8, int row_off, LAS float* scr, int item, int lane) {
    const int nblk = N / 64, kb = item / nblk, nb = item % nblk, k0 = 64 * kb, n0 = 64 * nb;
    const int n4 = (lane & 15) * 4, kr = lane >> 4;
#pragma unroll
    for (int i = 0; i < 16; ++i) { const int kk = kr + 4 * i;
        const f32x4 v = *(const GAS f32x4*)(W + (size_t)(k0 + kk) * N + n0 + n4);
        *(LAS f32x4*)(scr + kk * 64 + (n4 ^ ((kk >> 3) << 3))) = v; }
    LDS_WAIT(); asm volatile("" ::: "memory");
    const int c = lane & 7, nn = lane >> 3;
#pragma unroll
    for (int j = 0; j < 8; ++j) { const int n = nn + 8 * j; const LAS float* sp = scr + (8 * c) * 64 + (n ^ (c << 3));
        const float x0 = sp[0 * 64], x1 = sp[1 * 64], x2 = sp[2 * 64], x3 = sp[3 * 64], x4 = sp[4 * 64], x5 = sp[5 * 64], x6 = sp[6 * 64], x7 = sp[7 * 64];
        if (WT) { v4u o; o.x = pk2(x0, x1); o.y = pk2(x2, x3); o.z = pk2(x4, x5); o.w = pk2(x6, x7); *(GAS v4u*)(WT + (size_t)(row_off + n0 + n) * K + k0 + 8 * c) = o; }
        if (WT8) { v2u o; o.x = pk4_fp8(x0 * W8_SCALE, x1 * W8_SCALE, x2 * W8_SCALE, x3 * W8_SCALE); o.y = pk4_fp8(x4 * W8_SCALE, x5 * W8_SCALE, x6 * W8_SCALE, x7 * W8_SCALE);
            *(GAS v2u*)(WT8 + (size_t)(row_off + n0 + n) * K + k0 + 8 * c) = o; } }
    LDS_WAIT(); asm volatile("" ::: "memory");
}
__device__ __forceinline__ void cvt8(const float* src, bf16* dst) {
    const f32x4 a = *(const GAS f32x4*)src, b = *(const GAS f32x4*)(src + 4);
    v4u o; o.x = pk2(a.x, a.y); o.y = pk2(a.z, a.w); o.z = pk2(b.x, b.y); o.w = pk2(b.z, b.w);
    *(GAS v4u*)dst = o;
}
__device__ __forceinline__ void phase_prologue(Frame& F) {
    {
        LAS float* S = (LAS float*)F.lds;
        LAS float* red = (LAS float*)(F.lds + 16384);
        float* modp = (float*)(F.ws + WS_MODP);
        for (int u = F.bx; u < 96 * 8; u += F.G) {
            const int cb = u >> 3, kc = u & 7, layer = cb / 48, col0 = (cb % 48) * 256, kbase = kc * 256;
            for (int e = F.tid; e < 9 * 256; e += 512) { const int r = e >> 8, kk = e & 255;
                const float v = r < 8 ? inp<I_C>()[(size_t)r * DM + kbase + kk] : inp<I_CCTX>()[kbase + kk];
                S[e] = v / (1.0f + __expf(-v)); }
            __syncthreads();
            f32x4 acc[9];
#pragma unroll
            for (int r = 0; r < 9; ++r) acc[r] = (f32x4){0.f, 0.f, 0.f, 0.f};
            const float* wp = inp<I_WADA>() + ((size_t)layer * DM + kbase + F.wave * 32) * (6 * DM) + col0 + F.lane * 4;
#pragma unroll 8
            for (int kk = 0; kk < 32; ++kk) {
                const f32x4 w = *(const GAS f32x4*)(wp + (size_t)kk * (6 * DM));
#pragma unroll
                for (int r = 0; r < 9; ++r) { const float s = S[r * 256 + F.wave * 32 + kk]; acc[r] += w * s; }
            }
#pragma unroll
            for (int r = 0; r < 9; ++r) *(LAS f32x4*)(red + (F.wave * 9 + r) * 256 + F.lane * 4) = acc[r];
            __syncthreads();
            for (int e = F.tid; e < 9 * 256; e += 512) { const int r = e >> 8, cc = e & 255; float s = 0.f;
#pragma unroll
                for (int w = 0; w < 8; ++w) s += red[(w * 9 + r) * 256 + cc];
                modp[(((size_t)kc * 2 + layer) * 9 + r) * (6 * DM) + col0 + cc] = s; }
            __syncthreads();
        }
    }
    if (F.bx == F.G - 1) {
        float* rope = (float*)(F.ws + WS_ROPE);
        for (int e = F.tid; e < 64 * 32; e += 512) { const int pos = e >> 5, f = e & 31;
            const float inv = powf(10000.0f, -(float)f / 32.0f); const float ang = (float)pos * inv;
            rope[e] = cosf(ang); rope[2048 + e] = sinf(ang); }
    }
    LAS float* scr = (LAS float*)(F.lds + F.wave * 16384);
    const int gw = F.vcu * NWAVES + F.wave, NGW = F.G * NWAVES;
    constexpr int I_IN = (DM / 64) * (INW / 64), I_SQ = (DM / 64) * (DM / 64), I_PG = (256 / 64) * (512 / 64);
    constexpr int PER_LAYER = I_IN + 3 * I_SQ + 4 * I_PG;
    for (int it = gw; it < NLAYER * PER_LAYER; it += NGW) {
        const int layer = it / PER_LAYER; int r = it % PER_LAYER;
        if (r < I_IN) { const bool pool = (unsigned)(r % (INW / 64) - POOLOFF / 64) < 1024u / 64u;
            p0_transpose_item(inp<I_WIN>() + (size_t)layer * DM * INW, DM, INW, pool ? (bf16*)(F.ws + WS_WIN + (size_t)layer * 32 * MiB) : (bf16*)nullptr,
                              pool ? (unsigned char*)nullptr : F.ws + WS_WIN8 + (size_t)layer * 32 * MiB, 0, scr, r, F.lane); continue; } r -= I_IN;
        if (r < I_SQ) { p0_transpose_item(inp<I_WBR>() + (size_t)layer * DM * DM, DM, DM, nullptr, F.ws + WS_WBR8 + (size_t)layer * 32 * MiB, 0, scr, r, F.lane); continue; } r -= I_SQ;
        if (r < I_SQ) { p0_transpose_item(inp<I_WOUT>() + (size_t)layer * DM * DM, DM, DM, (bf16*)(F.ws + WS_WOUT + (size_t)layer * 8 * MiB), nullptr, 0, scr, r, F.lane); continue; } r -= I_SQ;
        if (r < I_SQ) { p0_transpose_item(inp<I_WQP>() + (size_t)layer * DM * DM, DM, DM, (bf16*)(F.ws + WS_WQP + (size_t)layer * 8 * MiB), nullptr, 0, scr, r, F.lane); continue; } r -= I_SQ;
        const int g = r / I_PG; r %= I_PG;
        p0_transpose_item(inp<I_WPOOL>() + ((size_t)layer * 4 + g) * 256 * 512, 256, 512, (bf16*)(F.ws + WS_WPOOL + (size_t)layer * 1 * MiB), nullptr, g * 512, scr, r, F.lane);
    }
    const size_t gt = (size_t)F.vcu * 512 + F.tid, NGT = (size_t)F.G * 512;
    for (size_t e = gt; e < (size_t)NLAYER * 2048 * 16; e += NGT) cvt8(inp<I_KEYS>() + e * 8, (bf16*)(F.ws + WS_KEYS) + e * 8);
    {
        typedef __bf16 bf32v __attribute__((ext_vector_type(32)));
        typedef unsigned v6u __attribute__((ext_vector_type(6)));
        const float* pu_ = inp<I_PU>(); const float* pv_ = inp<I_PV>();
        constexpr int NROWS = NLAYER * NEXP;
        for (int rr = gw; rr < 2 * NROWS; rr += NGW) {
            const bool isu = rr < NROWS; const int row = isu ? rr : rr - NROWS;
            const float* src = (isu ? pu_ : pv_) + (size_t)row * DM + F.lane * 4;
            f32x4 v[8];
#pragma unroll
            for (int j = 0; j < 8; ++j) v[j] = *(const GAS f32x4*)(src + 256 * j);
            float m = 0.f;
#pragma unroll
            for (int j = 0; j < 8; ++j) m = fmaxf(m, fmaxf(fmaxf(fabsf(v[j].x), fabsf(v[j].y)), fmaxf(fabsf(v[j].z), fabsf(v[j].w))));
            m = wave_max(m);
            float sc = 1.0f;
            if (m > 1e-30f) sc = fminf(6.0f / m, 1.0e30f);
            {
                unsigned pk[4];
#pragma unroll
                for (int d = 0; d < 4; ++d) { unsigned p = 0u;
                    p = __builtin_amdgcn_cvt_scalef32_pk_fp4_f32(p, v[2 * d].x * sc, v[2 * d].y * sc, 1.0f, 0); p = __builtin_amdgcn_cvt_scalef32_pk_fp4_f32(p, v[2 * d].z * sc, v[2 * d].w * sc, 1.0f, 1);
                    p = __builtin_amdgcn_cvt_scalef32_pk_fp4_f32(p, v[2 * d + 1].x * sc, v[2 * d + 1].y * sc, 1.0f, 2); p = __builtin_amdgcn_cvt_scalef32_pk_fp4_f32(p, v[2 * d + 1].z * sc, v[2 * d + 1].w * sc, 1.0f, 3);
                    pk[d] = p; }
                unsigned char* dst = F.ws + (isu ? WS_PU : WS_PV) + (size_t)(row / NEXP) * 32 * MiB + (size_t)(row % NEXP) * 1024 + F.lane * 16;
                *(GAS v4u*)dst = (v4u){pk[0], pk[1], pk[2], pk[3]};
            }
            if (F.lane == 0) ((float*)(F.ws + (isu ? WS_SCU : WS_SCV)))[row] = 1.0f / sc;
        }
    }
}
__device__ __forceinline__ void phase_mod_finalize(Frame& F) {
    const float* modp = (const float*)(F.ws + WS_MODP); float* mod = (float*)(F.ws + WS_MOD);
    constexpr int NMOD = NLAYER * 9 * 6 * DM;
    for (int e = F.vcu * 512 + F.tid; e < NMOD; e += F.G * 512) {
        const int layer = e / (9 * 6 * DM), col = e % (6 * DM);
        float s = inp<I_BADA>()[(size_t)layer * 6 * DM + col];
#pragma unroll
        for (int kc = 0; kc < 8; ++kc) s += modp[(size_t)kc * NMOD + e];
        mod[e] = s;
    }
}
__device__ __forceinline__ void phase_modulate(Frame& F, int layer, int which, int nrows, bool from_inputs, bool with_fp8) {
    const int gw = F.vcu * NWAVES + F.wave, NGW = F.G * NWAVES;
    bf16* H = (bf16*)(F.ws + WS_H);
    const float* x_ = inp<I_X>(); const float* ctx_ = inp<I_CTX>();
    for (int row = gw; row < nrows; row += NGW) {
        const float* mp = mod_ptr(F, layer, row) + (which ? 3 * DM : 0);
        f32x4 v[8]; float ss = 0.f;
        if (from_inputs) { const float* src = row < TL ? x_ + (size_t)row * DM : ctx_ + (size_t)(row - TL) * DM;
#pragma unroll
            for (int j = 0; j < 4; ++j) { v[2 * j] = *(const GAS f32x4*)(src + j * 512 + F.lane * 8); v[2 * j + 1] = *(const GAS f32x4*)(src + j * 512 + F.lane * 8 + 4); }
        } else { const bf16* src = (const bf16*)(F.ws + WS_X) + (size_t)row * DM; v4u r[4];
#pragma unroll
            for (int j = 0; j < 4; ++j) r[j] = *(const GAS v4u*)(src + j * 512 + F.lane * 8);
#pragma unroll
            for (int j = 0; j < 4; ++j) { v[2 * j] = (f32x4){bflo(r[j].x), bfhi(r[j].x), bflo(r[j].y), bfhi(r[j].y)}; v[2 * j + 1] = (f32x4){bflo(r[j].z), bfhi(r[j].z), bflo(r[j].w), bfhi(r[j].w)}; } }
#pragma unroll
        for (int j = 0; j < 8; ++j) ss += (v[j].x * v[j].x + v[j].y * v[j].y) + (v[j].z * v[j].z + v[j].w * v[j].w);
        const float rs = 1.0f / sqrtf(wave_sum(ss) * (1.0f / DM) + EPS);
#pragma unroll
        for (int j = 0; j < 4; ++j) { const int col = j * 512 + F.lane * 8;
            const f32x4 sh0 = *(const GAS f32x4*)(mp + col), sh1 = *(const GAS f32x4*)(mp + col + 4), sc0 = *(const GAS f32x4*)(mp + DM + col), sc1 = *(const GAS f32x4*)(mp + DM + col + 4);
            const f32x4 o0 = v[2 * j] * rs * (sc0 + 1.0f) + sh0, o1 = v[2 * j + 1] * rs * (sc1 + 1.0f) + sh1;
            v4u w; w.x = pk2(o0.x, o0.y); w.y = pk2(o0.z, o0.w); w.z = pk2(o1.x, o1.y); w.w = pk2(o1.z, o1.w);
            *(GAS v4u*)(H + (size_t)row * DM + col) = w;
            if (with_fp8) { v2u w8; w8.x = pk4_fp8(o0.x, o0.y, o0.z, o0.w); w8.y = pk4_fp8(o1.x, o1.y, o1.z, o1.w); *(GAS v2u*)(F.ws + WS_H8 + (size_t)row * DM + col) = w8; }
        }
    }
}

__device__ __forceinline__ v4u qk_item(const v4u raw, int row, int quad, int layer, int lane, const float* rope, const float* qg_, const float* kg_) {
    const int l16 = lane & 15, d0 = l16 * 8, head = quad * 4 + (lane >> 4);
    float v[8] = {bflo(raw.x), bfhi(raw.x), bflo(raw.y), bfhi(raw.y), bflo(raw.z), bfhi(raw.z), bflo(raw.w), bfhi(raw.w)};
    float ss = 0.f;
#pragma unroll
    for (int e = 0; e < 8; ++e) ss += v[e] * v[e];
    ss += __shfl_xor(ss, 1); ss += __shfl_xor(ss, 2); ss += __shfl_xor(ss, 4); ss += __shfl_xor(ss, 8);
    const float rs = 1.0f / sqrtf(ss * (1.0f / 128.0f) + EPS);
    const float* gain = (head < 16 ? qg_ : kg_) + (size_t)layer * 128 + d0;
    const f32x4 g0 = *(const GAS f32x4*)gain, g1 = *(const GAS f32x4*)(gain + 4);
    const float gg[8] = {g0.x, g0.y, g0.z, g0.w, g1.x, g1.y, g1.z, g1.w};
#pragma unroll
    for (int e = 0; e < 8; ++e) v[e] = v[e] * rs * gg[e];
    float part[8];
#pragma unroll
    for (int e = 0; e < 8; ++e) part[e] = __shfl_xor(v[e], 4);
    if (row < TL) {
        const int t = row & (SEQ - 1), pos = (d0 < 64) ? (t >> 6) : (t & 63), f0 = d0 & 31;
        const float* cs = rope + pos * 32 + f0; const float* sn = cs + 2048;
        const f32x4 c0 = *(const GAS f32x4*)cs, c1 = *(const GAS f32x4*)(cs + 4), s0 = *(const GAS f32x4*)sn, s1 = *(const GAS f32x4*)(sn + 4);
        const float cc[8] = {c0.x, c0.y, c0.z, c0.w, c1.x, c1.y, c1.z, c1.w}, sv[8] = {s0.x, s0.y, s0.z, s0.w, s1.x, s1.y, s1.z, s1.w};
        const float sgn = (l16 & 4) ? 1.0f : -1.0f;
#pragma unroll
        for (int e = 0; e < 8; ++e) v[e] = v[e] * cc[e] + sgn * part[e] * sv[e];
    }
    v4u o; o.x = pk2(v[0], v[1]); o.y = pk2(v[2], v[3]); o.z = pk2(v[4], v[5]); o.w = pk2(v[6], v[7]);
    return o;
}
__device__ __forceinline__ void phase_post(Frame& F, int layer) {
    const int gw = F.vcu * NWAVES + F.wave, NGW = F.G * NWAVES, lane = F.lane;
    bf16* P = (bf16*)(F.ws + WS_P);
    const float* rope = (const float*)(F.ws + WS_ROPE);
    const float* qg_ = inp<I_QG>(); const float* kg_ = inp<I_KG>();
    for (int it0 = gw; it0 < TT; it0 += 4 * NGW) {
        v4u raw[4]; bool ok[4];
#pragma unroll
        for (int q = 0; q < 4; ++q) { const int row = it0 + q * NGW; ok[q] = row < TT;
            if (ok[q]) raw[q] = *(const GAS v4u*)(P + (size_t)row * INW + 4 * 512 + lane * 8); }
#pragma unroll
        for (int q = 0; q < 4; ++q) if (ok[q]) { const int row = it0 + q * NGW;
            *(GAS v4u*)(P + (size_t)row * INW + 4 * 512 + lane * 8) = qk_item(raw[q], row, 4, layer, lane, rope, qg_, kg_); }
    }
    bf16* PO = (bf16*)(F.ws + WS_POOLED);
    const int prow = (layer == NLAYER - 1) ? TL : TT;
    for (int it = gw; it < prow * 2; it += NGW) {
        const int row = it >> 1, hsel = it & 1, c8 = hsel * 64 + lane, g = c8 >> 5, half = 1 << g;
        int base, t, L;
        if (row < TL) { base = row & ~(SEQ - 1); t = row & (SEQ - 1); L = SEQ; } else { const int j = row - TL; base = TL + (j & ~(CTXL - 1)); t = j & (CTXL - 1); L = CTXL; }
        const int lo = max(t - half, 0), hi = min(t + half, L);
        float acc[8] = {0.f, 0.f, 0.f, 0.f, 0.f, 0.f, 0.f, 0.f};
        const bf16* pp = P + (size_t)base * INW + POOLOFF + c8 * 8;
        const v4u selfraw = *(const GAS v4u*)(pp + (size_t)t * INW);
#define POOL_ACC(NW, H0) do { v4u rw_[NW]; \
            _Pragma("unroll") for (int d = 0; d < NW; ++d) { const int tt = min(max(t - (H0) + d, 0), L - 1); rw_[d] = *(const GAS v4u*)(pp + (size_t)tt * INW); } \
            _Pragma("unroll") for (int d = 0; d < NW; ++d) { const int tt = t - (H0) + d; const float wgt = (tt >= lo && tt < hi) ? 1.0f : 0.0f; \
                acc[0] += wgt * bflo(rw_[d].x); acc[1] += wgt * bfhi(rw_[d].x); acc[2] += wgt * bflo(rw_[d].y); acc[3] += wgt * bfhi(rw_[d].y); \
                acc[4] += wgt * bflo(rw_[d].z); acc[5] += wgt * bfhi(rw_[d].z); acc[6] += wgt * bflo(rw_[d].w); acc[7] += wgt * bfhi(rw_[d].w); } } while (0)
        if (hsel == 0) POOL_ACC(4, 2); else POOL_ACC(16, 8);
#undef POOL_ACC
        const float self[8] = {bflo(selfraw.x), bfhi(selfraw.x), bflo(selfraw.y), bfhi(selfraw.y), bflo(selfraw.z), bfhi(selfraw.z), bflo(selfraw.w), bfhi(selfraw.w)};
        const float inv = 1.0f / (float)(hi - lo);
        v4u o; o.x = pk2(acc[0] * inv - self[0], acc[1] * inv - self[1]); o.y = pk2(acc[2] * inv - self[2], acc[3] * inv - self[3]);
        o.z = pk2(acc[4] * inv - self[4], acc[5] * inv - self[5]); o.w = pk2(acc[6] * inv - self[6], acc[7] * inv - self[7]);
        *(GAS v4u*)(PO + (size_t)row * 1024 + c8 * 8) = o;
    }
}

namespace attn {
constexpr int D = 128, NW = 8, QBLK = 32, KVBLK = 64;
constexpr float SCALE = 0.088388347648318440f;
constexpr float THR = 8.f;
constexpr float Q8_SCALE = 8.0f;
constexpr int LDQ = INW, LDK = INW, LDO = DM;
constexpr size_t SHM_V = KVBLK * D * 2, SHM_K = KVBLK * D * 2;
constexpr size_t OFF_WS = 2 * SHM_V + 2 * SHM_K, OFF_OST = OFF_WS + NW * 64 * 4, SHM_ATTN = OFF_OST + NW * 4096;
using s16x4  = __attribute__((ext_vector_type(4))) short;
using f32x16 = __attribute__((ext_vector_type(16))) float;
using u32x4  = __attribute__((ext_vector_type(4))) unsigned;
#define KSWZ(row, colB) ((row) * 256 + ((colB) ^ (((row) & 7) << 4)))
#define SBAR() __builtin_amdgcn_sched_barrier(0)
__device__ __forceinline__ int crow(int r, int hi) { return (r & 3) + 8 * (r >> 2) + 4 * hi; }
__device__ __forceinline__ unsigned cvtpk(float lo, float hi) { unsigned r; asm volatile("v_cvt_pk_bf16_f32 %0, %1, %2" : "=v"(r) : "v"(lo), "v"(hi)); return r; }
__device__ __forceinline__ void partialSM(f32x16& p0, f32x16& p1, float& m_reg, float& mn, float& alpha) {
  constexpr float C = SCALE * 1.4426950408889634f;
  float pmax = p0[0]; for (int r = 1; r < 16; ++r) pmax = fmaxf(pmax, p0[r]); for (int r = 0; r < 16; ++r) pmax = fmaxf(pmax, p1[r]);
  { auto rr = __builtin_amdgcn_permlane32_swap(__float_as_uint(pmax), __float_as_uint(pmax), false, false);
    pmax = fmaxf(__uint_as_float(rr[0]), __uint_as_float(rr[1])); }
  if (__builtin_expect(__all(pmax - m_reg <= THR / SCALE), 1)) { mn = m_reg; alpha = 1.f; }
  else { mn = fmaxf(m_reg, pmax); alpha = __builtin_amdgcn_exp2f((m_reg - mn) * C); m_reg = mn; }
  float mnC = -mn * C;
  for (int r = 0; r < 16; ++r) p0[r] = fmaf(p0[r], C, mnC); for (int r = 0; r < 16; ++r) p1[r] = fmaf(p1[r], C, mnC);
  for (int r = 0; r < 16; ++r) p0[r] = __builtin_amdgcn_exp2f(p0[r]);
}
__device__ __forceinline__ void finishSM(f32x16& p0, f32x16& p1, float alpha, float& l_reg, bf16x8& pa0, bf16x8& pa1, bf16x8& pa2, bf16x8& pa3) {
  for (int r = 0; r < 16; ++r) p1[r] = __builtin_amdgcn_exp2f(p1[r]);
  float ps = 0; for (int r = 0; r < 16; ++r) ps += p0[r]; for (int r = 0; r < 16; ++r) ps += p1[r];
  { auto rr = __builtin_amdgcn_permlane32_swap(__float_as_uint(ps), __float_as_uint(ps), false, false);
    ps = __uint_as_float(rr[0]) + __uint_as_float(rr[1]); }
  l_reg = l_reg * alpha + ps;
#define PK4(P, BASE, OUT) do { unsigned a0 = cvtpk(P[BASE + 0], P[BASE + 1]), a1 = cvtpk(P[BASE + 2], P[BASE + 3]);   \
    unsigned b0 = cvtpk(P[BASE + 4], P[BASE + 5]), b1 = cvtpk(P[BASE + 6], P[BASE + 7]);                              \
    auto r0 = __builtin_amdgcn_permlane32_swap(a0, b0, false, false); auto r1 = __builtin_amdgcn_permlane32_swap(a1, b1, false, false); \
    u32x4 w = {r0[0], r1[0], r0[1], r1[1]}; OUT = *reinterpret_cast<bf16x8*>(&w); } while (0)
  PK4(p0, 0, pa0); PK4(p0, 8, pa1); PK4(p1, 0, pa2); PK4(p1, 8, pa3);
#undef PK4
}
__device__ __forceinline__ void qkt(f32x16& p0, f32x16& p1, const bf16* Ks, const bf16x8* qr, int r32, int hi) {
  p0 = f32x16{}; p1 = f32x16{};
  for (int d0 = 0; d0 < 8; ++d0) { int cb = (d0 * 16 + hi * 8) * 2;
    bf16x8 b0 = *reinterpret_cast<const bf16x8*>((const char*)Ks + KSWZ(r32, cb));
    bf16x8 b1 = *reinterpret_cast<const bf16x8*>((const char*)Ks + KSWZ(32 + r32, cb));
    p0 = __builtin_amdgcn_mfma_f32_32x32x16_bf16(b0, qr[d0], p0, 0, 0, 0);
    p1 = __builtin_amdgcn_mfma_f32_32x32x16_bf16(b1, qr[d0], p1, 0, 0, 0); }
}
__device__ __forceinline__ int v_st(int k, int c) { const int kk = (k & ~0xC) | ((k & 4) << 1) | ((k & 8) >> 1); return ((kk >> 3) * 4 + (c >> 5)) * 512 + ((kk & 7) * 32 + (c & 31)) * 2; }
__device__ __forceinline__ int v_rd_base(int lane) { return ((lane & 3) << 3) | (((lane >> 2) & 3) << 6) | (((lane >> 4) & 1) << 5) | (((lane >> 5) & 1) << 8); }
constexpr int v_rd_off(int d0, int ks, int half) { return d0 * 512 + ks * 4096 + half * 2048; }
template <int OFF> __device__ __forceinline__ s16x4 tr_read(int vb) {
  s16x4 r; asm volatile("ds_read_b64_tr_b16 %0, %1 offset:%2" : "=&v"(r) : "v"(vb), "i"(OFF) : "memory"); return r;
}
template <int D0> __device__ __forceinline__ void pv_one(f32x16& od, int vb, bf16x8 pa0, bf16x8 pa1, bf16x8 pa2, bf16x8 pa3) {
  const s16x4 l0 = tr_read<v_rd_off(D0, 0, 0)>(vb), h0 = tr_read<v_rd_off(D0, 0, 1)>(vb), l1 = tr_read<v_rd_off(D0, 1, 0)>(vb), h1 = tr_read<v_rd_off(D0, 1, 1)>(vb);
  const s16x4 l2 = tr_read<v_rd_off(D0, 2, 0)>(vb), h2 = tr_read<v_rd_off(D0, 2, 1)>(vb), l3 = tr_read<v_rd_off(D0, 3, 0)>(vb), h3 = tr_read<v_rd_off(D0, 3, 1)>(vb);
  asm volatile("s_waitcnt lgkmcnt(0)" ::: "memory"); SBAR();
#define PK(L, H) (bf16x8){L[0], L[1], L[2], L[3], H[0], H[1], H[2], H[3]}
  od = __builtin_amdgcn_mfma_f32_32x32x16_bf16(pa0, PK(l0, h0), od, 0, 0, 0);
  od = __builtin_amdgcn_mfma_f32_32x32x16_bf16(pa1, PK(l1, h1), od, 0, 0, 0);
  od = __builtin_amdgcn_mfma_f32_32x32x16_bf16(pa2, PK(l2, h2), od, 0, 0, 0);
  od = __builtin_amdgcn_mfma_f32_32x32x16_bf16(pa3, PK(l3, h3), od, 0, 0, 0);
#undef PK
}
__device__ __forceinline__ void pv_d0(f32x16* o, int vb, bf16x8 pa0, bf16x8 pa1, bf16x8 pa2, bf16x8 pa3) {
  pv_one<0>(o[0], vb, pa0, pa1, pa2, pa3); pv_one<1>(o[1], vb, pa0, pa1, pa2, pa3); pv_one<2>(o[2], vb, pa0, pa1, pa2, pa3); pv_one<3>(o[3], vb, pa0, pa1, pa2, pa3);
}
__device__ __forceinline__ void attn_unit(const unsigned char* __restrict__ Qb, const bf16* __restrict__ K1, const bf16* __restrict__ K2,
                                          int len1, int seq, unsigned char* __restrict__ Ob, char* lds, const float* __restrict__ qgain, const float* __restrict__ rope, int tq0) {
  int tid_ = threadIdx.x; asm volatile("" : "+v"(tid_));
  const int tid = tid_, wid = tid >> 6, lane = tid & 63, r32 = lane & 31, hi = lane >> 5;
  bf16* V_lds = (bf16*)lds; bf16* K_lds = (bf16*)(lds + 2 * SHM_V);
  float* ws = (float*)(lds + OFF_WS) + wid * 64; float* li_l = ws; float* al_l = ws + 32;
  float m_reg = -1e30f, l_reg = 0; f32x16 o[4] = {}; bf16x8 qr[8];
  const unsigned char* Qw = Qb + (long)(wid * QBLK + r32) * (LDQ * 2) + hi * 16;
  v2u q8[8];
#pragma unroll
  for (int d0 = 0; d0 < 8; ++d0) q8[d0] = *(const GAS v2u*)(Qw + d0 * 32);
  {
    float qf[8][8]; float ss = 0.f;
#pragma unroll
    for (int d0 = 0; d0 < 8; ++d0) {
      const auto a_ = __builtin_amdgcn_cvt_pk_f32_fp8((int)q8[d0].x, false), b_ = __builtin_amdgcn_cvt_pk_f32_fp8((int)q8[d0].x, true), c_ = __builtin_amdgcn_cvt_pk_f32_fp8((int)q8[d0].y, false), d_ = __builtin_amdgcn_cvt_pk_f32_fp8((int)q8[d0].y, true);
      qf[d0][0] = a_[0] * (1.0f / Q8_SCALE); qf[d0][1] = a_[1] * (1.0f / Q8_SCALE); qf[d0][2] = b_[0] * (1.0f / Q8_SCALE); qf[d0][3] = b_[1] * (1.0f / Q8_SCALE);
      qf[d0][4] = c_[0] * (1.0f / Q8_SCALE); qf[d0][5] = c_[1] * (1.0f / Q8_SCALE); qf[d0][6] = d_[0] * (1.0f / Q8_SCALE); qf[d0][7] = d_[1] * (1.0f / Q8_SCALE);
#pragma unroll
      for (int e = 0; e < 8; ++e) ss += qf[d0][e] * qf[d0][e]; }
    { auto rr = __builtin_amdgcn_permlane32_swap(__float_as_uint(ss), __float_as_uint(ss), false, false); ss = __uint_as_float(rr[0]) + __uint_as_float(rr[1]); }
    const float rs = 1.0f / sqrtf(ss * (1.0f / 128.0f) + EPS);
#pragma unroll
    for (int d0 = 0; d0 < 8; ++d0) { const float* gp = qgain + d0 * 16 + hi * 8; const f32x4 g0 = *(const GAS f32x4*)gp, g1 = *(const GAS f32x4*)(gp + 4);
      qf[d0][0] *= rs * g0.x; qf[d0][1] *= rs * g0.y; qf[d0][2] *= rs * g0.z; qf[d0][3] *= rs * g0.w; qf[d0][4] *= rs * g1.x; qf[d0][5] *= rs * g1.y; qf[d0][6] *= rs * g1.z; qf[d0][7] *= rs * g1.w; }
    if (tq0 >= 0) {
      const int t = tq0 + wid * QBLK + r32;
#pragma unroll
      for (int ch = 0; ch < 2; ++ch) { const int pos = ch == 0 ? (t >> 6) : (t & 63);
#pragma unroll
        for (int dd = 0; dd < 2; ++dd) { const int dA = ch * 4 + dd, dB = dA + 2; const float* cs = rope + pos * 32 + dd * 16 + hi * 8; const float* sn = cs + 2048;
          const f32x4 c0 = *(const GAS f32x4*)cs, c1 = *(const GAS f32x4*)(cs + 4), s0 = *(const GAS f32x4*)sn, s1 = *(const GAS f32x4*)(sn + 4);
          const float cc[8] = {c0.x, c0.y, c0.z, c0.w, c1.x, c1.y, c1.z, c1.w}, sv[8] = {s0.x, s0.y, s0.z, s0.w, s1.x, s1.y, s1.z, s1.w};
#pragma unroll
          for (int e = 0; e < 8; ++e) { const float x1 = qf[dA][e], x2 = qf[dB][e]; qf[dA][e] = x1 * cc[e] - x2 * sv[e]; qf[dB][e] = x2 * cc[e] + x1 * sv[e]; } } }
    }
#pragma unroll
    for (int d0 = 0; d0 < 8; ++d0) { u32x4 w; w[0] = cvtpk(qf[d0][0], qf[d0][1]); w[1] = cvtpk(qf[d0][2], qf[d0][3]); w[2] = cvtpk(qf[d0][4], qf[d0][5]); w[3] = cvtpk(qf[d0][6], qf[d0][7]); qr[d0] = __builtin_bit_cast(bf16x8, w); }
  }
  const int sr = tid >> 4, sc = (tid & 15) * 8, vst0 = v_st(sr, sc), vst1 = v_st(32 + sr, sc);
  const int vb0 = (int)(uintptr_t)V_lds + v_rd_base(lane);
  struct { bf16x8 vs0, vs1, ks0, ks1; } sr_[2];
  const unsigned lo0_ = (unsigned)(sr * LDK + sc) * 2u, lo1_ = lo0_ + 32u * LDK * 2u;
  constexpr int VKB = (VOFF - KVOFF) * 2;
#define SLOAD(i, k0) do { const int k0_ = (k0); const char* Kt_ = (const char*)((k0_ < len1) ? K1 + (long)k0_ * LDK : K2 + (long)(k0_ - len1) * LDK); \
    sr_[i].vs0 = *(const GAS bf16x8*)(Kt_ + lo0_ + VKB); sr_[i].vs1 = *(const GAS bf16x8*)(Kt_ + lo1_ + VKB); \
    sr_[i].ks0 = *(const GAS bf16x8*)(Kt_ + lo0_); sr_[i].ks1 = *(const GAS bf16x8*)(Kt_ + lo1_); } while (0)
#define SWRITE(b, i) do { *(bf16x8*)((char*)V_lds + (b) * SHM_V + vst0) = sr_[i].vs0;          \
    *(bf16x8*)((char*)V_lds + (b) * SHM_V + vst1) = sr_[i].vs1; int kc = sc * 2;               \
    *(bf16x8*)((char*)K_lds + (b) * SHM_K + KSWZ(sr, kc)) = sr_[i].ks0;                       \
    *(bf16x8*)((char*)K_lds + (b) * SHM_K + KSWZ(32 + sr, kc)) = sr_[i].ks1; } while (0)
#define SWAIT() asm volatile("s_waitcnt vmcnt(4)" ::: "memory")
#define RESC(a) do { if (__any((a) < 1.f)) { if (hi == 0) al_l[r32] = (a); asm volatile("s_waitcnt lgkmcnt(0)" ::: "memory"); \
    for (int d = 0; d < 4; ++d) for (int r = 0; r < 16; ++r) o[d][r] *= al_l[crow(r, hi)]; } } while (0)
  f32x16 pA0, pA1, pB0, pB1; float mnA, mnB, alA, alB; bf16x8 pa0, pa1, pa2, pa3; const int NT = seq / KVBLK;
  constexpr int SE = 0, SO = 1;
  SLOAD(SE, 0); asm volatile("s_waitcnt vmcnt(0)" ::: "memory"); SWRITE(0, SE); __syncthreads();
  qkt(pA0, pA1, K_lds, qr, r32, hi); partialSM(pA0, pA1, m_reg, mnA, alA);
  SLOAD(SO, KVBLK); if (2 < NT) SLOAD(SE, 2 * KVBLK);
  SWAIT(); SWRITE(1, SO); __syncthreads();
  for (int j = 1; j + 1 < NT; j += 2) {
    SBAR(); qkt(pB0, pB1, (bf16*)((char*)K_lds + SHM_K), qr, r32, hi);
    finishSM(pA0, pA1, alA, l_reg, pa0, pa1, pa2, pa3); SBAR();
    SLOAD(SO, (j + 2) * KVBLK); SBAR();
    pv_d0(o, vb0, pa0, pa1, pa2, pa3); partialSM(pB0, pB1, m_reg, mnB, alB);
    __syncthreads(); SWAIT(); SWRITE(0, SE);
    RESC(alB); __syncthreads();
    SBAR(); qkt(pA0, pA1, K_lds, qr, r32, hi);
    finishSM(pB0, pB1, alB, l_reg, pa0, pa1, pa2, pa3); SBAR();
    if (j + 3 < NT) SLOAD(SE, (j + 3) * KVBLK); SBAR();
    pv_d0(o, vb0 + (int)SHM_V, pa0, pa1, pa2, pa3); partialSM(pA0, pA1, m_reg, mnA, alA);
    __syncthreads(); SWAIT(); SWRITE(1, SO);
    RESC(alA); __syncthreads();
  }
  SBAR(); qkt(pB0, pB1, (bf16*)((char*)K_lds + SHM_K), qr, r32, hi);
  finishSM(pA0, pA1, alA, l_reg, pa0, pa1, pa2, pa3); SBAR();
  pv_d0(o, vb0, pa0, pa1, pa2, pa3); partialSM(pB0, pB1, m_reg, mnB, alB);
  __syncthreads(); RESC(alB);
  finishSM(pB0, pB1, alB, l_reg, pa0, pa1, pa2, pa3); SBAR();
  pv_d0(o, vb0 + (int)SHM_V, pa0, pa1, pa2, pa3);
  if (hi == 0) li_l[r32] = l_reg; asm volatile("s_waitcnt lgkmcnt(0)" ::: "memory");
  float rli[16];
#pragma unroll
  for (int r = 0; r < 16; ++r) rli[r] = __builtin_amdgcn_rcpf(li_l[crow(r, hi)]);
  unsigned char* Ow = (unsigned char*)Ob + (long)(wid * QBLK) * LDO;
  unsigned char* stg = (unsigned char*)(lds + OFF_OST) + wid * 4096;
#pragma unroll
  for (int r = 0; r < 16; ++r) { const int orow = crow(r, hi);
#pragma unroll
    for (int d0 = 0; d0 < 4; ++d0) { const float v = __builtin_amdgcn_fmed3f(o[d0][r] * rli[r] * 64.0f, -448.0f, 448.0f); stg[orow * 128 + d0 * 32 + r32] = (unsigned char)__builtin_amdgcn_cvt_pk_fp8_f32(v, v, 0, false); } }
  asm volatile("s_waitcnt lgkmcnt(0)" ::: "memory");
#pragma unroll
  for (int i = 0; i < 4; ++i) { const int row = i * 8 + (lane >> 3), ch = lane & 7; const u32x4 v = *(const u32x4*)(stg + row * 128 + ch * 16); *(GAS u32x4*)(Ow + (long)row * LDO + ch * 16) = v; }
  asm volatile("s_waitcnt lgkmcnt(0)" ::: "memory");
#undef SLOAD
#undef SWRITE
#undef SWAIT
#undef RESC
}
#undef KSWZ
#undef SBAR
}

__device__ __forceinline__ void phase_attention(Frame& F, int layer, char* lds) {
    const bf16* P = (const bf16*)(F.ws + WS_P); unsigned char* AO = F.ws + WS_AO;
    const float* qg_ = inp<I_QG>() + (size_t)layer * 128; const float* rope_ = (const float*)(F.ws + WS_ROPE);
    const int nunits = 1024 + (layer == NLAYER - 1 ? 0 : 128);
    for (int L = F.vcu; L < nunits; L += F.G) {
        const bool lat = L < 1024; const int cidx = L - 1024;
        const int combo = L >> 5, loc = L & 31, b = lat ? (combo >> 2) : (cidx >> 4), h = lat ? ((combo & 3) * 4 + (loc >> 3)) : (cidx & 15), kvh = h >> 2, qb = loc & 7;
        const size_t crow = (size_t)TL + b * CTXL, qrow = lat ? (size_t)b * SEQ + qb * 256 : crow, k1row = lat ? (size_t)b * SEQ : crow;
        attn::attn_unit((const unsigned char*)P + qrow * (INW * 2) + (h >> 1) * 256 + (h & 1) * 8, P + k1row * INW + KVOFF + kvh * 128, P + crow * INW + KVOFF + kvh * 128, lat ? SEQ : CTXL, lat ? SEQ + CTXL : CTXL, AO + qrow * DM + h * 128, lds, qg_, rope_, lat ? qb * 256 : -1);
    }
}

using pg8::f32x4;
struct FNone {};
struct FStoreBf16 { bf16* O; int ldc; float scale;
    typedef FNone Pre; typedef FNone Col;
    __device__ __forceinline__ Col col_load(int, int) const { return Col{}; }
    __device__ __forceinline__ Pre load(int, int) const { return Pre{}; }
    __device__ __forceinline__ void apply(int row, int col, f32x4 v0, f32x4 v1, Pre, Col) const {
        v0 = v0 * scale; v1 = v1 * scale;
        v4u w; w.x = pk2(v0[0], v0[1]); w.y = pk2(v0[2], v0[3]); w.z = pk2(v1[0], v1[1]); w.w = pk2(v1[2], v1[3]);
        *(GAS v4u*)(O + (size_t)row * ldc + col) = w; } };
constexpr float GATE_SCALE = 8.0f;
__device__ __forceinline__ size_t gate8_off(int row, int gc) {
    return (size_t)row * (INW * 2) + (INW) + (size_t)((gc & ~255) + ((gc & 127) << 1) + ((gc >> 7) & 1) * 8); }
__device__ __forceinline__ void unpack8_fp8(v2u raw, float* v) {
    const auto a = __builtin_amdgcn_cvt_pk_f32_fp8((int)raw.x, false), b = __builtin_amdgcn_cvt_pk_f32_fp8((int)raw.x, true), c = __builtin_amdgcn_cvt_pk_f32_fp8((int)raw.y, false), d = __builtin_amdgcn_cvt_pk_f32_fp8((int)raw.y, true);
    constexpr float inv = 1.0f / GATE_SCALE;
    v[0] = a[0] * inv; v[1] = a[1] * inv; v[2] = b[0] * inv; v[3] = b[1] * inv; v[4] = c[0] * inv; v[5] = c[1] * inv; v[6] = d[0] * inv; v[7] = d[1] * inv; }
struct FStoreG1 { bf16* O; float scale;
    typedef FNone Pre; typedef FNone Col;
    __device__ __forceinline__ void apply(int row, int col, f32x4 v0, f32x4 v1) const {
        v0 = v0 * scale; v1 = v1 * scale;
        v4u w; w.x = pk2(v0[0], v0[1]); w.y = pk2(v0[2], v0[3]); w.z = pk2(v1[0], v1[1]); w.w = pk2(v1[2], v1[3]);
        *(GAS v4u*)(O + (size_t)row * INW + col) = w; }
    __device__ __forceinline__ void apply2(int row, int col0, f32x4 a0, f32x4 a1, f32x4 b0, f32x4 b1) const {
        if (col0 < KVOFF) {
            const float g = scale * attn::Q8_SCALE; a0 = a0 * g; a1 = a1 * g; b0 = b0 * g; b1 = b1 * g;
            v4u w; w.x = pk4_fp8(a0[0], a0[1], a0[2], a0[3]); w.y = pk4_fp8(a1[0], a1[1], a1[2], a1[3]); w.z = pk4_fp8(b0[0], b0[1], b0[2], b0[3]); w.w = pk4_fp8(b1[0], b1[1], b1[2], b1[3]);
            *(GAS v4u*)((unsigned char*)O + (size_t)row * (INW * 2) + (size_t)((col0 & ~255) + ((col0 & 127) << 1))) = w; }
        else if (col0 < GAOFF) { apply(row, col0, a0, a1); apply(row, col0 + pg8::HALF, b0, b1); }
        else { const float g = scale * GATE_SCALE; a0 = a0 * g; a1 = a1 * g; b0 = b0 * g; b1 = b1 * g;
            v4u w; w.x = pk4_fp8(a0[0], a0[1], a0[2], a0[3]); w.y = pk4_fp8(a1[0], a1[1], a1[2], a1[3]); w.z = pk4_fp8(b0[0], b0[1], b0[2], b0[3]); w.w = pk4_fp8(b1[0], b1[1], b1[2], b1[3]);
            *(GAS v4u*)((unsigned char*)O + gate8_off(row, col0 - GAOFF)) = w; } } };
__device__ __forceinline__ void unpack8(v4u raw, float* v) { v[0] = bflo(raw.x); v[1] = bfhi(raw.x); v[2] = bflo(raw.y); v[3] = bfhi(raw.y); v[4] = bflo(raw.z); v[5] = bfhi(raw.z); v[6] = bflo(raw.w); v[7] = bfhi(raw.w); }
struct FPool { bf16* YB; const bf16* P; const float* pscale;
    struct Pre { v2u g; }; struct Col { f32x4 s0, s1; };
    __device__ __forceinline__ Col col_load(int, int col) const { Col c; c.s0 = *(const GAS f32x4*)(pscale + col); c.s1 = *(const GAS f32x4*)(pscale + col + 4); return c; }
    __device__ __forceinline__ Pre load(int row, int col) const { Pre p; p.g = *(const GAS v2u*)((const unsigned char*)P + gate8_off(row, DM + col)); return p; }
    __device__ __forceinline__ void apply(int row, int col, f32x4 v0, f32x4 v1, Pre p, Col c) const {
        float gt[8]; unpack8_fp8(p.g, gt);
        float o[8];
#pragma unroll
        for (int e = 0; e < 4; ++e) { o[e] = v0[e] * c.s0[e] * sigmoidf_(gt[e]); o[4 + e] = v1[e] * c.s1[e] * sigmoidf_(gt[4 + e]); }
        v4u w; w.x = pk2(o[0], o[1]); w.y = pk2(o[2], o[3]); w.z = pk2(o[4], o[5]); w.w = pk2(o[6], o[7]);
        *(GAS v4u*)(YB + (size_t)row * DM + col) = w; } };
struct FMerge { bf16* MG; const bf16* P; const bf16* YB; float scale;
    struct Pre { v2u g; v4u y; }; typedef FNone Col;
    __device__ __forceinline__ Col col_load(int, int) const { return Col{}; }
    __device__ __forceinline__ Pre load(int row, int col) const { Pre p; p.g = *(const GAS v2u*)((const unsigned char*)P + gate8_off(row, col)); p.y = *(const GAS v4u*)(YB + (size_t)row * DM + col); return p; }
    __device__ __forceinline__ void apply(int row, int col, f32x4 v0, f32x4 v1, Pre p, Col) const {
        v0 = v0 * scale; v1 = v1 * scale;
        float gt[8], yb[8]; unpack8_fp8(p.g, gt); unpack8(p.y, yb);
        float o[8];
#pragma unroll
        for (int e = 0; e < 4; ++e) { o[e] = v0[e] * sigmoidf_(gt[e]) + yb[e]; o[4 + e] = v1[e] * sigmoidf_(gt[4 + e]) + yb[4 + e]; }
        v4u w; w.x = pk2(o[0], o[1]); w.y = pk2(o[2], o[3]); w.z = pk2(o[4], o[5]); w.w = pk2(o[6], o[7]);
        *(GAS v4u*)(MG + (size_t)row * DM + col) = w; } };
constexpr float SG_MIN = 1e-20f;
struct FMid { const bf16* P; const float* pscale; float inv_scale;
    struct Pre { v2u ga, gb; }; struct Col { f32x4 s0, s1; };
    __device__ __forceinline__ Col col_load(int, int col) const { Col c; c.s0 = *(const GAS f32x4*)(pscale + col); c.s1 = *(const GAS f32x4*)(pscale + col + 4); return c; }
    __device__ __forceinline__ Pre load(int row, int col) const { Pre p; p.ga = *(const GAS v2u*)((const unsigned char*)P + gate8_off(row, col)); p.gb = *(const GAS v2u*)((const unsigned char*)P + gate8_off(row, DM + col)); return p; }
    __device__ __forceinline__ void xform(f32x4& v0, f32x4& v1, Pre p, Col c) const {
        float ga[8], gb[8]; unpack8_fp8(p.ga, ga); unpack8_fp8(p.gb, gb);
#pragma unroll
        for (int e = 0; e < 4; ++e) {
            v0[e] = v0[e] * (c.s0[e] * sigmoidf_(gb[e]) * (inv_scale * __builtin_amdgcn_rcpf(fmaxf(sigmoidf_(ga[e]), SG_MIN))));
            v1[e] = v1[e] * (c.s1[e] * sigmoidf_(gb[4 + e]) * (inv_scale * __builtin_amdgcn_rcpf(fmaxf(sigmoidf_(ga[4 + e]), SG_MIN)))); } } };
struct FMergeC { bf16* MG; const bf16* P; float scale;
    struct Pre { v2u g; }; typedef FNone Col;
    __device__ __forceinline__ Col col_load(int, int) const { return Col{}; }
    __device__ __forceinline__ Pre load(int row, int col) const { Pre p; p.g = *(const GAS v2u*)((const unsigned char*)P + gate8_off(row, col)); return p; }
    __device__ __forceinline__ void apply(int row, int col, f32x4 v0, f32x4 v1, Pre p, Col) const {
        float gt[8]; unpack8_fp8(p.g, gt);
        float o[8];
#pragma unroll
        for (int e = 0; e < 4; ++e) { o[e] = v0[e] * (scale * fmaxf(sigmoidf_(gt[e]), SG_MIN)); o[4 + e] = v1[e] * (scale * fmaxf(sigmoidf_(gt[4 + e]), SG_MIN)); }
        v4u w; w.x = pk2(o[0], o[1]); w.y = pk2(o[2], o[3]); w.z = pk2(o[4], o[5]); w.w = pk2(o[6], o[7]);
        *(GAS v4u*)(MG + (size_t)row * DM + col) = w; } };
struct FResid { bf16* X; const float* xin; const float* cin; const float* mod; int from_inputs;
    struct Pre { f32x4 x0, x1; }; struct Col { f32x4 g0, g1; };
    __device__ __forceinline__ Col col_load(int row, int col) const {
        const int mr = row < TL ? (row >> 11) : 8;
        const float* g = mod + (size_t)mr * (6 * DM) + 2 * DM + col;
        Col c; c.g0 = *(const GAS f32x4*)g; c.g1 = *(const GAS f32x4*)(g + 4); return c; }
    __device__ __forceinline__ Pre load(int row, int col) const {
        Pre p;
        if (from_inputs) { const float* src = (row < TL ? xin : cin - (size_t)TL * DM) + (size_t)row * DM + col; p.x0 = *(const GAS f32x4*)src; p.x1 = *(const GAS f32x4*)(src + 4); }
        else { p.x0 = *(const GAS f32x4*)(X + (size_t)row * DM + col); p.x1 = p.x0; }
        return p; }
    __device__ __forceinline__ void apply(int row, int col, f32x4 v0, f32x4 v1, Pre p, Col c) const {
        f32x4 x0 = p.x0, x1 = p.x1;
        if (!from_inputs) { const v4u raw = __builtin_bit_cast(v4u, p.x0); x0 = (f32x4){bflo(raw.x), bfhi(raw.x), bflo(raw.y), bfhi(raw.y)}; x1 = (f32x4){bflo(raw.z), bfhi(raw.z), bflo(raw.w), bfhi(raw.w)}; }
        const f32x4 o0 = x0 + c.g0 * v0, o1 = x1 + c.g1 * v1;
        v4u w; w.x = pk2(o0[0], o0[1]); w.y = pk2(o0[2], o0[3]); w.z = pk2(o1[0], o1[1]); w.w = pk2(o1[2], o1[3]);
        *(GAS v4u*)(X + (size_t)row * DM + col) = w; } };

namespace pk {
using f32x16 = __attribute__((ext_vector_type(16))) float;
__device__ __forceinline__ float vmaxf(float a, float b) { float r; asm("v_max_f32 %0, %1, %2" : "=v"(r) : "v"(a), "v"(b)); return r; }
__device__ __forceinline__ float vminf(float a, float b) { float r; asm("v_min_f32 %0, %1, %2" : "=v"(r) : "v"(a), "v"(b)); return r; }
#define PK_CE(x, y) do { const float mx_ = vmaxf(x, y), mn_ = vminf(x, y); x = mx_; y = mn_; } while (0)
template <int OFF> __device__ __forceinline__ void sort16(float (&a)[64]) {
#pragma unroll
    for (int k = 2; k <= 16; k <<= 1)
#pragma unroll
        for (int j = k >> 1; j > 0; j >>= 1)
#pragma unroll
            for (int i = 0; i < 16; ++i) { const int l = i ^ j; if (l > i) { if ((i & k) == 0) PK_CE(a[OFF + i], a[OFF + l]); else PK_CE(a[OFF + l], a[OFF + i]); } }
}
template <int A, int B> __device__ __forceinline__ void merge16(float (&a)[64]) {
#pragma unroll
    for (int i = 0; i < 16; ++i) a[A + i] = vmaxf(a[A + i], a[B + 15 - i]);
#pragma unroll
    for (int j = 8; j > 0; j >>= 1)
#pragma unroll
        for (int i = 0; i < 16; ++i) { const int l = i ^ j; if (l > i) PK_CE(a[A + i], a[A + l]); }
}
__device__ __forceinline__ void top16_of_64(float (&a)[64]) {
    sort16<0>(a); sort16<16>(a); sort16<32>(a); sort16<48>(a);
    merge16<0, 16>(a); merge16<32, 48>(a); merge16<0, 32>(a);
}
struct Cand { int a[50], b[50]; };
constexpr Cand make_cand() { Cand c{}; int n = 0; for (int a = 0; a < 16; ++a) for (int b = 0; b < 16; ++b) if ((a + 1) * (b + 1) <= 16) { c.a[n] = a; c.b[n] = b; ++n; } return c; }
constexpr Cand CAND = make_cand();
constexpr int LDS_KEYS = 0, LDS_IDX = 65536;
}
__device__ __forceinline__ void phase_pk(Frame& F, int layer, int nrows) {
    using namespace pk;
    const int lane = F.lane, r32 = lane & 31, hi = lane >> 5, wave = F.wave;
    const bf16* QP = (const bf16*)(F.ws + WS_P + P_QP);
    int* IDX = (int*)(F.ws + WS_P + P_IDX); float* GW = (float*)(F.ws + WS_P + P_GW);
    const bf16* KB = (const bf16*)(F.ws + WS_KEYS) + (size_t)layer * 2048 * 128;
    const int nunits = (nrows / 256) * 8;
    int cur_hd = -1;
    for (int u = F.bx; u < nunits; u += F.G) {
        const int hd = u & 7, tb = u >> 3;
        if (hd != cur_hd) {
            __syncthreads();
#pragma unroll
            for (int i = 0; i < 8; ++i) { const int idx = F.tid + 512 * i, row = idx >> 4, c = idx & 15;
                const v4u v = *(const GAS v4u*)(KB + ((size_t)hd * 256 + row) * 128 + c * 8);
                *(LAS v4u*)(F.lds + LDS_KEYS + row * 256 + ((c ^ (row & 15)) << 4)) = v; }
            __syncthreads();
            cur_hd = hd;
        }
        const int t0 = tb * 256 + wave * 32;
        float v01[2][16];
#pragma unroll
        for (int p = 0; p < 2; ++p) {
            bf16x8 bq[8];
            const bf16* qrow = QP + (size_t)(t0 + r32) * DM + hd * 256 + p * 128 + hi * 8;
#pragma unroll
            for (int ks = 0; ks < 8; ++ks) bq[ks] = *(const GAS bf16x8*)(qrow + ks * 16);
            f32x16 acc[4];
#pragma unroll
            for (int nb = 0; nb < 4; ++nb) acc[nb] = f32x16{};
            const LAS unsigned char* kbase = F.lds + LDS_KEYS + (p * 128 + r32) * 256;
#pragma unroll
            for (int ks = 0; ks < 8; ++ks) { const int coff = ((2 * ks + hi) ^ (r32 & 15)) << 4;
#pragma unroll
                for (int nb = 0; nb < 4; ++nb) { const bf16x8 ak = *(const LAS bf16x8*)(kbase + nb * 32 * 256 + coff);
                    acc[nb] = __builtin_amdgcn_mfma_f32_32x32x16_bf16(ak, bq[ks], acc[nb], 0, 0, 0); } }
            float a[64]; const unsigned hib = (unsigned)hi << 2;
#pragma unroll
            for (int nb = 0; nb < 4; ++nb)
#pragma unroll
                for (int r = 0; r < 16; ++r) { const unsigned n0 = 32u * nb + (r & 3) + 8u * (r >> 2);
                    a[nb * 16 + r] = __uint_as_float(((__float_as_uint(acc[nb][r]) & ~127u) | n0) | hib); }
            top16_of_64(a);
            float m0[64];
#pragma unroll
            for (int i = 0; i < 16; ++i) { auto rr = __builtin_amdgcn_permlane32_swap(__float_as_uint(a[i]), __float_as_uint(a[i]), false, false);
                m0[i] = __uint_as_float(rr[0]); m0[16 + i] = __uint_as_float(rr[1]); }
            merge16<0, 16>(m0);
#pragma unroll
            for (int i = 0; i < 16; ++i) v01[p][i] = m0[i];
        }
        LAS unsigned* tab = (LAS unsigned*)(F.lds + LDS_IDX + wave * 8192);
#pragma unroll
        for (int i = 0; i < 16; ++i) { tab[i * 64 + lane] = __float_as_uint(v01[0][i]) & 127u; tab[(16 + i) * 64 + lane] = __float_as_uint(v01[1][i]) & 127u; }
        float c[64];
        float f0[16], f1[16];
#pragma unroll
        for (int i = 0; i < 16; ++i) { f0[i] = __uint_as_float(__float_as_uint(v01[0][i]) & ~127u); f1[i] = __uint_as_float(__float_as_uint(v01[1][i]) & ~127u); }
#pragma unroll
        for (int i = 0; i < 50; ++i) c[i] = __uint_as_float((__float_as_uint(f0[CAND.a[i]] + f1[CAND.b[i]]) & ~255u) | (unsigned)(CAND.a[i] * 16 + CAND.b[i]));
#pragma unroll
        for (int i = 50; i < 64; ++i) c[i] = -INFINITY;
        top16_of_64(c);
        float ev[16], sum = 0.f;
#pragma unroll
        for (int i = 0; i < 16; ++i) { ev[i] = __expf(__uint_as_float(__float_as_uint(c[i]) & ~255u) - __uint_as_float(__float_as_uint(c[0]) & ~255u)); sum += ev[i]; }
        const float rinv = 1.0f / sum;
        LDS_WAIT();
        int eid[8]; float gw[8];
#pragma unroll
        for (int j = 0; j < 8; ++j) { const float cj = hi ? c[8 + j] : c[j]; const unsigned bits = __float_as_uint(cj);
            const unsigned ia = tab[((bits >> 4) & 15u) * 64 + lane], ib = tab[(16u + (bits & 15u)) * 64 + lane];
            eid[j] = (int)(ia * 128u + ib); gw[j] = (hi ? ev[8 + j] : ev[j]) * rinv; }
        const size_t o = (size_t)(t0 + r32) * NSEL + hd * 16 + hi * 8;
        *(GAS v4u*)(IDX + o) = (v4u){(unsigned)eid[0], (unsigned)eid[1], (unsigned)eid[2], (unsigned)eid[3]}; *(GAS v4u*)(IDX + o + 4) = (v4u){(unsigned)eid[4], (unsigned)eid[5], (unsigned)eid[6], (unsigned)eid[7]};
        *(GAS f32x4*)(GW + o) = (f32x4){gw[0], gw[1], gw[2], gw[3]}; *(GAS f32x4*)(GW + o + 4) = (f32x4){gw[4], gw[5], gw[6], gw[7]};
        LDS_WAIT();
    }
}

typedef float f32x2 __attribute__((ext_vector_type(2)));
typedef __bf16 bf16x2_t __attribute__((ext_vector_type(2)));
struct RowV { v4u a, b; };
__device__ __forceinline__ void rowv_load(RowV& r, const unsigned char* tab, int idA, int idB, int hi, int j32) {
    const unsigned off = (unsigned)(hi ? idB : idA) * 1024u + (unsigned)j32;
    const unsigned char* p = tab + off;
    r.a = *(const GAS v4u*)p; r.b = *(const GAS v4u*)(p + 16);
}
#define DW_B(b) do { const f32x2 d_ = __builtin_amdgcn_cvt_scalef32_pk_f32_fp4(dw, 1.0f, b); asm("v_pk_fma_f32 %0, %1, %2, %0" : "+v"(o[b]) : "v"(d_), "v"(w2)); } while (0)
__device__ __forceinline__ void dw_axpy(unsigned dw, f32x2 w2, f32x2* o) { DW_B(0); DW_B(1); DW_B(2); DW_B(3);
    __builtin_amdgcn_sched_barrier(0); }
__device__ __forceinline__ void rowv_axpy(const RowV& r, float w, f32x2 (&o)[32]) {
    const f32x2 w2 = {w, w};
    dw_axpy(r.a.x, w2, o); dw_axpy(r.a.y, w2, o + 4); dw_axpy(r.a.z, w2, o + 8); dw_axpy(r.a.w, w2, o + 12);
    dw_axpy(r.b.x, w2, o + 16); dw_axpy(r.b.y, w2, o + 20); dw_axpy(r.b.z, w2, o + 24); dw_axpy(r.b.w, w2, o + 28);
}
#define DW_D(dw, b, hidx) acc = __builtin_amdgcn_fdot2_f32_bf16(__builtin_amdgcn_cvt_scalef32_pk_bf16_fp4(dw, 1.0f, b), __builtin_bit_cast(bf16x2_t, h[hidx]), acc, false)
__device__ __forceinline__ float rowv_dot(const RowV& r, const unsigned (&h)[32]) {
    float acc = 0.f;
    DW_D(r.a.x, 0, 0); DW_D(r.a.x, 1, 1); DW_D(r.a.x, 2, 2); DW_D(r.a.x, 3, 3);       DW_D(r.a.y, 0, 4); DW_D(r.a.y, 1, 5); DW_D(r.a.y, 2, 6); DW_D(r.a.y, 3, 7);
    DW_D(r.a.z, 0, 8); DW_D(r.a.z, 1, 9); DW_D(r.a.z, 2, 10); DW_D(r.a.z, 3, 11);    DW_D(r.a.w, 0, 12); DW_D(r.a.w, 1, 13); DW_D(r.a.w, 2, 14); DW_D(r.a.w, 3, 15);
    DW_D(r.b.x, 0, 16); DW_D(r.b.x, 1, 17); DW_D(r.b.x, 2, 18); DW_D(r.b.x, 3, 19);  DW_D(r.b.y, 0, 20); DW_D(r.b.y, 1, 21); DW_D(r.b.y, 2, 22); DW_D(r.b.y, 3, 23);
    DW_D(r.b.z, 0, 24); DW_D(r.b.z, 1, 25); DW_D(r.b.z, 2, 26); DW_D(r.b.z, 3, 27);  DW_D(r.b.w, 0, 28); DW_D(r.b.w, 1, 29); DW_D(r.b.w, 2, 30); DW_D(r.b.w, 3, 31);
    return acc;
}
template <int CTRL, int ROWMASK> __device__ __forceinline__ float dpp_add(float v) {
    return v + __uint_as_float((unsigned)__builtin_amdgcn_update_dpp(0, (int)__float_as_uint(v), CTRL, ROWMASK, 0xF, false)); }
__device__ __forceinline__ void reduce4x2(const float (&p)[4], float (&tot)[8]) {
    float r[4];
#pragma unroll
    for (int i = 0; i < 4; ++i) r[i] = dpp_add<0xB1, 0xF>(p[i]);
#pragma unroll
    for (int i = 0; i < 4; ++i) r[i] = dpp_add<0x4E, 0xF>(r[i]);
#pragma unroll
    for (int i = 0; i < 4; ++i) r[i] = dpp_add<0x141, 0xF>(r[i]);
#pragma unroll
    for (int i = 0; i < 4; ++i) r[i] = dpp_add<0x140, 0xF>(r[i]);
#pragma unroll
    for (int i = 0; i < 4; ++i) r[i] = dpp_add<0x142, 0xA>(r[i]);
#pragma unroll
    for (int i = 0; i < 4; ++i) { tot[2 * i] = __uint_as_float(__builtin_amdgcn_readlane(__float_as_uint(r[i]), 31)); tot[2 * i + 1] = __uint_as_float(__builtin_amdgcn_readlane(__float_as_uint(r[i]), 63)); }
}
__device__ __forceinline__ float gelu_erf(float s) { return 0.5f * s * (1.0f + erff(s * 0.70710678118654752f)); }
__device__ __forceinline__ float rdl(float v, int l) { return __uint_as_float(__builtin_amdgcn_readlane(__float_as_uint(v), l)); }
__device__ __forceinline__ void phase_peer(Frame& F, int layer, int nrows) {
    const int gw = F.vcu * NWAVES + F.wave, NGW = F.G * NWAVES, lane = F.lane, hi = lane >> 5;
    const int* IDX = (const int*)(F.ws + WS_P + P_IDX); const float* GW = (const float*)(F.ws + WS_P + P_GW);
    const unsigned char* PU = F.ws + WS_PU + (size_t)layer * 32 * MiB; const unsigned char* PV = F.ws + WS_PV + (size_t)layer * 32 * MiB;
    const float* SCU = (const float*)(F.ws + WS_SCU) + (size_t)layer * NEXP; const float* SCV = (const float*)(F.ws + WS_SCV) + (size_t)layer * NEXP;
    bf16* H = (bf16*)(F.ws + WS_H); bf16* X = (bf16*)(F.ws + WS_X);
    const float* fg_ = inp<I_FG>(); float* out_ = (float*)inp<I_OUT>();
    for (int t = gw; t < nrows; t += NGW) {
        const int id0 = *(const GAS int*)(IDX + (size_t)t * NSEL + lane), id1 = *(const GAS int*)(IDX + (size_t)t * NSEL + 64 + lane);
        const float g0 = *(const GAS float*)(GW + (size_t)t * NSEL + lane), g1 = *(const GAS float*)(GW + (size_t)t * NSEL + 64 + lane);
        const float su0 = *(const GAS float*)(SCU + id0), su1 = *(const GAS float*)(SCU + id1), sv0 = *(const GAS float*)(SCV + id0), sv1 = *(const GAS float*)(SCV + id1);
        unsigned hp[32];
        { const bf16* hrow = H + (size_t)t * DM + (lane & 31) * 8;
#pragma unroll
          for (int jj = 0; jj < 8; ++jj) { const v4u q = *(const GAS v4u*)(hrow + 256 * jj); hp[2 * jj] = q.x; hp[2 * jj + 1] = q.y; hp[16 + 2 * jj] = q.z; hp[16 + 2 * jj + 1] = q.w; } }
        float s0 = 0.f, s1 = 0.f;
        const int j32 = (lane & 31) * 32;
        RowV A[2], B[2];
#define LOAD2(buf, tab, idv, base) do { _Pragma("unroll") for (int q = 0; q < 2; ++q) rowv_load(buf[q], tab, __builtin_amdgcn_readlane(idv, (base) + 2 * q), __builtin_amdgcn_readlane(idv, (base) + 2 * q + 1), hi, j32); } while (0)
#define USTEP(sv_, base, tabn, idn, basen) do { float p_[4], tt_[8]; \
        _Pragma("unroll") for (int q = 0; q < 2; ++q) { p_[q] = rowv_dot(A[q], hp); __builtin_amdgcn_sched_barrier(0); } LOAD2(A, tabn, idn, basen); __builtin_amdgcn_sched_barrier(0); \
        _Pragma("unroll") for (int q = 0; q < 2; ++q) { p_[2 + q] = rowv_dot(B[q], hp); __builtin_amdgcn_sched_barrier(0); } LOAD2(B, tabn, idn, (basen) + 4); __builtin_amdgcn_sched_barrier(0); \
        reduce4x2(p_, tt_); _Pragma("unroll") for (int q = 0; q < 8; ++q) sv_ = (lane == (base) + q) ? tt_[q] : sv_; } while (0)
        LOAD2(A, PU, id0, 0); LOAD2(B, PU, id0, 4);
#pragma unroll 1
        for (int b = 0; b < 56; b += 8) USTEP(s0, b, PU, id0, b + 8);
        USTEP(s0, 56, PU, id1, 0);
#pragma unroll 1
        for (int b = 0; b < 56; b += 8) USTEP(s1, b, PU, id1, b + 8);
        USTEP(s1, 56, PV, id0, 0);
        const float w0 = g0 * gelu_erf(s0 * su0) * sv0, w1 = g1 * gelu_erf(s1 * su1) * sv1;
        f32x2 av[32];
#pragma unroll
        for (int i = 0; i < 32; ++i) av[i] = (f32x2){0.f, 0.f};
#define VSTEP(wv_, base, idn, basen) do { \
        _Pragma("unroll") for (int q = 0; q < 2; ++q) { const float we_ = rdl(wv_, (base) + 2 * q), wo_ = rdl(wv_, (base) + 2 * q + 1); rowv_axpy(A[q], hi ? wo_ : we_, av); } LOAD2(A, PV, idn, basen); \
        _Pragma("unroll") for (int q = 0; q < 2; ++q) { const float we_ = rdl(wv_, (base) + 4 + 2 * q), wo_ = rdl(wv_, (base) + 4 + 2 * q + 1); rowv_axpy(B[q], hi ? wo_ : we_, av); } LOAD2(B, PV, idn, (basen) + 4); } while (0)
#pragma unroll 1
        for (int b = 0; b < 56; b += 8) VSTEP(w0, b, id0, b + 8);
        VSTEP(w0, 56, id1, 0);
        const int col0 = (lane & 31) * 8 + hi * 4;
        const float* mp = mod_ptr(F, layer, t);
        v2u xr_[8]; f32x4 gf_[8];
#pragma unroll
        for (int j = 0; j < 8; ++j) { const int col = col0 + 256 * j; xr_[j] = *(const GAS v2u*)(X + (size_t)t * DM + col); gf_[j] = *(const GAS f32x4*)(mp + 5 * DM + col); }
#pragma unroll 1
        for (int b = 0; b < 56; b += 8) VSTEP(w1, b, id1, b + 8);
        VSTEP(w1, 56, id1, 56);
#undef LOAD2
#undef USTEP
#undef VSTEP
        float acc[32];
#pragma unroll
        for (int i = 0; i < 32; ++i) { auto rr = __builtin_amdgcn_permlane32_swap(__float_as_uint(av[i >> 1][i & 1]), __float_as_uint(av[16 + (i >> 1)][i & 1]), false, false);
            acc[i] = __uint_as_float(rr[0]) + __uint_as_float(rr[1]); }
        float xn[32]; float ss = 0.f;
#pragma unroll
        for (int j = 0; j < 8; ++j) {
            const v2u xr = xr_[j]; const f32x4 x0 = {bflo(xr.x), bfhi(xr.x), bflo(xr.y), bfhi(xr.y)}, gf = gf_[j];
            float* o = xn + 4 * j;
            o[0] = x0.x + gf.x * acc[4 * j]; o[1] = x0.y + gf.y * acc[4 * j + 1]; o[2] = x0.z + gf.z * acc[4 * j + 2]; o[3] = x0.w + gf.w * acc[4 * j + 3];
            ss += (o[0] * o[0] + o[1] * o[1]) + (o[2] * o[2] + o[3] * o[3]); }
        const float rs = 1.0f / sqrtf(wave_sum(ss) * (1.0f / DM) + EPS);
        if (layer == NLAYER - 1) {
#pragma unroll
            for (int j = 0; j < 8; ++j) { const int col = col0 + 256 * j; const float* o = xn + 4 * j;
                const f32x4 fg = *(const GAS f32x4*)(fg_ + col);
                *(GAS f32x4*)(out_ + (size_t)t * DM + col) = (f32x4){o[0] * rs * fg.x, o[1] * rs * fg.y, o[2] * rs * fg.z, o[3] * rs * fg.w}; }
        } else {
            const float* mn = mod_ptr(F, layer + 1, t);
#pragma unroll
            for (int j = 0; j < 8; ++j) { const int col = col0 + 256 * j; const float* o = xn + 4 * j;
                { v2u xw; xw.x = pk2(o[0], o[1]); xw.y = pk2(o[2], o[3]); *(GAS v2u*)(X + (size_t)t * DM + col) = xw; }
                const f32x4 sh = *(const GAS f32x4*)(mn + col), sc = *(const GAS f32x4*)(mn + DM + col);
                v2u w; w.x = pk2(o[0] * rs * (1.0f + sc.x) + sh.x, o[1] * rs * (1.0f + sc.y) + sh.y); w.y = pk2(o[2] * rs * (1.0f + sc.z) + sh.z, o[3] * rs * (1.0f + sc.w) + sh.w);
                *(GAS v2u*)(H + (size_t)t * DM + col) = w;
                *(GAS unsigned*)(F.ws + WS_H8 + (size_t)t * DM + col) = pk4_fp8(o[0] * rs * (1.0f + sc.x) + sh.x, o[1] * rs * (1.0f + sc.y) + sh.y, o[2] * rs * (1.0f + sc.z) + sh.z, o[3] * rs * (1.0f + sc.w) + sh.w); }
        }
    }
}

constexpr int PH_PER_LAYER = 10, PH_BASE = 3, N_PHASES = PH_BASE + NLAYER * PH_PER_LAYER;
struct Args { const float* in[18]; float* out; unsigned char* ws; int ph_lo, ph_hi; };
__global__ void __launch_bounds__(NWAVES * 64, 2) mk_fwd(Args args) {
    extern __shared__ __attribute__((aligned(16))) unsigned char lds[];
    unsigned char* const wsbase = args.ws;
    for (int u = threadIdx.x; u < (LDS_BYTES - LDSCTL_OFF) / 4; u += NWAVES * 64) ((LAS unsigned*)((LAS unsigned char*)lds + LDSCTL_OFF))[u] = 0u;
    __syncthreads();
    unsigned* ctl = (unsigned*)(args.ws + WS_CTL);
    XcdBarrier bar; bar.bar = ctl + CW_BAR; bar.x = 0; bar.st = nullptr;
#if !MK_PER_PHASE
    bar = xcd_barrier_post(ctl + CW_BAR, (volatile LAS unsigned*)((LAS unsigned char*)lds + MISC_OFF) + 8);
#endif
    const int lo = args.ph_lo, hi = args.ph_hi;
#ifndef PHM
#define PHM 0xFFFF
#endif
#define EN(b) ((PHM >> (b)) & 1)
#define IN(k) (lo <= (k) && (k) < hi)
#define SEAM(k) do { if (IN(k) && IN((k) + 1)) xcd_barrier(bar); } while (0)
    if (EN(0) && IN(0)) { Frame F = mkframe(lds, wsbase); phase_prologue(F); } SEAM(0);
    if (EN(1) && IN(1)) { Frame F = mkframe(lds, wsbase); phase_mod_finalize(F); } SEAM(1);
    if (EN(2) && IN(2)) { Frame F = mkframe(lds, wsbase); phase_modulate(F, 0, 0, TT, true, true); } SEAM(2);
#pragma unroll 1
    for (int layer = 0; layer < NLAYER; ++layer) {
        const int pb = PH_BASE + layer * PH_PER_LAYER;
        const bool lastl = (layer == NLAYER - 1);
        const int MR = lastl ? TL : TT;
        if (EN(3) && IN(pb + 0)) {
            Frame F = mkframe(lds, wsbase); bf16* P = (bf16*)(F.ws + WS_P); bf16* H = (bf16*)(F.ws + WS_H); (void)P; (void)H;
            {
                pg8::Gemm<DM, DM, DM, 0, 0, 2> g{H, F.ws + WS_WIN + (size_t)layer * 32 * MiB};
                pg8::SplitOrder S; S.S.init(MR, 4 * 256, F.G, F.bx); S.kind = 0; S.pm0 = 0; S.nMx = 0;
                pg8::EpiRow8<FStoreBf16> E{{P, INW, 1.0f}};
                pg8::gemm_phase(F.lds, g, S, E); }
            {
                pg8::Gemm<DM, DM, DM, 0, 0, 1> g{F.ws + WS_H8, F.ws + WS_WIN8 + (size_t)layer * 32 * MiB};
                pg8::SplitOrder S; S.S.init(MR, 28 * 256, F.G, F.G - 1 - F.bx); S.kind = 1; S.pm0 = TL / 256; S.nMx = 0;
                pg8::EpiPair<FStoreG1> E{{P, 1.0f / W8_SCALE}};
                pg8::gemm_phase(F.lds, g, S, E);
                if (lastl)
                    for (int q = F.vcu; q < (TC / 128) * 8; q += F.G) pg8::gemm_quarter(F.lds, g, TL / 128 + (q >> 3), KVOFF / 128 + (q & 7), E); }
        }
        SEAM(pb + 0);
        if (EN(4) && IN(pb + 1)) { Frame F = mkframe(lds, wsbase); phase_post(F, layer); }
        SEAM(pb + 1);
        if (EN(5) && IN(pb + 2)) {
            Frame F = mkframe(lds, wsbase); bf16* P = (bf16*)(F.ws + WS_P); bf16* H = (bf16*)(F.ws + WS_H); (void)P; (void)H;
            if (!lastl) {
              pg8::Gemm<1024, 256, 256, 256, 1> g{(const bf16*)(F.ws + WS_POOLED), (const bf16*)(F.ws + WS_WPOOL + (size_t)layer * 1 * MiB)};
              pg8::EpiRow8<FPool> E{{(bf16*)(F.ws + WS_YB), P, inp<I_PSCALE>() + (size_t)layer * DM}};
              for (int q = F.vcu; q < (TC / 128) * (DM / 128); q += F.G) { const int grp = q >> 5, r = q & 31; pg8::gemm_quarter(F.lds, g, TL / 128 + (grp >> 1) * 4 + (r & 3), (grp & 1) * 8 + (r >> 2), E); } }
            phase_attention(F, layer, (char*)lds);
        }
        SEAM(pb + 2);
        if (EN(6) && IN(pb + 3)) {
            Frame F = mkframe(lds, wsbase); bf16* P = (bf16*)(F.ws + WS_P); bf16* H = (bf16*)(F.ws + WS_H); (void)P; (void)H;
            pg8::Gemm<DM, DM, DM, 0, 0, 1> g{F.ws + WS_AO, F.ws + WS_WBR8 + (size_t)layer * 32 * MiB};
            pg8::StaticOrder S; S.init(TL, DM, F.G, F.bx);
            pg8::EpiRow8<FMerge> E{{H, P, (const bf16*)(F.ws + WS_YB), 1.0f / (64.0f * W8_SCALE)}};
            {
                pg8::Gemm<1024, 256, 256, 256, 1> gp{(const bf16*)(F.ws + WS_POOLED), (const bf16*)(F.ws + WS_WPOOL + (size_t)layer * 1 * MiB)};
                pg8::MidRow8<FMid> Mx{{P, inp<I_PSCALE>() + (size_t)layer * DM, 64.0f * W8_SCALE}};
                pg8::EpiRow8<FMergeC> Ec{{H, P, 1.0f / (64.0f * W8_SCALE)}};
                pg8::gemm_chain(F.lds, gp, g, S, Mx, Ec); }
            if (!lastl)
                for (int q = F.vcu; q < (TC / 128) * (DM / 128); q += F.G) { const int grp = q >> 5, r = q & 31; pg8::gemm_quarter(F.lds, g, TL / 128 + (grp >> 1) * 4 + (r & 3), (grp & 1) * 8 + (r >> 2), E); }
        }
        SEAM(pb + 3);
        if (EN(7) && IN(pb + 4)) {
            Frame F = mkframe(lds, wsbase); bf16* P = (bf16*)(F.ws + WS_P); bf16* H = (bf16*)(F.ws + WS_H); (void)P; (void)H;
            pg8::Gemm<DM, DM, DM, 0, 0> g{H, (const bf16*)(F.ws + WS_WOUT + (size_t)layer * 8 * MiB)};
            pg8::StaticOrder S; S.init(TL, DM, F.G, F.bx);
            pg8::EpiRow8<FResid> E{{(bf16*)(F.ws + WS_X), inp<I_X>(), inp<I_CTX>(), (const float*)(F.ws + WS_MOD) + (size_t)layer * 9 * 6 * DM, layer == 0 ? 1 : 0}};
            pg8::gemm_phase(F.lds, g, S, E);
            if (!lastl)
                for (int q = F.vcu; q < (TC / 128) * (DM / 128); q += F.G) { const int grp = q >> 5, r = q & 31; pg8::gemm_quarter(F.lds, g, TL / 128 + (grp >> 1) * 4 + (r & 3), (grp & 1) * 8 + (r >> 2), E); }
        }
        SEAM(pb + 4);
        if (EN(8) && IN(pb + 5)) { Frame F = mkframe(lds, wsbase); phase_modulate(F, layer, 1, MR, false, false); }
        SEAM(pb + 5);
        if (EN(9) && IN(pb + 6)) {
            Frame F = mkframe(lds, wsbase); bf16* P = (bf16*)(F.ws + WS_P); bf16* H = (bf16*)(F.ws + WS_H); (void)P; (void)H;
            pg8::Gemm<DM, DM, DM, 0, 0> g{H, (const bf16*)(F.ws + WS_WQP + (size_t)layer * 8 * MiB)};
            pg8::StaticOrder S; S.init(TL, DM, F.G, F.bx);
            pg8::EpiRow8<FStoreBf16> E{{(bf16*)(F.ws + WS_P + P_QP), DM, 1.0f}};
            pg8::gemm_phase(F.lds, g, S, E);
            if (!lastl)
                for (int q = F.vcu; q < (TC / 128) * (DM / 128); q += F.G) { const int grp = q >> 5, r = q & 31; pg8::gemm_quarter(F.lds, g, TL / 128 + (grp >> 1) * 4 + (r & 3), (grp & 1) * 8 + (r >> 2), E); }
        }
        if (IN(pb + 6) && IN(pb + 8)) xcd_barrier(bar);
        if (EN(11) && IN(pb + 8)) { Frame F = mkframe(lds, wsbase); phase_pk(F, layer, MR); }
        SEAM(pb + 8);
        if (EN(12) && IN(pb + 9)) { Frame F = mkframe(lds, wsbase); phase_peer(F, layer, MR); }
        if (!lastl) SEAM(pb + 9);
    }
#undef IN
#undef SEAM
}

extern "C" void kernel_launch(void* const* d_in, const int* in_sizes, int n_in, void* d_out, int out_size, void* d_ws, size_t ws_size, hipStream_t stream) {
    static int grid = 0;
    if (grid == 0) {
        if (n_in != 18 || out_size != TL * DM || ws_size < WS_END) { fprintf(stderr, "kernel_launch: unexpected shapes (n_in %d out %d ws %zu need %zu)\n", n_in, out_size, ws_size, (size_t)WS_END); grid = -1; return; }
        int dev = 0, cus = 0, per_cu = 0;
        if (hipGetDevice(&dev) != hipSuccess || hipDeviceGetAttribute(&cus, hipDeviceAttributeMultiprocessorCount, dev) != hipSuccess) { grid = -1; return; }
        if (hipFuncSetAttribute((const void*)mk_fwd, hipFuncAttributeMaxDynamicSharedMemorySize, LDS_BYTES) != hipSuccess) { fprintf(stderr, "kernel_launch: hipFuncSetAttribute failed\n"); grid = -1; return; }
        if (hipOccupancyMaxActiveBlocksPerMultiprocessor(&per_cu, (const void*)mk_fwd, NWAVES * 64, LDS_BYTES) != hipSuccess || per_cu < 1)
            fprintf(stderr, "kernel_launch: occupancy query reports %d\n", per_cu);
        (void)hipGetLastError();
        grid = cus;
    }
    if (grid < 0) return;
    if (hipMemsetAsync((char*)d_ws + WS_CTL, 0, CTL_ZERO_BYTES, stream) != hipSuccess) return;
    Args a{};
    for (int i = 0; i < 18; ++i) a.in[i] = (const float*)d_in[i];
    a.out = (float*)d_out; a.ws = (unsigned char*)d_ws;
#if MK_PER_PHASE
    for (int p = 0; p < N_PHASES; ++p) { a.ph_lo = p; a.ph_hi = p + 1; hipLaunchKernelGGL(mk_fwd, dim3(grid), dim3(NWAVES * 64), LDS_BYTES, stream, a); }
#else
    a.ph_lo = 0; a.ph_hi = N_PHASES;
    hipLaunchKernelGGL(mk_fwd, dim3(grid), dim3(NWAVES * 64), LDS_BYTES, stream, a);
#endif
    const hipError_t le = hipPeekAtLastError();
    if (le != hipSuccess) fprintf(stderr, "kernel_launch: launch failed: %s\n", hipGetErrorName(le));
}
```
